# Optimizing an MI355X kernel written in HIP

```python
import math
import jax
import jax.numpy as jnp
from jax import lax
import numpy as np

D_MODEL = 2048
BATCH = 4
SEQ = 8192
DEPTH = 1

CHUNK = 64
QBLK = 128
RMS_EPS = 1e-6
ROPE_THETA = 500000.0

A_HEADS = 8
A_KV_HEADS = 2
A_HEAD_DIM = 128
A_ROT_DIM = A_HEAD_DIM // 4
IDX_HEADS = 16
IDX_DIM = 64
IDX_ROT_DIM = IDX_DIM // 4
TOPK_MAX = 256

B_HEADS = 8
B_HEAD_DIM = 128

N_EXPERTS = 32
TOP_K_EXPERTS = 4
D_FF = D_MODEL
SWIGLU_LIMIT = 7.0
SWIGLU_ALPHA = 1.702
MOE_BLOCK = 128

A_Q_W = A_HEADS * A_HEAD_DIM
A_KV_W = A_KV_HEADS * A_HEAD_DIM
B_W = B_HEADS * B_HEAD_DIM
IDX_Q_W = IDX_HEADS * IDX_DIM
IN_SPLITS = (A_Q_W, A_KV_W, A_KV_W, B_W, B_W, B_W, IDX_Q_W, IDX_DIM, IDX_HEADS, D_MODEL, D_MODEL)
IN_W = A_Q_W + 2 * A_KV_W + 3 * B_W + IDX_Q_W + IDX_DIM + IDX_HEADS + 2 * D_MODEL

kernel_name = 'hybrid_dsa_stickbreak_moe_block'


def rms_norm(x, g):
    xf = x.astype(jnp.float32)
    y = xf * lax.rsqrt(jnp.mean(xf * xf, axis=-1, keepdims=True) + RMS_EPS)
    return (y * g.astype(jnp.float32)).astype(x.dtype)


def partial_rope(x, positions, rot_dim):
    half = rot_dim // 2
    inv_freq = ROPE_THETA ** (-jnp.arange(half, dtype=jnp.float32) / half)
    ang = positions.astype(jnp.float32)[..., None] * inv_freq
    cos = jnp.cos(ang)[:, :, None, :]
    sin = jnp.sin(ang)[:, :, None, :]
    xf = x.astype(jnp.float32)
    x1, x2, rest = xf[..., :half], xf[..., half:rot_dim], xf[..., rot_dim:]
    out = jnp.concatenate([x1 * cos - x2 * sin, x2 * cos + x1 * sin, rest], axis=-1)
    return out.astype(x.dtype)


def split_cols(z):
    outs = []
    off = 0
    for w in IN_SPLITS:
        outs.append(z[..., off:off + w])
        off += w
    return outs


def dsa_mixer(q, k, v, qi, ki, wi):
    bsz, seq = q.shape[0], q.shape[1]
    topk = min(TOPK_MAX, seq // 4)
    n_blk = seq // QBLK
    grp = A_HEADS // A_KV_HEADS
    key_pos = jnp.arange(seq)
    bidx = jnp.arange(bsz)[:, None, None]
    ki32 = ki.astype(jnp.float32)

    def block(i):
        t0 = i * QBLK
        t = t0 + jnp.arange(QBLK)
        limit = (t // CHUNK + 1) * CHUNK
        admissible = key_pos[None, :] < limit[:, None]
        qi_b = lax.dynamic_slice_in_dim(qi, t0, QBLK, axis=1).astype(jnp.float32)
        wi_b = lax.dynamic_slice_in_dim(wi, t0, QBLK, axis=1).astype(jnp.float32)
        dots = jnp.einsum('bqhd,bsd->bhqs', qi_b, ki32) * (IDX_DIM ** -0.5)
        score = jnp.einsum('bhqs,bqh->bqs', jax.nn.relu(dots), wi_b) * (IDX_HEADS ** -0.5)
        score = jnp.where(admissible[None], score, -jnp.inf)
        _, sel = lax.top_k(score, topk)
        sel_ok = sel < limit[None, :, None]
        kg = k[bidx, sel]
        vg = v[bidx, sel]
        q_b = lax.dynamic_slice_in_dim(q, t0, QBLK, axis=1).reshape(bsz, QBLK, A_KV_HEADS, grp, A_HEAD_DIM)
        logits = jnp.einsum('bqjgd,bqnjd->bqjgn', q_b, kg).astype(jnp.float32) * (A_HEAD_DIM ** -0.5)
        logits = jnp.where(sel_ok[:, :, None, None, :], logits, -jnp.inf)
        p = jax.nn.softmax(logits, axis=-1).astype(v.dtype)
        o = jnp.einsum('bqjgn,bqnjd->bqjgd', p, vg)
        return o.reshape(bsz, QBLK, A_Q_W)

    out = lax.map(block, jnp.arange(n_blk))
    return jnp.transpose(out, (1, 0, 2, 3)).reshape(bsz, seq, A_Q_W)


def stick_breaking_mixer(q, k, v):
    bsz, seq = q.shape[0], q.shape[1]
    n_blk = seq // QBLK
    key_pos = jnp.arange(seq)

    def block(i):
        t0 = i * QBLK
        t = t0 + jnp.arange(QBLK)
        causal = key_pos[None, :] < t[:, None]
        q_b = lax.dynamic_slice_in_dim(q, t0, QBLK, axis=1)
        z = jnp.einsum('bqhd,bshd->bhqs', q_b, k).astype(jnp.float32) * (B_HEAD_DIM ** -0.5)
        log_beta = jax.nn.log_sigmoid(z)
        log_keep = jnp.where(causal, log_beta - z, 0.0)
        log_gap = lax.cumsum(log_keep, axis=3, reverse=True) - log_keep
        attn = jnp.where(causal, jnp.exp(log_beta + log_gap), 0.0).astype(v.dtype)
        return jnp.einsum('bhqs,bshd->bqhd', attn, v).reshape(bsz, QBLK, B_W)

    out = lax.map(block, jnp.arange(n_blk))
    return jnp.transpose(out, (1, 0, 2, 3)).reshape(bsz, seq, B_W)


def clamped_swiglu(hid):
    glu = jnp.minimum(hid[..., ::2], SWIGLU_LIMIT)
    lin = jnp.clip(hid[..., 1::2], -SWIGLU_LIMIT, SWIGLU_LIMIT)
    return glu * jax.nn.sigmoid(SWIGLU_ALPHA * glu) * (lin + 1.0)


def moe_ffn(h, w_router, b_router, w1, b1, w2, b2):
    n_tok, d = h.shape
    logits = (h @ w_router).astype(jnp.float32) + b_router.astype(jnp.float32)
    top_logit, top_e = lax.top_k(logits, TOP_K_EXPERTS)
    top_w = jax.nn.softmax(top_logit, axis=-1).astype(h.dtype)
    n_slots = n_tok * TOP_K_EXPERTS
    flat_e = top_e.reshape(-1)
    flat_tok = jnp.arange(n_slots, dtype=jnp.int32) // TOP_K_EXPERTS
    flat_w = top_w.reshape(-1)
    order = jnp.argsort(flat_e)
    se, stok, sw = flat_e[order], flat_tok[order], flat_w[order]
    counts = jnp.bincount(flat_e, length=N_EXPERTS)
    padded = (counts + MOE_BLOCK - 1) // MOE_BLOCK * MOE_BLOCK
    pad_end = jnp.cumsum(padded)
    pad_start = pad_end - padded
    start = jnp.cumsum(counts) - counts
    dest = pad_start[se] + jnp.arange(n_slots, dtype=jnp.int32) - start[se]
    n_blocks = -(-n_slots // MOE_BLOCK) + N_EXPERTS
    n_rows = n_blocks * MOE_BLOCK
    buf_tok = jnp.full((n_rows,), n_tok, dtype=jnp.int32).at[dest].set(stok)
    buf_w = jnp.zeros((n_rows,), dtype=h.dtype).at[dest].set(sw)
    block_e = jnp.minimum(jnp.searchsorted(pad_end, jnp.arange(n_blocks) * MOE_BLOCK, side='right'), N_EXPERTS - 1)
    h_pad = jnp.concatenate([h, jnp.zeros((1, d), h.dtype)], axis=0)

    def expert_block(args):
        tok, wgt, e = args
        hid = h_pad[tok] @ w1[e] + b1[e]
        out = clamped_swiglu(hid) @ w2[e] + b2[e]
        return out * wgt[:, None]

    out = lax.map(expert_block, (buf_tok.reshape(n_blocks, MOE_BLOCK), buf_w.reshape(n_blocks, MOE_BLOCK), block_e))
    y = jax.ops.segment_sum(out.reshape(n_rows, d), buf_tok, num_segments=n_tok + 1)
    return y[:n_tok]


def setup_inputs(seed: int = 0) -> dict:
    key = jax.random.key(seed)
    ks = jax.random.split(key, 20)
    f32 = jnp.float32
    nrm = jax.random.normal
    x = nrm(ks[0], (BATCH, SEQ, D_MODEL), f32)
    c = nrm(ks[1], (BATCH, D_MODEL), f32)
    offset = jax.random.randint(ks[2], (BATCH, 1), 0, 4096, dtype=jnp.int32)
    positions = offset + jnp.arange(SEQ, dtype=jnp.int32)[None, :]
    w_ada = nrm(ks[3], (DEPTH, D_MODEL, 6 * D_MODEL), f32) * (0.5 * D_MODEL ** -0.5)
    b_ada = nrm(ks[4], (DEPTH, 6 * D_MODEL), f32) * 0.02
    g_pre_mix = 1.0 + 0.05 * nrm(ks[5], (DEPTH, D_MODEL), f32)
    g_post_mix = 1.0 + 0.05 * nrm(ks[6], (DEPTH, D_MODEL), f32)
    w_in = nrm(ks[7], (DEPTH, D_MODEL, IN_W), f32) * D_MODEL ** -0.5
    w_branch_a = nrm(ks[8], (DEPTH, A_Q_W, D_MODEL), f32) * A_Q_W ** -0.5
    w_branch_b = nrm(ks[9], (DEPTH, B_W, D_MODEL), f32) * B_W ** -0.5
    w_out = nrm(ks[10], (DEPTH, D_MODEL, D_MODEL), f32) * D_MODEL ** -0.5
    g_pre_ffn = 1.0 + 0.05 * nrm(ks[11], (DEPTH, D_MODEL), f32)
    g_post_ffn = 1.0 + 0.05 * nrm(ks[12], (DEPTH, D_MODEL), f32)
    w_router = nrm(ks[13], (DEPTH, D_MODEL, N_EXPERTS), f32) * D_MODEL ** -0.5
    b_router = nrm(ks[14], (DEPTH, N_EXPERTS), f32) * 0.01
    w1 = nrm(ks[15], (DEPTH, N_EXPERTS, D_MODEL, 2 * D_FF), f32) * D_MODEL ** -0.5
    b1 = nrm(ks[16], (DEPTH, N_EXPERTS, 2 * D_FF), f32) * 0.02
    w2 = nrm(ks[17], (DEPTH, N_EXPERTS, D_FF, D_MODEL), f32) * D_FF ** -0.5
    b2 = nrm(ks[18], (DEPTH, N_EXPERTS, D_MODEL), f32) * 0.02
    return {'x': x, 'c': c, 'positions': positions, 'w_ada': w_ada, 'b_ada': b_ada,
            'g_pre_mix': g_pre_mix, 'g_post_mix': g_post_mix, 'w_in': w_in,
            'w_branch_a': w_branch_a, 'w_branch_b': w_branch_b, 'w_out': w_out,
            'g_pre_ffn': g_pre_ffn, 'g_post_ffn': g_post_ffn, 'w_router': w_router,
            'b_router': b_router, 'w1': w1, 'b1': b1, 'w2': w2, 'b2': b2}


def reference(x, c, positions, w_ada, b_ada, g_pre_mix, g_post_mix, w_in, w_branch_a, w_branch_b, w_out, g_pre_ffn, g_post_ffn, w_router, b_router, w1, b1, w2, b2):
    bsz, seq, d = x.shape
    for l in range(DEPTH):
        mod = jax.nn.silu(c) @ w_ada[l] + b_ada[l]
        sh1, sc1, ga1, sh2, sc2, ga2 = jnp.split(mod, 6, axis=-1)

        h = rms_norm(x, g_pre_mix[l]) * (1.0 + sc1[:, None, :]) + sh1[:, None, :]
        z = h @ w_in[l]
        qa, ka, va, qb, kb, vb, qi, ki, wi, gate_a, gate_b = split_cols(z)
        qa = partial_rope(qa.reshape(bsz, seq, A_HEADS, A_HEAD_DIM), positions, A_ROT_DIM)
        ka = partial_rope(ka.reshape(bsz, seq, A_KV_HEADS, A_HEAD_DIM), positions, A_ROT_DIM)
        va = va.reshape(bsz, seq, A_KV_HEADS, A_HEAD_DIM)
        qi = partial_rope(qi.reshape(bsz, seq, IDX_HEADS, IDX_DIM), positions, IDX_ROT_DIM)
        ki = partial_rope(ki[:, :, None, :], positions, IDX_ROT_DIM)[:, :, 0, :]
        o_a = dsa_mixer(qa, ka, va, qi, ki, wi)
        o_b = stick_breaking_mixer(qb.reshape(bsz, seq, B_HEADS, B_HEAD_DIM),
                                   kb.reshape(bsz, seq, B_HEADS, B_HEAD_DIM),
                                   vb.reshape(bsz, seq, B_HEADS, B_HEAD_DIM))
        merged = jax.nn.sigmoid(gate_a) * (o_a @ w_branch_a[l]) + jax.nn.sigmoid(gate_b) * (o_b @ w_branch_b[l])
        mix = merged @ w_out[l]
        x = x + ga1[:, None, :] * rms_norm(mix, g_post_mix[l])

        h2 = rms_norm(x, g_pre_ffn[l]) * (1.0 + sc2[:, None, :]) + sh2[:, None, :]
        f = moe_ffn(h2.reshape(bsz * seq, d), w_router[l], b_router[l], w1[l], b1[l], w2[l], b2[l]).reshape(bsz, seq, d)
        x = x + ga2[:, None, :] * rms_norm(f, g_post_ffn[l])
    return x
```

```cpp
#include <hip/hip_runtime.h>
#include <cstdio>
#include <cstdint>

#ifndef DBG_DOUBLE
#define DBG_DOUBLE 0
#endif
#ifndef MK_N_LAUNCHES
#define MK_N_LAUNCHES 1
#endif

#define LAS __attribute__((address_space(3)))
typedef unsigned short bf16_t;
typedef short bf16x8 __attribute__((ext_vector_type(8)));
typedef short s16x4 __attribute__((ext_vector_type(4)));
typedef float f32x2 __attribute__((ext_vector_type(2)));
typedef float f32x4 __attribute__((ext_vector_type(4)));
typedef float f32x16 __attribute__((ext_vector_type(16)));
typedef unsigned u32x2 __attribute__((ext_vector_type(2)));
typedef unsigned u32x4 __attribute__((ext_vector_type(4)));
#define DI __device__ __forceinline__

constexpr int NB = 4, SEQ = 8192, T = NB * SEQ, DM = 2048;
constexpr int INW = 9808, INWP = 9984;
constexpr int INB = 5888;
constexpr int C_QA = 0, C_KA = 1024, C_VA = 1280, C_QB = 1536, C_KB = 2560, C_VB = 3584, C_QI = 4608, C_KI = 5632, C_WI = 5696, C_GA = 5712, C_GB = 7760;
constexpr int NE = 32, TOPK = 4, DFF = 2048, NSLOT = T * TOPK;
constexpr int MAXROWS = NSLOT + NE * 256;
constexpr float RMS_EPS = 1e-6f;
constexpr int NWAVES = 8, NTHR = 512;
constexpr int LDS_BYTES = 147456;

constexpr size_t al256(size_t x) { return (x + 255) / 256 * 256; }
constexpr size_t WS_CTL = 0;
constexpr size_t CTL_BYTES = 65536;
constexpr size_t WS_MODP = WS_CTL + CTL_BYTES;
constexpr size_t WS_MOD = WS_MODP + al256((size_t)32 * 4 * 12288 * 4);
constexpr size_t WS_WINT = WS_MOD + al256((size_t)4 * 12288 * 4);
constexpr size_t WS_WAT = WS_WINT + al256((size_t)INWP * DM * 2);
constexpr size_t WS_WBT = WS_WAT + al256((size_t)2048 * 1024 * 2);
constexpr size_t WS_WOT = WS_WBT + al256((size_t)2048 * 1024 * 2);
constexpr size_t WS_W1T = WS_WOT + al256((size_t)2048 * 2048 * 2);
constexpr size_t WS_W2T = WS_W1T + al256((size_t)NE * 4096 * 2048 * 2);
constexpr size_t WS_WRT = WS_W2T + al256((size_t)NE * 2048 * 2048 * 2);
constexpr int NF8 = 4608;
constexpr size_t WS_WING8 = WS_WRT + al256((size_t)2 * NE * DM * 2);
constexpr size_t WS_H8 = WS_WING8 + al256((size_t)(NF8 + 4096) * DM);
constexpr size_t WS_GZ = WS_H8 + al256((size_t)T * DM);
constexpr size_t WS_TOPE = WS_GZ + al256((size_t)T * 4096);
constexpr size_t WS_TOPW = WS_TOPE + al256((size_t)T * 4 * 4);
constexpr size_t WS_CNT = WS_TOPW + al256((size_t)T * 4 * 4);
constexpr size_t WS_RSLOT = WS_CNT + al256((size_t)256 * NE * 4);
constexpr size_t WS_RW = WS_RSLOT + al256((size_t)MAXROWS * 4);
constexpr size_t WS_H = WS_RW + al256((size_t)MAXROWS * 4);
constexpr size_t WS_Z = WS_H + al256((size_t)T * DM * 2);
constexpr size_t SC_PER_B = (size_t)4096 * 128 * 129 / 2;
constexpr size_t WS_SC = WS_Z + al256((size_t)T * INWP * 2);
constexpr size_t WS_KBF = WS_SC + al256(SC_PER_B * 4 * NB);
constexpr size_t WS_VBF = WS_KBF + al256((size_t)T * 1024 * 2);
constexpr size_t WS_KIDX = WS_VBF + al256((size_t)T * 1024 * 2);
constexpr size_t WS_WIF = WS_KIDX + al256((size_t)T * 64 * 2);
constexpr size_t WS_SEL = WS_WIF + al256((size_t)T * 16 * 4);
constexpr size_t WS_OA = WS_SEL + al256((size_t)T * 128 * 8);
constexpr size_t WS_OB = WS_OA + al256((size_t)T * 1024 * 2);
constexpr size_t WS_MERGED = WS_OB + al256((size_t)T * 1024 * 2);
constexpr size_t WS_MIX = WS_MERGED + al256((size_t)T * DM * 2);
constexpr size_t WS_ENDX = WS_MIX + al256((size_t)T * DM * 2);
constexpr size_t WS_X1B = WS_GZ;
constexpr size_t WS_H2LO = WS_Z;
constexpr size_t WS_H2Q = WS_H2LO + al256((size_t)T * DM * 2);
constexpr size_t WS_HS = WS_H2Q + al256((size_t)T * DM);
constexpr size_t WS_ACT = WS_HS + al256((size_t)MAXROWS * DM * 2);
constexpr size_t WS_YS = WS_ACT + al256((size_t)MAXROWS * DFF * 2);
constexpr size_t WS_ENDY = WS_YS + al256((size_t)NSLOT * DM * 2);
constexpr size_t WS_END = WS_ENDX > WS_ENDY ? WS_ENDX : WS_ENDY;
static_assert(WS_END < 0xffffffffull, "32-bit workspace offsets");
static_assert(WS_HS >= WS_Z + (size_t)T * DM * 2 && WS_HS + (size_t)MAXROWS * DM <= WS_SC, "map: h2lo, h2q, hs must stay inside the dead z buffer while merged/mix (further up) are live");

struct Params { const float* in[19]; float* out; unsigned char* ws; int ph_lo, ph_hi; };
enum { I_X = 0, I_C, I_POS, I_WADA, I_BADA, I_GPREMIX, I_GPOSTMIX, I_WIN, I_WA, I_WB, I_WOUT, I_GPREFFN, I_GPOSTFFN, I_WR, I_BR, I_W1, I_B1, I_W2, I_B2 };

#define XB_TMO      128
#define XB_XCNT(j)  (256  + 64 * (j))
#define XB_XSUB(j)  (1280 + 64 * (j))
#define XB_XGEN(j)  (2304 + 64 * (j))
#define XB_TOP      3328
#define XB_TOPGEN   3392
#define XCD_BAR_WORDS 3456
#define XB_SPIN_CAP (1u << 18)
__device__ __forceinline__ unsigned xb_ld(unsigned* p)              { return __hip_atomic_load(p, __ATOMIC_RELAXED, __HIP_MEMORY_SCOPE_AGENT); }
__device__ __forceinline__ unsigned xb_add(unsigned* p, unsigned v) { return __hip_atomic_fetch_add(p, v, __ATOMIC_RELAXED, __HIP_MEMORY_SCOPE_AGENT); }
__device__ __forceinline__ unsigned xb_xcc_id() { return (unsigned)__builtin_amdgcn_s_getreg((3 << 11) | 20) & 0xFu; }
#define XB_SPIN(cond, bar) do { unsigned _sp = 0; while (cond) { __builtin_amdgcn_s_sleep(1); \
    if ((++_sp & 255u) == 0u) { if (xb_ld(&(bar)[XB_TMO])) break; if (_sp > XB_SPIN_CAP) { atomicAdd(&(bar)[XB_TMO], 1u); break; } } } } while (0)
struct XcdBarrier { unsigned* bar; unsigned x; volatile LAS unsigned* st; };
__device__ __forceinline__ XcdBarrier xcd_barrier_post(unsigned* bar, volatile LAS unsigned* st) {
    XcdBarrier b; b.bar = bar; b.x = xb_xcc_id(); b.st = st;
    if (threadIdx.x == 0) (void)xb_add(&bar[XB_XCNT(b.x)], 1u);
    return b;
}
__device__ __forceinline__ void xcd_barrier_complete(unsigned* bar, unsigned x, unsigned& nloc, unsigned& nx) {
    const unsigned G = gridDim.x * gridDim.y * gridDim.z;
    unsigned sum, cnt, mine, sp = 0u;
    for (;;) {
        sum = 0u; cnt = 0u; mine = 0u;
#pragma unroll
        for (unsigned j = 0; j < 16; ++j) { const unsigned c = xb_ld(&bar[XB_XCNT(j)]); sum += c; cnt += (c > 0u) ? 1u : 0u; mine = (j == x) ? c : mine; }
        if (sum == G) break;
        __builtin_amdgcn_s_sleep(1);
        if ((++sp & 255u) == 0u) { if (xb_ld(&bar[XB_TMO])) break; if (sp > XB_SPIN_CAP) { atomicAdd(&bar[XB_TMO], 1u); break; } }
    }
    nloc = mine > 0u ? mine : 1u; nx = cnt > 0u ? cnt : 1u;
}
__device__ __forceinline__ void xcd_barrier(const XcdBarrier& b) {
    asm volatile("s_waitcnt vmcnt(0)" ::: "memory");
    __syncthreads();
    if (threadIdx.x == 0) {
        unsigned* bar = b.bar;
        __builtin_amdgcn_s_waitcnt(0);
        unsigned nloc = b.st[0], nx = b.st[1];
        if (nloc == 0u) { xcd_barrier_complete(bar, b.x, nloc, nx); b.st[0] = nloc; b.st[1] = nx; }
        const unsigned old = xb_add(&bar[XB_XSUB(b.x)], 1u);
        const unsigned gen = old / nloc;
        if (old + 1u == (gen + 1u) * nloc) {
            __builtin_amdgcn_fence(__ATOMIC_RELEASE, "agent");
            asm volatile("s_waitcnt vmcnt(0)" ::: "memory");
            const unsigned og = xb_add(&bar[XB_TOP], 1u);
            const unsigned tg = og / nx;
            if (og + 1u == (tg + 1u) * nx) xb_add(&bar[XB_TOPGEN], 1u);
            else XB_SPIN(xb_ld(&bar[XB_TOPGEN]) == tg, bar);
            __builtin_amdgcn_fence(__ATOMIC_ACQUIRE, "agent");
            xb_add(&bar[XB_XGEN(b.x)], 1u);
            asm volatile("s_waitcnt vmcnt(0)" ::: "memory");
        } else {
            XB_SPIN(xb_ld(&bar[XB_XGEN(b.x)]) == gen, bar);
            __builtin_amdgcn_fence(__ATOMIC_ACQUIRE, "agent");
            asm volatile("s_waitcnt vmcnt(0)" ::: "memory");
        }
    }
    __syncthreads();
}

typedef __bf16 bf16x2v __attribute__((ext_vector_type(2)));
DI unsigned cvt_pk_bf16(float lo, float hi) { const f32x2 v = {lo, hi}; const bf16x2v b = __builtin_convertvector(v, bf16x2v); return __builtin_bit_cast(unsigned, b); }
DI float bf2f(unsigned short b) { return __uint_as_float((unsigned)b << 16); }
DI float bflo(unsigned w) { return __uint_as_float(w << 16); }
DI float bfhi(unsigned w) { return __uint_as_float(w & 0xffff0000u); }
DI float wave_sum(float v) {
    v += __builtin_bit_cast(float, __builtin_amdgcn_update_dpp(0, __builtin_bit_cast(int, v), 0xB1, 0xF, 0xF, false));
    v += __builtin_bit_cast(float, __builtin_amdgcn_update_dpp(0, __builtin_bit_cast(int, v), 0x4E, 0xF, 0xF, false));
    v += __builtin_bit_cast(float, __builtin_amdgcn_update_dpp(0, __builtin_bit_cast(int, v), 0x141, 0xF, 0xF, false));
    v += __builtin_bit_cast(float, __builtin_amdgcn_update_dpp(0, __builtin_bit_cast(int, v), 0x140, 0xF, 0xF, false));
    { auto r = __builtin_amdgcn_permlane16_swap(__float_as_uint(v), __float_as_uint(v), false, false); v = __uint_as_float(r[0]) + __uint_as_float(r[1]); }
    { auto r = __builtin_amdgcn_permlane32_swap(__float_as_uint(v), __float_as_uint(v), false, false); v = __uint_as_float(r[0]) + __uint_as_float(r[1]); }
    return v;
}
DI float sigmoidf_(float x) { return 1.0f / (1.0f + __expf(-x)); }

namespace pg8 {
constexpr int BM = 256, BK = 64, HALF = 128, HTB = HALF * BK * 2, STAGE_BYTES = 8 * HTB;
__host__ __device__ __forceinline__ int lds_byte(int r, int c) { const int st = (r >> 4) * 2 + (c >> 5), rr = r & 15, cc = c & 31, ob = rr * 64 + cc * 2; return st * 1024 + (ob ^ (((ob >> 9) & 1) << 5)); }
__host__ __device__ __forceinline__ void stage_rc(int b, int& R, int& C) { const int st = b / 1024, sb = b % 1024, swz = sb ^ (((sb >> 9) & 1) << 5); R = (st >> 1) * 16 + swz / 64; C = (st & 1) * 32 + (swz % 64) / 2; }
__host__ __device__ __forceinline__ int perm32(int rho) { const int n = rho >> 4, i = rho & 15; return 8 * (i >> 2) + 4 * n + (i & 3); }

struct Unit { unsigned A, B; int pm, pn, e, aux; };

typedef int v8i32 __attribute__((ext_vector_type(8)));
typedef int v4i32 __attribute__((ext_vector_type(4)));
template <int K, class Epi, class Sched, bool FP8 = false, int SC_W = 127, int SC_A = 127>
__device__ __forceinline__ void gemm_phase(LAS unsigned char* lds, const unsigned char* wsbase, const Sched& S, const Epi& E) {
    const __amdgpu_buffer_rsrc_t rsrc = __builtin_amdgcn_make_buffer_rsrc((void*)wsbase, 0, 0xffffffff, 0x00020000);
    const int tid = threadIdx.x, wid = __builtin_amdgcn_readfirstlane(tid >> 6), lane = tid & 63, wr = wid >> 2, wc = wid & 3, fr = lane & 15, fq = lane >> 4;
    constexpr int nt = K / BK;
    unsigned voffA[2], voffB[2];
#pragma unroll
    for (int i = 0; i < 2; ++i) { int R, C; stage_rc(tid * 16 + i * 8192, R, C); const int Rb = Epi::PERM ? ((R & ~31) + perm32(R & 31)) : R;
        voffA[i] = (unsigned)(R * K + C) * 2u; voffB[i] = (unsigned)(Rb * K + C) * 2u; }
    constexpr unsigned kstep = (unsigned)(BK * 2);
    constexpr unsigned hstep = (unsigned)HALF * K * 2;
    const unsigned ldsw = (unsigned)wid * 1024u;
    const int aoff = lds_byte(wr * 64 + fr, fq * 8), boff = lds_byte(wc * 32 + fr, fq * 8);
#define PG8_SA(b, h) (((b) * 2 + (h)) * HTB)
#define PG8_SB(b, h) ((4 + (b) * 2 + (h)) * HTB)
#define PG8_STAGE(bufoff, gbase, voff) do { _Pragma("unroll") for (int _i = 0; _i < 2; ++_i) \
        __builtin_amdgcn_raw_ptr_buffer_load_lds(rsrc, (LAS void*)(lds + (bufoff) + ldsw + _i * 8192), 16, (int)(voff)[_i], (int)(gbase), 0, 0); } while (0)
#define PG8_CAT2(p0, p1) __builtin_shufflevector(*(const LAS v4i32*)(p0), *(const LAS v4i32*)(p1), 0, 1, 2, 3, 4, 5, 6, 7)
#define PG8_LDA(dst, b, h) do { _Pragma("unroll") for (int m = 0; m < 4; ++m) { if constexpr (FP8) dst##8[m] = PG8_CAT2(lds + PG8_SA(b, h) + aoff + m * 2048, lds + PG8_SA(b, h) + aoff + m * 2048 + 1024); \
        else { _Pragma("unroll") for (int k = 0; k < 2; ++k) dst[m][k] = *(const LAS bf16x8*)(lds + PG8_SA(b, h) + aoff + m * 2048 + k * 1024); } } } while (0)
#define PG8_LDB(dst, b, h) do { _Pragma("unroll") for (int n = 0; n < 2; ++n) { if constexpr (FP8) dst##8[n] = PG8_CAT2(lds + PG8_SB(b, h) + boff + n * 2048, lds + PG8_SB(b, h) + boff + n * 2048 + 1024); \
        else { _Pragma("unroll") for (int k = 0; k < 2; ++k) dst[n][k] = *(const LAS bf16x8*)(lds + PG8_SB(b, h) + boff + n * 2048 + k * 1024); } } } while (0)
#define PG8_CAT(x) __builtin_shufflevector(__builtin_bit_cast(v4i32, (x)[0]), __builtin_bit_cast(v4i32, (x)[1]), 0, 1, 2, 3, 4, 5, 6, 7)
#define PG8_MMA(ai, bj, At, Bt) do { __builtin_amdgcn_s_setprio(1); _Pragma("unroll") for (int m = 0; m < 4; ++m) _Pragma("unroll") for (int n = 0; n < 2; ++n) { \
        if constexpr (FP8) acc[ai][bj][m][n] = __builtin_amdgcn_mfma_scale_f32_16x16x128_f8f6f4(Bt##8[n], At##8[m], acc[ai][bj][m][n], 0, 0, 0, SC_W, 0, SC_A); \
        else { _Pragma("unroll") for (int k = 0; k < 2; ++k) acc[ai][bj][m][n] = __builtin_amdgcn_mfma_f32_16x16x32_bf16(Bt[n][k], At[m][k], acc[ai][bj][m][n], 0, 0, 0); } } \
        __builtin_amdgcn_s_setprio(0); } while (0)
#define PG8_WAIT_V(n) asm volatile("s_waitcnt vmcnt(" #n ")" ::: "memory")
#define PG8_WAIT_L(n) asm volatile("s_waitcnt lgkmcnt(" #n ")" ::: "memory")
#define PG8_BAR __builtin_amdgcn_s_barrier()
#define PG8_SCHED __builtin_amdgcn_sched_barrier(0)
    Unit cur, nxt; int ui = 0;
    if (!S.next(0, cur)) return;
    f32x4 acc[2][2][4][2];
#pragma unroll
    for (int a = 0; a < 2; ++a)
#pragma unroll
        for (int b = 0; b < 2; ++b)
#pragma unroll
            for (int m = 0; m < 4; ++m)
#pragma unroll
                for (int n = 0; n < 2; ++n) acc[a][b][m][n] = (f32x4){0.f, 0.f, 0.f, 0.f};
    bf16x8 At[4][2], B0[2][2], B1[2][2]; v8i32 At8[4], B08[2], B18[2];
    unsigned cA = (unsigned)__builtin_amdgcn_readfirstlane((int)cur.A), cB = (unsigned)__builtin_amdgcn_readfirstlane((int)cur.B);
    PG8_STAGE(PG8_SB(0, 0), cB, voffB); PG8_STAGE(PG8_SB(0, 1), cB + hstep, voffB); PG8_STAGE(PG8_SA(0, 0), cA, voffA); PG8_STAGE(PG8_SA(0, 1), cA + hstep, voffA);
    if (wr == 1) PG8_BAR;
    PG8_WAIT_V(2); PG8_BAR;
    PG8_STAGE(PG8_SB(1, 0), cB + kstep, voffB); PG8_STAGE(PG8_SA(1, 0), cA + kstep, voffA); PG8_STAGE(PG8_SB(1, 1), cB + hstep + kstep, voffB);
    PG8_WAIT_V(6); PG8_BAR;
    for (;;) {
        const bool has_next = S.next(ui + 1, nxt);
        const unsigned nA = has_next ? (unsigned)__builtin_amdgcn_readfirstlane((int)nxt.A) : cA, nB = has_next ? (unsigned)__builtin_amdgcn_readfirstlane((int)nxt.B) : cB;
#pragma unroll 1
        for (int t = 0; t < nt; t += 2) {
            const bool last = (t == nt - 2);
            const unsigned a1 = cA + (unsigned)(t + 1) * kstep;
            const unsigned a2 = last ? nA : cA + (unsigned)(t + 2) * kstep, b2 = last ? nB : cB + (unsigned)(t + 2) * kstep;
            const unsigned a3 = a2 + kstep, b3 = b2 + kstep;
            PG8_LDB(B0, 0, 0); PG8_LDB(B1, 0, 1); PG8_SCHED; PG8_LDA(At, 0, 0); PG8_STAGE(PG8_SA(1, 1), a1 + hstep, voffA);
            PG8_WAIT_V(8); PG8_WAIT_L(0); PG8_BAR; PG8_MMA(0, 0, At, B0); PG8_MMA(0, 1, At, B1); PG8_BAR; PG8_SCHED;
            PG8_LDA(At, 0, 1); PG8_STAGE(PG8_SB(0, 0), b2, voffB); PG8_STAGE(PG8_SB(0, 1), b2 + hstep, voffB); PG8_STAGE(PG8_SA(0, 0), a2, voffA);
            PG8_WAIT_V(8); PG8_WAIT_L(0); PG8_BAR; PG8_MMA(1, 0, At, B0); PG8_MMA(1, 1, At, B1); PG8_BAR; PG8_SCHED;
            PG8_LDB(B0, 1, 0); PG8_LDB(B1, 1, 1); PG8_SCHED; PG8_LDA(At, 1, 0); PG8_STAGE(PG8_SA(0, 1), a2 + hstep, voffA);
            PG8_WAIT_V(8); PG8_WAIT_L(0); PG8_BAR; PG8_MMA(0, 0, At, B0); PG8_MMA(0, 1, At, B1); PG8_BAR; PG8_SCHED;
            PG8_LDA(At, 1, 1); PG8_STAGE(PG8_SB(1, 0), b3, voffB); PG8_STAGE(PG8_SB(1, 1), b3 + hstep, voffB); PG8_STAGE(PG8_SA(1, 0), a3, voffA);
            PG8_WAIT_V(8); PG8_WAIT_L(0); PG8_BAR; PG8_MMA(1, 0, At, B0); PG8_MMA(1, 1, At, B1); PG8_BAR; PG8_SCHED;
        }
        if (wr == 0) PG8_BAR;
        int tl_ = threadIdx.x; asm volatile("" : "+v"(tl_));
        const bool keep = E(acc, cur, wr, wc, tl_ & 15, (tl_ & 63) >> 4);
        if (!has_next) break;
        if (!keep) {
#pragma unroll
        for (int a = 0; a < 2; ++a)
#pragma unroll
            for (int b = 0; b < 2; ++b)
#pragma unroll
                for (int m = 0; m < 4; ++m)
#pragma unroll
                    for (int n = 0; n < 2; ++n) acc[a][b][m][n] = (f32x4){0.f, 0.f, 0.f, 0.f};
        }
        cur = nxt; cA = nA; cB = nB; ++ui;
        if (wr == 1) PG8_BAR;
    }
    PG8_WAIT_V(0);
    PG8_BAR;
#undef PG8_SA
#undef PG8_SB
#undef PG8_STAGE
#undef PG8_LDA
#undef PG8_LDB
#undef PG8_MMA
#undef PG8_CAT
#undef PG8_CAT2
#undef PG8_WAIT_V
#undef PG8_WAIT_L
#undef PG8_BAR
#undef PG8_SCHED
}

struct TileOrder {
    int nM, nN, nwg, G, c;
    DI void init(int nM_, int nN_, int G_, int c_) { nM = nM_; nN = nN_; nwg = nM * nN; G = G_; c = c_; }
    DI bool tile(int i, int& pm, int& pn) const {
        const long L = (long)i * G + c; if (L >= nwg) return false;
        int wgid = (int)L; { const int q = nwg / 8, r = nwg % 8, xcd = wgid % 8, off = wgid / 8; wgid = (xcd < r ? xcd * (q + 1) : r * (q + 1) + (xcd - r) * q) + off; }
        const int nig = 8 * nN, gid = wgid / nig, fm = gid * 8, gsz = (nM - fm) < 8 ? (nM - fm) : 8;
        pm = fm + ((wgid % nig) % gsz); pn = (wgid % nig) / gsz; return true;
    }
};
}

typedef const __attribute__((address_space(4))) Params* KParams;
struct Frame {
    KParams kp; unsigned char* ws; LAS unsigned char* lds; int tid, wave, lane, G, wg;
    template <class Tp> DI Tp* at(size_t off) const { return (Tp*)(ws + off); }
};

DI void p0_modpart(const Frame& F, int item) {
    const int ks = item / 6, jt = item % 6;
    LAS float* sl = (LAS float*)F.lds;
    __syncthreads();
    if (F.tid < 256) { const int b = F.tid >> 6, k = F.tid & 63; const float cv = F.kp->in[I_C][b * DM + ks * 64 + k]; sl[F.tid] = cv / (1.0f + __expf(-cv)); }
    __syncthreads();
    const int j0 = jt * 2048 + F.tid * 4;
    const float* w = F.kp->in[I_WADA] + (size_t)(ks * 64) * 12288 + j0;
    f32x4 a0 = {0, 0, 0, 0}, a1 = a0, a2 = a0, a3 = a0;
#pragma unroll 8
    for (int k = 0; k < 64; ++k) { const f32x4 v = *(const f32x4*)(w + (size_t)k * 12288);
        a0 += v * sl[k]; a1 += v * sl[64 + k]; a2 += v * sl[128 + k]; a3 += v * sl[192 + k]; }
    float* o = F.at<float>(WS_MODP) + (size_t)ks * 4 * 12288 + j0;
    *(f32x4*)(o) = a0; *(f32x4*)(o + 12288) = a1; *(f32x4*)(o + 2 * 12288) = a2; *(f32x4*)(o + 3 * 12288) = a3;
}
DI void p0_cvt_tile(const Frame& F, const float* __restrict__ src, bf16_t* __restrict__ dst, int K, int Nsrc, int kt, int ntile) {
    LAS float* tl = (LAS float*)F.lds;
    __syncthreads();
    const int k0 = kt * 64, n0 = ntile * 128;
    {
        const int c4 = (F.tid & 31) * 4, r0 = F.tid >> 5;
#pragma unroll
        for (int i = 0; i < 4; ++i) { const int r = r0 + 16 * i; f32x4 v = {0, 0, 0, 0};
            if (n0 + c4 < Nsrc) v = *(const f32x4*)(src + (size_t)(k0 + r) * Nsrc + n0 + c4);
            tl[r * 129 + c4] = v[0]; tl[r * 129 + c4 + 1] = v[1]; tl[r * 129 + c4 + 2] = v[2]; tl[r * 129 + c4 + 3] = v[3]; }
    }
    __syncthreads();
    {
        const int kc = F.tid & 7;
#pragma unroll
        for (int i = 0; i < 2; ++i) { const int n = (F.tid >> 3) + 64 * i;
            float v[8];
#pragma unroll
            for (int j = 0; j < 8; ++j) v[j] = tl[(kc * 8 + j) * 129 + n];
            u32x4 w = {cvt_pk_bf16(v[0], v[1]), cvt_pk_bf16(v[2], v[3]), cvt_pk_bf16(v[4], v[5]), cvt_pk_bf16(v[6], v[7])};
            *(u32x4*)(dst + (size_t)(n0 + n) * K + k0 + kc * 8) = w; }
    }
}
DI unsigned pk_fp8x4(float a, float b, float c, float d) { int w = 0; w = __builtin_amdgcn_cvt_pk_fp8_f32(a, b, w, false); w = __builtin_amdgcn_cvt_pk_fp8_f32(c, d, w, true); return (unsigned)w; }
DI float clamp448(float x) { return __builtin_amdgcn_fmed3f(x, -448.f, 448.f); }
DI void p0_cvt_tile_fp8(const Frame& F, const float* __restrict__ src, unsigned char* __restrict__ dst, int K, int N, int kt, int ntile) {
    LAS float* tl = (LAS float*)F.lds;
    __syncthreads();
    const int k0 = kt * 128, n0 = ntile * 128;
    {
        const int c4 = (F.tid & 31) * 4, r0 = F.tid >> 5;
#pragma unroll
        for (int i = 0; i < 8; ++i) { const int r = r0 + 16 * i; const f32x4 v = *(const f32x4*)(src + (size_t)(k0 + r) * N + n0 + c4);
            tl[r * 129 + c4] = v[0]; tl[r * 129 + c4 + 1] = v[1]; tl[r * 129 + c4 + 2] = v[2]; tl[r * 129 + c4 + 3] = v[3]; }
    }
    __syncthreads();
    {
        const int n = F.tid & 127, kc = F.tid >> 7;
        unsigned w[8];
#pragma unroll
        for (int j = 0; j < 8; ++j) { const LAS float* p = tl + (kc * 32 + j * 4) * 129 + n;
            w[j] = pk_fp8x4(clamp448(p[0] * 32.f), clamp448(p[129] * 32.f), clamp448(p[258] * 32.f), clamp448(p[387] * 32.f)); }
        unsigned char* o = dst + (size_t)(n0 + n) * K + k0 + kc * 32;
        *(u32x4*)o = (u32x4){w[0], w[1], w[2], w[3]}; *(u32x4*)(o + 16) = (u32x4){w[4], w[5], w[6], w[7]};
    }
}
constexpr int CV_NB = (INB - NF8) / 128, CV_NF = NF8 / 128, CV_N0 = 32 * CV_NB + 16 * CV_NF + 16 * 32, CV_N1 = 8 * 16, CV_N2 = 8 * 16, CV_N3 = 16 * 16, CV_N4 = 0, CV_N5 = 0;
constexpr int CV_S1 = CV_N0, CV_S2 = CV_S1 + CV_N1, CV_S3 = CV_S2 + CV_N2, CV_S4 = CV_S3 + CV_N3, CV_S5 = CV_S4 + CV_N4, CV_TOT = CV_S5 + CV_N5;
DI void p0_prologue(const Frame& F) {
    for (int it = F.wg; it < 192; it += F.G) p0_modpart(F, it);
    for (int i = F.wg * NTHR + F.tid; i < NE * DM; i += F.G * NTHR) { const int e = i / DM, k = i % DM; const float v = F.kp->in[I_WR][(size_t)k * NE + e];
        const unsigned hi = cvt_pk_bf16(v, 0.f) & 0xffffu; const float r = v - __uint_as_float(hi << 16);
        F.at<bf16_t>(WS_WRT)[i] = (bf16_t)hi; F.at<bf16_t>(WS_WRT)[NE * DM + i] = (bf16_t)(cvt_pk_bf16(r, 0.f) & 0xffffu); }
    for (int it = F.wg; it < CV_TOT; it += F.G) {
        int j = it;
        Frame F2 = F; { KParams kq_ = F.kp; asm volatile("" : "+s"(kq_)); F2.kp = kq_; }
        if (j < 32 * CV_NB) { p0_cvt_tile(F, F2.kp->in[I_WIN] + NF8, F.at<bf16_t>(WS_WINT), 2048, INW, j / CV_NB, j % CV_NB); continue; }
        if (j < 32 * CV_NB + 16 * CV_NF) { const int r = j - 32 * CV_NB; p0_cvt_tile_fp8(F, F2.kp->in[I_WIN], F.at<unsigned char>(WS_WING8), 2048, INW, r / CV_NF, r % CV_NF); continue; }
        if (j < CV_N0) { const int r = j - 32 * CV_NB - 16 * CV_NF; p0_cvt_tile_fp8(F, F2.kp->in[I_WIN] + C_GA, F.at<unsigned char>(WS_WING8) + (size_t)NF8 * DM, 2048, INW, r / 32, r % 32); continue; }
        j -= CV_N0;
        if (j < CV_N1) { p0_cvt_tile_fp8(F, F2.kp->in[I_WA], F.at<unsigned char>(WS_WAT), 1024, 2048, j / 16, j % 16); continue; }
        j -= CV_N1;
        if (j < CV_N2) { p0_cvt_tile_fp8(F, F2.kp->in[I_WB], F.at<unsigned char>(WS_WBT), 1024, 2048, j / 16, j % 16); continue; }
        j -= CV_N2;
        p0_cvt_tile_fp8(F, F2.kp->in[I_WOUT], F.at<unsigned char>(WS_WOT), 2048, 2048, j / 16, j % 16);
    }
}

DI float mod_sum(const Frame& F, int b, int j) {
    const float* mp = F.at<float>(WS_MODP) + (size_t)b * 12288 + j; float s = F.kp->in[I_BADA][j]; float v[32];
#pragma unroll
    for (int ks = 0; ks < 32; ++ks) v[ks] = mp[(size_t)ks * 4 * 12288];
#pragma unroll
    for (int ks = 0; ks < 32; ++ks) s += v[ks];
    return s;
}
DI void p1_norm(const Frame& F) {
    LAS float* sA = (LAS float*)F.lds; LAS float* sB = sA + DM;
    for (int o = F.wg * NTHR + F.tid; o < 4 * 12288; o += F.G * NTHR) F.at<float>(WS_MOD)[o] = mod_sum(F, o / 12288, o % 12288);
    for (int blk = F.wg; blk < T / 128; blk += F.G) {
        const int b = blk / 64;
        __syncthreads();
        {
            const int col = F.tid * 4; const float* mp = F.at<float>(WS_MODP) + (size_t)b * 12288 + col;
            f32x4 a1 = *(const f32x4*)(F.kp->in[I_BADA] + 2048 + col), a0 = *(const f32x4*)(F.kp->in[I_BADA] + col);
#pragma unroll 8
            for (int ks = 0; ks < 32; ++ks) { a1 += *(const f32x4*)(mp + (size_t)ks * 4 * 12288 + 2048); a0 += *(const f32x4*)(mp + (size_t)ks * 4 * 12288); }
            const f32x4 g = *(const f32x4*)(F.kp->in[I_GPREMIX] + col);
#pragma unroll
            for (int i = 0; i < 4; ++i) { sA[col + i] = g[i] * (1.0f + a1[i]); sB[col + i] = a0[i]; }
        }
        __syncthreads();
        const size_t rowb = (size_t)blk * 128 + F.wave * 16;
        f32x4 v[8], vn[8];
        { const float* xr = F.kp->in[I_X] + rowb * DM + F.lane * 4;
#pragma unroll
          for (int q = 0; q < 8; ++q) v[q] = *(const f32x4*)(xr + q * 256); }
        for (int i = 0; i < 16; ++i) {
            const size_t row = rowb + i;
            if (i + 1 < 16) { const float* xr = F.kp->in[I_X] + (row + 1) * DM + F.lane * 4;
#pragma unroll
                for (int q = 0; q < 8; ++q) vn[q] = *(const f32x4*)(xr + q * 256); }
            float ss = 0.f;
#pragma unroll
            for (int q = 0; q < 8; ++q) ss += v[q][0] * v[q][0] + v[q][1] * v[q][1] + v[q][2] * v[q][2] + v[q][3] * v[q][3];
            ss = wave_sum(ss);
            const float rstd = rsqrtf(ss * (1.0f / DM) + RMS_EPS);
            bf16_t* hr = F.at<bf16_t>(WS_H) + row * DM + F.lane * 4;
#pragma unroll
            for (int q = 0; q < 8; ++q) { const int col = q * 256 + F.lane * 4;
                const float o0 = v[q][0] * rstd * sA[col] + sB[col], o1 = v[q][1] * rstd * sA[col + 1] + sB[col + 1], o2 = v[q][2] * rstd * sA[col + 2] + sB[col + 2], o3 = v[q][3] * rstd * sA[col + 3] + sB[col + 3];
                u32x2 w = {cvt_pk_bf16(o0, o1), cvt_pk_bf16(o2, o3)}; *(u32x2*)(hr + q * 256) = w;
                *(unsigned*)(F.at<unsigned char>(WS_H8) + row * DM + col) = pk_fp8x4(clamp448(o0), clamp448(o1), clamp448(o2), clamp448(o3)); }
#pragma unroll
            for (int q = 0; q < 8; ++q) v[q] = vn[q];
        }
    }
}

struct EpiStoreBf16 {
    static constexpr bool PERM = true;
    bf16_t* O; int ldc; int colmax;
    DI bool operator()(const f32x4 (&acc)[2][2][4][2], const pg8::Unit& u, int wr, int wc, int fr, int fq) const {
        const int row0 = u.pm * 256 + wr * 64 + fr, col0 = u.pn * 256 + wc * 32 + 8 * fq;
#pragma unroll
        for (int ai = 0; ai < 2; ++ai)
#pragma unroll
            for (int m = 0; m < 4; ++m) { bf16_t* rowp = O + (size_t)(row0 + ai * 128 + m * 16) * ldc + col0;
#pragma unroll
                for (int bj = 0; bj < 2; ++bj) { const f32x4 v0 = acc[ai][bj][m][0], v1 = acc[ai][bj][m][1];
                    u32x4 w; w.x = cvt_pk_bf16(v0[0], v0[1]); w.y = cvt_pk_bf16(v0[2], v0[3]); w.z = cvt_pk_bf16(v1[0], v1[1]); w.w = cvt_pk_bf16(v1[2], v1[3]);
                    if (col0 + bj * 128 < colmax) *(u32x4*)(rowp + bj * 128) = w; } }
        return false;
    }
};
template <int SCALE> struct EpiStoreFp8 {
    static constexpr bool PERM = true;
    unsigned char* O; int ldc;
    DI bool operator()(const f32x4 (&acc)[2][2][4][2], const pg8::Unit& u, int wr, int wc, int fr, int fq) const {
        const int row0 = u.pm * 256 + wr * 64 + fr, col0 = u.pn * 256 + wc * 32 + 8 * fq;
#pragma unroll
        for (int ai = 0; ai < 2; ++ai)
#pragma unroll
            for (int m = 0; m < 4; ++m) { unsigned char* rowp = O + (size_t)(row0 + ai * 128 + m * 16) * ldc + col0;
#pragma unroll
                for (int bj = 0; bj < 2; ++bj) { const f32x4 v0 = acc[ai][bj][m][0] * (float)SCALE, v1 = acc[ai][bj][m][1] * (float)SCALE;
                    u32x2 w; w.x = pk_fp8x4(clamp448(v0[0]), clamp448(v0[1]), clamp448(v0[2]), clamp448(v0[3])); w.y = pk_fp8x4(clamp448(v1[0]), clamp448(v1[1]), clamp448(v1[2]), clamp448(v1[3]));
                    *(u32x2*)(rowp + bj * 128) = w; } }
        return false;
    }
};
struct EpiInFp8 {
    static constexpr bool PERM = true;
    bf16_t* Z; unsigned char* GZ;
    DI bool operator()(const f32x4 (&acc)[2][2][4][2], const pg8::Unit& u, int wr, int wc, int fr, int fq) const {
        const int row0 = u.pm * 256 + wr * 64 + fr, colt = wc * 32 + 8 * fq;
        if (u.pn < NF8 / 256) {
#pragma unroll
            for (int ai = 0; ai < 2; ++ai)
#pragma unroll
                for (int m = 0; m < 4; ++m) { bf16_t* rowp = Z + (size_t)(row0 + ai * 128 + m * 16) * INWP + u.pn * 256 + colt;
#pragma unroll
                    for (int bj = 0; bj < 2; ++bj) { const f32x4 v0 = acc[ai][bj][m][0], v1 = acc[ai][bj][m][1];
                        u32x4 w; w.x = cvt_pk_bf16(v0[0], v0[1]); w.y = cvt_pk_bf16(v0[2], v0[3]); w.z = cvt_pk_bf16(v1[0], v1[1]); w.w = cvt_pk_bf16(v1[2], v1[3]);
                        *(u32x4*)(rowp + bj * 128) = w; } }
        } else {
#pragma unroll
            for (int ai = 0; ai < 2; ++ai)
#pragma unroll
                for (int m = 0; m < 4; ++m) { unsigned char* rowp = GZ + (size_t)(row0 + ai * 128 + m * 16) * 4096 + (u.pn - NF8 / 256) * 256 + colt;
#pragma unroll
                    for (int bj = 0; bj < 2; ++bj) { const f32x4 v0 = acc[ai][bj][m][0] * 16.f, v1 = acc[ai][bj][m][1] * 16.f;
                        u32x2 w; w.x = pk_fp8x4(clamp448(v0[0]), clamp448(v0[1]), clamp448(v0[2]), clamp448(v0[3])); w.y = pk_fp8x4(clamp448(v1[0]), clamp448(v1[1]), clamp448(v1[2]), clamp448(v1[3]));
                        *(u32x2*)(rowp + bj * 128) = w; } }
        }
        return false;
    }
};
template <int K> struct DenseSched {
    pg8::TileOrder ord; unsigned A, Bt;
    DI bool next(int i, pg8::Unit& u) const { int pm, pn; if (!ord.tile(i, pm, pn)) return false;
        u.pm = pm; u.pn = pn; u.e = 0; u.aux = 0; u.A = A + (unsigned)pm * 256u * K * 2u; u.B = Bt + (unsigned)pn * 256u * K * 2u; return true; }
};

DI void p3_rope(const Frame& F) {
    LAS float* cs = (LAS float*)F.lds;
    bf16_t* z = F.at<bf16_t>(WS_Z); bf16_t* kidx = F.at<bf16_t>(WS_KIDX); float* wif = F.at<float>(WS_WIF);
    bf16_t* kbF = F.at<bf16_t>(WS_KBF); bf16_t* vbF = F.at<bf16_t>(WS_VBF);
    const int* pos = (const int*)F.kp->in[I_POS];
    for (int item = F.wg; item < T / 32; item += F.G) {
        const int b = item >> 8, blk = item & 255, s0 = blk * 32; const size_t row0 = (size_t)b * SEQ + s0;
        __syncthreads();
        for (int e = F.tid; e < 32 * 24; e += NTHR) { const int tok = e / 24, a = e % 24;
            const float ex = a < 16 ? -(float)a * (1.0f / 16.0f) : -(float)(a - 16) * (1.0f / 8.0f);
            const float inv = __builtin_powf(500000.0f, ex);
            const float ang = (float)pos[row0 + tok] * inv;
            const double ad = (double)ang; const double kq = __builtin_rint(ad * 0.15915494309189535); const float r = (float)(ad - kq * 6.283185307179586);
            cs[e * 2] = __cosf(r); cs[e * 2 + 1] = __sinf(r); }
        __syncthreads();
        {
            const int tok = F.tid >> 4, u = F.tid & 15, u7 = u & 7; bf16_t* zr = z + (row0 + tok) * INWP;
            const float c16 = cs[(tok * 24 + u) * 2], s16 = cs[(tok * 24 + u) * 2 + 1], c8 = cs[(tok * 24 + 16 + u7) * 2], s8 = cs[(tok * 24 + 16 + u7) * 2 + 1];
            float x1[19], x2[19];
#pragma unroll
            for (int it = 0; it < 19; ++it) { const int c1 = it < 8 ? C_QA + it * 128 + u : it < 10 ? C_KA + (it - 8) * 128 + u : it < 18 ? C_QI + (2 * (it - 10) + (u >> 3)) * 64 + u7 : C_KI + u7;
                const int dist = it < 10 ? 16 : 8; x1[it] = bf2f(zr[c1]); x2[it] = bf2f(zr[c1 + dist]); }
#pragma unroll
            for (int it = 0; it < 18; ++it) { const int c1 = it < 8 ? C_QA + it * 128 + u : it < 10 ? C_KA + (it - 8) * 128 + u : C_QI + (2 * (it - 10) + (u >> 3)) * 64 + u7;
                const int dist = it < 10 ? 16 : 8; const float cc = it < 10 ? c16 : c8, sn = it < 10 ? s16 : s8;
                zr[c1] = (bf16_t)(cvt_pk_bf16(x1[it] * cc - x2[it] * sn, 0.f) & 0xffffu); zr[c1 + dist] = (bf16_t)(cvt_pk_bf16(x2[it] * cc + x1[it] * sn, 0.f) & 0xffffu); }
            if (u < 8) { bf16_t* kd = kidx + (row0 + tok) * 64; kd[u7] = (bf16_t)(cvt_pk_bf16(x1[18] * c8 - x2[18] * s8, 0.f) & 0xffffu); kd[u7 + 8] = (bf16_t)(cvt_pk_bf16(x2[18] * c8 + x1[18] * s8, 0.f) & 0xffffu); }
        }
        {
            unsigned short v[4];
#pragma unroll
            for (int it = 0; it < 4; ++it) { const int j = F.tid + it * NTHR, tok = j >> 6, q = j & 63; const bf16_t* zr = z + (row0 + tok) * INWP; v[it] = q < 48 ? zr[C_KI + 16 + q] : zr[C_WI + q - 48]; }
#pragma unroll
            for (int it = 0; it < 4; ++it) { const int j = F.tid + it * NTHR, tok = j >> 6, q = j & 63;
                if (q < 48) kidx[(row0 + tok) * 64 + 16 + q] = v[it]; else wif[(row0 + tok) * 16 + (q - 48)] = bf2f(v[it]); }
        }
        {
            u32x4 v[8];
#pragma unroll
            for (int i = 0; i < 8; ++i) { const int id = F.tid + NTHR * i, l = id & 63, kk = (id >> 6) & 7, h = id >> 9; v[i] = *(const u32x4*)(z + (row0 + (l & 31)) * INWP + C_KB + h * 128 + kk * 16 + (l >> 5) * 8); }
#pragma unroll
            for (int i = 0; i < 8; ++i) { const int id = F.tid + NTHR * i, l = id & 63, kk = (id >> 6) & 7, h = id >> 9; *(u32x4*)(kbF + ((((size_t)(b * 8 + h) * 256 + blk) * 8 + kk) * 64 + l) * 8) = v[i]; }
        }
#pragma unroll
        for (int i0 = 0; i0 < 8; i0 += 4) {
            unsigned short e[4][8];
#pragma unroll
            for (int i = 0; i < 4; ++i) { const int id = F.tid + NTHR * (i0 + i), l = id & 63, sb = (id >> 6) & 1, db = (id >> 7) & 3, h = id >> 9;
                const bf16_t* vp = z + (row0 + 16 * sb + 4 * (l >> 5)) * INWP + C_VB + h * 128 + 32 * db + (l & 31);
#pragma unroll
                for (int j = 0; j < 8; ++j) e[i][j] = vp[(size_t)(8 * (j >> 2) + (j & 3)) * INWP]; }
#pragma unroll
            for (int i = 0; i < 4; ++i) { const int id = F.tid + NTHR * (i0 + i), l = id & 63, sb = (id >> 6) & 1, db = (id >> 7) & 3, h = id >> 9;
                u32x4 w = {(unsigned)e[i][0] | ((unsigned)e[i][1] << 16), (unsigned)e[i][2] | ((unsigned)e[i][3] << 16), (unsigned)e[i][4] | ((unsigned)e[i][5] << 16), (unsigned)e[i][6] | ((unsigned)e[i][7] << 16)};
                *(u32x4*)(vbF + (((((size_t)(b * 8 + h) * 256 + blk) * 4 + db) * 2 + sb) * 64 + l) * 8) = w; }
        }
    }
}

#define MFMA32(a, b, c) __builtin_amdgcn_mfma_f32_32x32x16_bf16((a), (b), (c), 0, 0, 0)
DI void idx_chunk(const Frame& F, int b, int c) {
    const int l = F.lane, m = l & 31, hi = l >> 5, q = (m >> 2) & 1, head = ((m >> 3) << 2) | (m & 3);
    const int t0 = 64 * c + 8 * F.wave;
    const bf16_t* z = F.at<bf16_t>(WS_Z); const float* wif = F.at<float>(WS_WIF);
    LAS char* kl = (LAS char*)F.lds;
    bf16x8 Aq[4][4]; f32x4 wv[4][4];
#pragma unroll
    for (int p = 0; p < 4; ++p) { const bf16_t* qp = z + ((size_t)b * SEQ + t0 + 2 * p + q) * INWP + C_QI + head * 64 + hi * 8;
#pragma unroll
        for (int kk = 0; kk < 4; ++kk) Aq[p][kk] = *(const bf16x8*)(qp + kk * 16);
        const float* wp = wif + ((size_t)b * SEQ + t0 + 2 * p + hi) * 16;
#pragma unroll
        for (int r4 = 0; r4 < 4; ++r4) wv[p][r4] = *(const f32x4*)(wp + 4 * r4); }
    const int ntile = c + 1, L = 64 * (c + 1);
    const int skey = F.tid >> 3, sch = F.tid & 7;
    const bf16_t* kg = F.at<bf16_t>(WS_KIDX) + ((size_t)b * SEQ + skey) * 64 + sch * 8;
    const int swr = skey * 128 + ((sch ^ (skey & 7)) << 4);
    float* scb = F.at<float>(WS_SC) + (size_t)b * SC_PER_B + (size_t)2048 * c * (c + 1) + (size_t)(8 * F.wave + hi) * L + m;
    __syncthreads();
    u32x4 st = *(const u32x4*)kg;
    *(LAS u32x4*)(kl + swr) = st;
    if (ntile > 1) st = *(const u32x4*)(kg + (size_t)64 * 64);
    __syncthreads();
    for (int tl = 0; tl < ntile; ++tl) {
        LAS const char* kb = kl + (tl & 1) * 8192;
#pragma unroll
        for (int hb = 0; hb < 2; ++hb) {
            bf16x8 Bk[4];
            const int key = hb * 32 + m;
#pragma unroll
            for (int kk = 0; kk < 4; ++kk) Bk[kk] = *(LAS const bf16x8*)(kb + key * 128 + (((kk * 2 + hi) ^ (key & 7)) << 4));
#pragma unroll
            for (int p = 0; p < 4; ++p) {
                f32x16 acc = {};
#pragma unroll
                for (int kk = 0; kk < 4; ++kk) acc = MFMA32(Aq[p][kk], Bk[kk], acc);
                float sc_ = 0.f;
#pragma unroll
                for (int r = 0; r < 16; ++r) sc_ = fmaf(__int_as_float(max(__float_as_int(acc[r]), 0)), wv[p][r >> 2][r & 3], sc_);
                scb[(size_t)(2 * p) * L + tl * 64 + hb * 32] = sc_;
                if (p & 1) __builtin_amdgcn_sched_barrier(0);
            }
        }
        if (tl + 1 < ntile) {
            *(LAS u32x4*)(kl + ((tl + 1) & 1) * 8192 + swr) = st;
            if (tl + 2 < ntile) st = *(const u32x4*)(kg + (size_t)(tl + 2) * 64 * 64);
        }
        __syncthreads();
    }
}
DI void p4_indexer(const Frame& F) {
    for (int item = F.wg; item < 256; item += F.G) { const int b = item >> 6, pi = item & 63; idx_chunk(F, b, pi); idx_chunk(F, b, 127 - pi); }
}

DI unsigned f2key(float f) { const unsigned u = __float_as_uint(f); return u ^ ((unsigned)((int)u >> 31) | 0x80000000u); }
DI unsigned umed3(unsigned a, unsigned b, unsigned c) { const unsigned mx = a > b ? a : b, mn = a > b ? b : a; const unsigned t = mx < c ? mx : c; return mn > t ? mn : t; }
DI int wave_allsum(int v) {
    v += __builtin_amdgcn_update_dpp(0, v, 0xB1, 0xF, 0xF, false);
    v += __builtin_amdgcn_update_dpp(0, v, 0x4E, 0xF, 0xF, false);
    v += __builtin_amdgcn_update_dpp(0, v, 0x141, 0xF, 0xF, false);
    v += __builtin_amdgcn_update_dpp(0, v, 0x140, 0xF, 0xF, false);
    { auto r = __builtin_amdgcn_permlane16_swap((unsigned)v, (unsigned)v, false, false); v = (int)(r[0] + r[1]); }
    { auto r = __builtin_amdgcn_permlane32_swap((unsigned)v, (unsigned)v, false, false); v = (int)(r[0] + r[1]); }
    return v;
}
template <int NBITS> DI int wave_total(int pl) { int tot = 0;
#pragma unroll
    for (int b = 0; b < NBITS; ++b) tot += __popcll(__ballot((pl >> b) & 1)) << b;
    return tot; }
constexpr int NCVW = 2, NPW = NWAVES - NCVW;
constexpr int CVJ1 = NE * 32 * 64, CVJ2 = NE * 32 * 32, CVJ = CVJ1 + CVJ2;
struct CvJob { const float* src; unsigned char* dst; int N; };
DI CvJob cv_job(const Frame& F, int job) {
    CvJob J;
    if (job < CVJ1) { const int e = job >> 11, r = job & 2047, kt = r >> 6, nt = r & 63; J.N = 4096;
        J.src = F.kp->in[I_W1] + (size_t)e * 2048 * 4096 + (size_t)(kt * 64) * 4096 + nt * 64; J.dst = F.at<unsigned char>(WS_W1T) + (size_t)e * 4096 * 2048 + (size_t)(nt * 64) * 2048 + kt * 64; }
    else { const int j2 = job - CVJ1, e = j2 >> 10, r = j2 & 1023, kt = r >> 5, nt = r & 31; J.N = 2048;
        J.src = F.kp->in[I_W2] + (size_t)e * 2048 * 2048 + (size_t)(kt * 64) * 2048 + nt * 64; J.dst = F.at<unsigned char>(WS_W2T) + (size_t)e * 2048 * 2048 + (size_t)(nt * 64) * 2048 + kt * 64; }
    return J;
}
DI void cv_load(const CvJob& J, int l, f32x4 (&v)[16]) {
    const float* p = J.src + (size_t)((l >> 4) * 8) * J.N + (l & 15) * 4;
#pragma unroll
    for (int h = 0; h < 2; ++h)
#pragma unroll
        for (int i = 0; i < 8; ++i) v[h * 8 + i] = *(const f32x4*)(p + (size_t)(h * 32 + i) * J.N);
}
DI void cv_finish(const CvJob& J, int l, const f32x4 (&v)[16], LAS unsigned char* Tl) {
    const int c4 = (l & 15) * 4, g = l >> 4;
#pragma unroll
    for (int h = 0; h < 2; ++h)
#pragma unroll
        for (int q = 0; q < 2; ++q)
#pragma unroll
            for (int j = 0; j < 4; ++j)
                *(LAS unsigned*)(Tl + (c4 + j) * 80 + h * 32 + g * 8 + q * 4) = pk_fp8x4(clamp448(v[h * 8 + q * 4][j] * 32.f), clamp448(v[h * 8 + q * 4 + 1][j] * 32.f), clamp448(v[h * 8 + q * 4 + 2][j] * 32.f), clamp448(v[h * 8 + q * 4 + 3][j] * 32.f));
    u32x4 o[4];
#pragma unroll
    for (int p = 0; p < 4; ++p) o[p] = *(LAS const u32x4*)(Tl + ((l >> 2) + 16 * p) * 80 + (l & 3) * 16);
#pragma unroll
    for (int p = 0; p < 4; ++p) *(u32x4*)(J.dst + (size_t)((l >> 2) + 16 * p) * 2048 + (l & 3) * 16) = o[p];
}
DI void cv_stream(const Frame& F) {
    const int cw = F.wg * NCVW + (F.wave - NPW), ncw = F.G * NCVW, l = F.lane;
    LAS unsigned char* Tl = F.lds + 8192 + F.wave * 16640;
#pragma unroll 1
    for (int job = cw; job < CVJ; job += 6 * ncw) {
        f32x4 va[16], vb[16], vc[16];
        const int j1 = job + ncw, j2 = job + 2 * ncw, j3 = job + 3 * ncw, j4 = job + 4 * ncw, j5 = job + 5 * ncw;
        const CvJob J0 = cv_job(F, job), J1 = cv_job(F, j1 < CVJ ? j1 : job), J2 = cv_job(F, j2 < CVJ ? j2 : job);
#define CV_SB __builtin_amdgcn_sched_barrier(0)
        cv_load(J0, l, va); CV_SB; cv_load(J1, l, vb); CV_SB; cv_load(J2, l, vc); CV_SB;
        cv_finish(J0, l, va, Tl); CV_SB;
        const CvJob J3 = cv_job(F, j3 < CVJ ? j3 : job); cv_load(J3, l, va); CV_SB;
        if (j1 < CVJ) cv_finish(J1, l, vb, Tl);
        CV_SB;
        const CvJob J4 = cv_job(F, j4 < CVJ ? j4 : job); cv_load(J4, l, vb); CV_SB;
        if (j2 < CVJ) cv_finish(J2, l, vc, Tl);
        CV_SB;
        const CvJob J5 = cv_job(F, j5 < CVJ ? j5 : job); cv_load(J5, l, vc); CV_SB;
        if (j3 < CVJ) cv_finish(J3, l, va, Tl);
        CV_SB;
        if (j4 < CVJ) cv_finish(J4, l, vb, Tl);
        CV_SB;
        if (j5 < CVJ) cv_finish(J5, l, vc, Tl);
#undef CV_SB
    }
}
DI int p56_grab(LAS int* ctr, int lane) { int j = 0; if (lane == 0) j = __hip_atomic_fetch_add(ctr, 1, __ATOMIC_RELAXED, __HIP_MEMORY_SCOPE_WORKGROUP); return __builtin_amdgcn_readfirstlane(j); }
constexpr int P56_CTR = LDS_BYTES - 64;
DI void p5_select(const Frame& F) {
    { LAS int* ctr0 = (LAS int*)(F.lds + P56_CTR); if (F.tid < 2) ctr0[F.tid] = 0; __syncthreads(); }
    if (F.wave >= NPW) cv_stream(F);
    unsigned long long* sel = F.at<unsigned long long>(WS_SEL); const float* sc = F.at<float>(WS_SC);
    const int lane = F.lane;
    LAS int* ctr = (LAS int*)(F.lds + P56_CTR);
    LAS unsigned long long* wsl = (LAS unsigned long long*)(F.lds + F.wave * 1024);
    LAS unsigned* cl = (LAS unsigned*)(F.lds + 8192 + F.wave * 16640);
    for (;;) {
        const int row = p56_grab(ctr, lane) * F.G + F.wg; if (row >= T) break;
        const int b = row >> 13, t = row & 8191, c = t >> 6;
        if (c < 4) { if (lane <= c) sel[(size_t)row * 128 + lane] = ~0ull; continue; }
        const float* rowp = sc + (size_t)b * SC_PER_B + (size_t)2048 * c * (c + 1) + (size_t)(t & 63) * 64 * (c + 1);
        unsigned k[128];
        {
            float kf[128];
#pragma unroll
            for (int g = 0; g < 8; ++g) { const float* rg_ = rowp + ((g * 16 <= c) ? g * 1024 : 0);
#pragma unroll
                for (int i = 0; i < 16; ++i) kf[g * 16 + i] = rg_[(unsigned)(i * 64 + lane)]; }
#pragma unroll
            for (int i = 0; i < 128; ++i) k[i] = (i <= c) ? f2key(kf[i]) : 0u;
        }
        unsigned ta = 0u, tb = 0u, tc = 0u, td = 0u;
#pragma unroll
        for (int g = 0; g < 4; ++g) { if (g * 32 <= c) {
#pragma unroll
            for (int i = g * 32; i < g * 32 + 32; ++i) { const unsigned x = k[i]; const unsigned nd = umed3(tc, td, x), nc = umed3(tb, tc, x), nb = umed3(ta, tb, x); ta = ta > x ? ta : x; tb = nb; tc = nc; td = nd; } } }
        unsigned L = td;
#pragma unroll
        for (int o = 32; o >= 1; o >>= 1) { const unsigned y = (unsigned)__shfl_xor((int)L, o); L = L < y ? L : y; }
        unsigned wa = (unsigned)lane * 4u;
#pragma unroll
        for (int g = 0; g < 4; ++g) { if (g * 32 <= c) {
#pragma unroll
            for (int i = g * 32; i < g * 32 + 32; ++i) { *(LAS unsigned*)((LAS char*)cl + wa) = k[i]; wa += (k[i] >= L && wa < 64u * 256u) ? 256u : 0u; } } }
        const int npl = (int)(wa >> 8);
        int mx = npl;
#pragma unroll
        for (int o = 32; o >= 1; o >>= 1) { const int y = __shfl_xor(mx, o); mx = mx > y ? mx : y; }
        asm volatile("s_waitcnt lgkmcnt(0)" ::: "memory");
        unsigned U = ta;
#pragma unroll
        for (int o = 32; o >= 1; o >>= 1) { const unsigned y = (unsigned)__shfl_xor((int)U, o); U = U > y ? U : y; }
        const unsigned dif = (unsigned)__builtin_amdgcn_readfirstlane((int)(L ^ U));
        const int hb = dif ? 31 - __builtin_clz(dif) : -1;
        unsigned pfx = (hb >= 31) ? 0u : (hb < 0 ? L : (L & ~((2u << hb) - 1u)));
        int cge, cgt;
        if (mx <= 24) {
            unsigned cc[24];
#pragma unroll
            for (int j = 0; j < 24; ++j) { const unsigned v = cl[j * 64 + lane]; cc[j] = (j < npl) ? v : 0u; asm volatile("" : "+v"(cc[j])); }
            for (int bit = hb; bit >= 0; --bit) { const unsigned cand = pfx | (1u << bit); int pl = 0;
#pragma unroll
                for (int j = 0; j < 24; ++j) pl += (cc[j] >= cand) ? 1 : 0;
                pfx = (wave_allsum(pl) >= 256) ? cand : pfx; }
            int p1 = 0, p2 = 0;
#pragma unroll
            for (int j = 0; j < 24; ++j) { p1 += (cc[j] >= pfx) ? 1 : 0; p2 += (cc[j] > pfx) ? 1 : 0; }
            cge = __builtin_amdgcn_readfirstlane(wave_allsum(p1)); cgt = __builtin_amdgcn_readfirstlane(wave_allsum(p2));
        } else {
            for (int bit = hb; bit >= 0; --bit) { const unsigned cand = pfx | (1u << bit); int pl = 0;
#pragma unroll
                for (int i = 0; i < 128; ++i) pl += (k[i] >= cand) ? 1 : 0;
                pfx = (wave_allsum(pl) >= 256) ? cand : pfx; }
            unsigned thrc = pfx; asm volatile("" : "+v"(thrc));
            int p1 = 0, p2 = 0;
#pragma unroll
            for (int i = 0; i < 128; ++i) { p1 += (k[i] >= thrc) ? 1 : 0; p2 += (k[i] > thrc) ? 1 : 0; }
            cge = __builtin_amdgcn_readfirstlane(wave_allsum(p1)); cgt = __builtin_amdgcn_readfirstlane(wave_allsum(p2));
        }
        const unsigned prefix = (unsigned)__builtin_amdgcn_readfirstlane((int)pfx);
        const unsigned thr = prefix;
        if (cge == 256) {
#pragma unroll
            for (int g = 0; g < 32; ++g) { if ((g >> 3) * 32 <= c) { unsigned long long w4[4];
#pragma unroll
                for (int j = 0; j < 4; ++j) w4[j] = __ballot(k[g * 4 + j] >= thr);
                if (lane == 0) {
#pragma unroll
                    for (int j = 0; j < 4; ++j) wsl[g * 4 + j] = w4[j]; }
                __builtin_amdgcn_sched_barrier(0); } }
        } else {
            const int allowed = 256 - cgt; int R = 0;
#pragma unroll
            for (int i = 0; i < 128; ++i) {
                unsigned long long gtm = __ballot(k[i] > thr), tm = __ballot(k[i] == thr);
                const int nt = __popcll(tm);
                if (R + nt > allowed) { int keepn = allowed - R; if (keepn < 0) keepn = 0; while (__popcll(tm) > keepn) tm &= ~(1ull << (63 - __clzll(tm))); }
                R += nt;
                const unsigned long long word = gtm | tm;
                if (lane == 0) wsl[i] = word;
                if ((i & 3) == 3) __builtin_amdgcn_sched_barrier(0);
            }
        }
        asm volatile("s_waitcnt lgkmcnt(0)" ::: "memory");
        if (lane <= c) sel[(size_t)row * 128 + lane] = wsl[lane];
        if (lane + 64 <= c) sel[(size_t)row * 128 + 64 + lane] = wsl[64 + lane];
    }
}

DI bf16x8 pack8(const f32x16& x, int s) {
    const u32x4 p = {cvt_pk_bf16(x[8 * s], x[8 * s + 1]), cvt_pk_bf16(x[8 * s + 2], x[8 * s + 3]), cvt_pk_bf16(x[8 * s + 4], x[8 * s + 5]), cvt_pk_bf16(x[8 * s + 6], x[8 * s + 7])};
    return __builtin_bit_cast(bf16x8, p);
}
DI void p6_stick(const Frame& F) {
    const int l = F.lane, n = l & 31, hi = l >> 5;
    const bf16_t* z = F.at<bf16_t>(WS_Z); const bf16x8* kbF = F.at<bf16x8>(WS_KBF); const bf16x8* vbF = F.at<bf16x8>(WS_VBF); bf16_t* ob = F.at<bf16_t>(WS_OB);
    constexpr float C2 = 0.088388347648318440f * 1.4426950408889634f;
    LAS int* ctr = (LAS int*)(F.lds + P56_CTR) + 1;
    for (;;) {
        const int u = p56_grab(ctr, l) * F.G + F.wg; if (u >= NB * 8 * 256) break;
        const int qt = 255 - (u >> 5), bh = u & 31, b = bh >> 3, h = bh & 7, t0 = qt * 32;
        bf16x8 Bq[8];
        { const bf16_t* qp = z + ((size_t)b * SEQ + t0 + n) * INWP + C_QB + h * 128 + hi * 8;
#pragma unroll
          for (int kk = 0; kk < 8; ++kk) Bq[kk] = *(const bf16x8*)(qp + kk * 16); }
        f32x16 oT[4] = {};
        float carry = 0.f;
        bf16x8 Kn[8];
        { const bf16x8* kc0 = kbF + (((size_t)(b * 8 + h) * 256 + qt) * 8) * 64 + l;
#pragma unroll
          for (int kk = 0; kk < 8; ++kk) Kn[kk] = kc0[kk * 64]; }
        bf16x8 Vn[8];
        { const bf16x8* vc0 = vbF + (((size_t)(b * 8 + h) * 256 + qt) * 8) * 64 + l;
#pragma unroll
          for (int kk = 0; kk < 8; ++kk) Vn[kk] = vc0[kk * 64]; }
        for (int kb = qt; kb >= 0; --kb) {
            const bf16x8* kc = kbF + (((size_t)(b * 8 + h) * 256 + (kb > 0 ? kb - 1 : 0)) * 8) * 64 + l;
            const bf16x8* vc = vbF + (((size_t)(b * 8 + h) * 256 + (kb > 0 ? kb - 1 : 0)) * 8) * 64 + l;
            bf16x8 Ka[8], Va[8];
#pragma unroll
            for (int kk = 0; kk < 8; ++kk) { Ka[kk] = Kn[kk]; Va[kk] = Vn[kk]; }
#pragma unroll
            for (int kk = 0; kk < 8; ++kk) Kn[kk] = kc[kk * 64];
#pragma unroll
            for (int kk = 0; kk < 8; ++kk) Vn[kk] = vc[kk * 64];
            f32x16 S = {};
#pragma unroll
            for (int kk = 0; kk < 8; ++kk) S = MFMA32(Ka[kk], Bq[kk], S);
            const bool diag = (kb == qt);
            float lk[16], lb[16];
#pragma unroll
            for (int r = 0; r < 16; ++r) {
                const float z2 = S[r] * C2;
                const float e = __builtin_amdgcn_exp2f(-__builtin_fabsf(z2));
                const float sp = fmaxf(z2, 0.f) + __builtin_amdgcn_logf(1.0f + e);
                const int srel = (r & 3) + 8 * (r >> 2) + 4 * hi;
                const bool causal = !diag || (srel < n);
                lk[r] = causal ? -sp : 0.f; lb[r] = z2 - sp;
                S[r] = causal ? 0.f : -1e30f;
            }
            float G[4];
#pragma unroll
            for (int q = 0; q < 4; ++q) G[q] = (lk[4 * q] + lk[4 * q + 1]) + (lk[4 * q + 2] + lk[4 * q + 3]);
            float Ev[4], Ov[4];
#pragma unroll
            for (int q = 0; q < 4; ++q) { auto rr = __builtin_amdgcn_permlane32_swap(__float_as_uint(G[q]), __float_as_uint(G[q]), false, false); Ev[q] = __uint_as_float(rr[0]); Ov[q] = __uint_as_float(rr[1]); }
            float Rq[4]; Rq[3] = 0.f; Rq[2] = Ev[3] + Ov[3]; Rq[1] = Rq[2] + (Ev[2] + Ov[2]); Rq[0] = Rq[1] + (Ev[1] + Ov[1]);
            const float tot = Rq[0] + (Ev[0] + Ov[0]);
#pragma unroll
            for (int q = 0; q < 4; ++q) {
                const float base = carry + Rq[q] + (hi ? 0.f : Ov[q]);
                const float g3 = base, g2 = g3 + lk[4 * q + 3], g1 = g2 + lk[4 * q + 2], g0 = g1 + lk[4 * q + 1];
                S[4 * q + 3] = __builtin_amdgcn_exp2f(lb[4 * q + 3] + g3 + S[4 * q + 3]);
                S[4 * q + 2] = __builtin_amdgcn_exp2f(lb[4 * q + 2] + g2 + S[4 * q + 2]);
                S[4 * q + 1] = __builtin_amdgcn_exp2f(lb[4 * q + 1] + g1 + S[4 * q + 1]);
                S[4 * q + 0] = __builtin_amdgcn_exp2f(lb[4 * q + 0] + g0 + S[4 * q + 0]);
            }
            carry += tot;
            const bf16x8 P0 = pack8(S, 0), P1 = pack8(S, 1);
#pragma unroll
            for (int db = 0; db < 4; ++db) { oT[db] = MFMA32(Va[db * 2], P0, oT[db]); oT[db] = MFMA32(Va[db * 2 + 1], P1, oT[db]); }
            if (__all(carry < -150.5f)) break;
        }
        unsigned char* op = (unsigned char*)ob + ((size_t)b * SEQ + t0 + n) * 1024 + h * 128 + 4 * hi;
#pragma unroll
        for (int db = 0; db < 4; ++db)
#pragma unroll
            for (int q = 0; q < 4; ++q) *(unsigned*)(op + 32 * db + 8 * q) = pk_fp8x4(clamp448(oT[db][4 * q] * 32.f), clamp448(oT[db][4 * q + 1] * 32.f), clamp448(oT[db][4 * q + 2] * 32.f), clamp448(oT[db][4 * q + 3] * 32.f));
    }
}

namespace dsa {
constexpr float SCALE = 0.088388347648318440f, THR = 8.f;
constexpr int SHM_V = 64 * 128 * 2, SHM_K = 64 * 128 * 2, SHM_ATTN = 2 * SHM_V + 2 * SHM_K + 8 * 64 * 4;
#define KSWZ(row, colB) ((row) * 256 + ((colB) ^ (((row) & 7) << 4)))
#define SBAR() __builtin_amdgcn_sched_barrier(0)
DI int crow(int r, int hi) { return (r & 3) + 8 * (r >> 2) + 4 * hi; }
DI void apply_mask(f32x16& p0, f32x16& p1, unsigned long long w, int hi) {
    const unsigned lo = (unsigned)w >> (4 * hi), up = (unsigned)(w >> 32) >> (4 * hi);
#pragma unroll
    for (int r = 0; r < 16; ++r) { const int bp = (r & 3) + 8 * (r >> 2);
        const unsigned t0 = (unsigned)(((int)(lo << (31 - bp))) >> 31), t1 = (unsigned)(((int)(up << (31 - bp))) >> 31);
        p0[r] = __uint_as_float((__float_as_uint(p0[r]) & t0) | (~t0 & 0xff800000u));
        p1[r] = __uint_as_float((__float_as_uint(p1[r]) & t1) | (~t1 & 0xff800000u)); }
}
DI void partialSM(f32x16& p0, f32x16& p1, float& m_reg, float& mn, float& alpha) {
    constexpr float C = SCALE * 1.4426950408889634f;
    float pmax = p0[0];
#pragma unroll
    for (int r = 1; r < 16; ++r) pmax = fmaxf(pmax, p0[r]);
#pragma unroll
    for (int r = 0; r < 16; ++r) pmax = fmaxf(pmax, p1[r]);
    { auto rr = __builtin_amdgcn_permlane32_swap(__float_as_uint(pmax), __float_as_uint(pmax), false, false);
      pmax = fmaxf(__uint_as_float(rr[0]), __uint_as_float(rr[1])); }
    if (__builtin_expect(__all(pmax - m_reg <= THR / SCALE), 1)) { mn = m_reg; alpha = 1.f; }
    else { mn = fmaxf(m_reg, pmax); alpha = __builtin_amdgcn_exp2f((m_reg - mn) * C); m_reg = mn; }
    const float mnC = -mn * C;
#pragma unroll
    for (int r = 0; r < 16; ++r) p0[r] = fmaf(p0[r], C, mnC);
#pragma unroll
    for (int r = 0; r < 16; ++r) p1[r] = fmaf(p1[r], C, mnC);
#pragma unroll
    for (int r = 0; r < 16; ++r) p0[r] = __builtin_amdgcn_exp2f(p0[r]);
}
DI void finishSM(f32x16& p0, f32x16& p1, float alpha, float& l_reg, bf16x8& pa0, bf16x8& pa1, bf16x8& pa2, bf16x8& pa3) {
#pragma unroll
    for (int r = 0; r < 16; ++r) p1[r] = __builtin_amdgcn_exp2f(p1[r]);
    float ps = 0;
#pragma unroll
    for (int r = 0; r < 16; ++r) ps += p0[r];
#pragma unroll
    for (int r = 0; r < 16; ++r) ps += p1[r];
    { auto rr = __builtin_amdgcn_permlane32_swap(__float_as_uint(ps), __float_as_uint(ps), false, false);
      ps = __uint_as_float(rr[0]) + __uint_as_float(rr[1]); }
    l_reg = l_reg * alpha + ps;
#define PK4(P, BASE, OUT) do { unsigned a0 = cvt_pk_bf16(P[BASE + 0], P[BASE + 1]), a1 = cvt_pk_bf16(P[BASE + 2], P[BASE + 3]);   \
    unsigned b0 = cvt_pk_bf16(P[BASE + 4], P[BASE + 5]), b1 = cvt_pk_bf16(P[BASE + 6], P[BASE + 7]);                              \
    auto r0 = __builtin_amdgcn_permlane32_swap(a0, b0, false, false); auto r1 = __builtin_amdgcn_permlane32_swap(a1, b1, false, false); \
    u32x4 w = {r0[0], r1[0], r0[1], r1[1]}; OUT = __builtin_bit_cast(bf16x8, w); } while (0)
    PK4(p0, 0, pa0); PK4(p0, 8, pa1); PK4(p1, 0, pa2); PK4(p1, 8, pa3);
#undef PK4
}
DI void qkt(f32x16& p0, f32x16& p1, LAS const char* Ks, const bf16x8* qr, int r32, int hi) {
    p0 = f32x16{}; p1 = f32x16{};
#pragma unroll
    for (int d0 = 0; d0 < 8; ++d0) { const int cb = (d0 * 16 + hi * 8) * 2;
        const bf16x8 b0 = *(LAS const bf16x8*)(Ks + KSWZ(r32, cb));
        const bf16x8 b1 = *(LAS const bf16x8*)(Ks + KSWZ(32 + r32, cb));
        p0 = MFMA32(b0, qr[d0], p0);
        p1 = MFMA32(b1, qr[d0], p1); }
}
DI int v_st(int k, int c) { const int kk = (k & ~0xC) | ((k & 4) << 1) | ((k & 8) >> 1); return ((kk >> 3) * 4 + (c >> 5)) * 512 + ((kk & 7) * 32 + (c & 31)) * 2; }
DI int v_rd_base(int lane) { return ((lane & 3) << 3) | (((lane >> 2) & 3) << 6) | (((lane >> 4) & 1) << 5) | (((lane >> 5) & 1) << 8); }
constexpr int v_rd_off(int d0, int ks, int half) { return d0 * 512 + ks * 4096 + half * 2048; }
template <int OFF> DI s16x4 tr_read(int vb) { s16x4 r; asm volatile("ds_read_b64_tr_b16 %0, %1 offset:%2" : "=&v"(r) : "v"(vb), "i"(OFF) : "memory"); return r; }
template <int D0> DI void pv_one(f32x16& od, int vb, bf16x8 pa0, bf16x8 pa1, bf16x8 pa2, bf16x8 pa3) {
    const s16x4 l0 = tr_read<v_rd_off(D0, 0, 0)>(vb), h0 = tr_read<v_rd_off(D0, 0, 1)>(vb), l1 = tr_read<v_rd_off(D0, 1, 0)>(vb), h1 = tr_read<v_rd_off(D0, 1, 1)>(vb);
    const s16x4 l2 = tr_read<v_rd_off(D0, 2, 0)>(vb), h2 = tr_read<v_rd_off(D0, 2, 1)>(vb), l3 = tr_read<v_rd_off(D0, 3, 0)>(vb), h3 = tr_read<v_rd_off(D0, 3, 1)>(vb);
    asm volatile("s_waitcnt lgkmcnt(0)" ::: "memory"); SBAR();
#define PKV(L, H) (bf16x8){L[0], L[1], L[2], L[3], H[0], H[1], H[2], H[3]}
    od = MFMA32(pa0, PKV(l0, h0), od);
    od = MFMA32(pa1, PKV(l1, h1), od);
    od = MFMA32(pa2, PKV(l2, h2), od);
    od = MFMA32(pa3, PKV(l3, h3), od);
#undef PKV
}
DI void pv_d0(f32x16* o, int vb, bf16x8 pa0, bf16x8 pa1, bf16x8 pa2, bf16x8 pa3) {
    pv_one<0>(o[0], vb, pa0, pa1, pa2, pa3); pv_one<1>(o[1], vb, pa0, pa1, pa2, pa3); pv_one<2>(o[2], vb, pa0, pa1, pa2, pa3); pv_one<3>(o[3], vb, pa0, pa1, pa2, pa3);
}
DI void unit(const bf16_t* __restrict__ Qw, const bf16_t* __restrict__ Kh, const bf16_t* __restrict__ Vh, const unsigned long long* __restrict__ selw, int NT,
             bf16_t* __restrict__ Ob, LAS char* lds) {
    const int tid = threadIdx.x, wid = tid >> 6, lane = tid & 63, r32 = lane & 31, hi = lane >> 5;
    constexpr long LDK = INWP;
    LAS char* V_lds = lds; LAS char* K_lds = lds + 2 * SHM_V;
    LAS float* wsl = (LAS float*)(lds + 2 * SHM_V + 2 * SHM_K) + wid * 64; LAS float* li_l = wsl; LAS float* al_l = wsl + 32;
    float m_reg = -1e30f, l_reg = 0; f32x16 o[4] = {}; bf16x8 qr[8];
#pragma unroll
    for (int d0 = 0; d0 < 8; ++d0) qr[d0] = *(const bf16x8*)(Qw + d0 * 16);
    const int sr = tid >> 4, sc = (tid & 15) * 8, vst0 = v_st(sr, sc), vst1 = v_st(32 + sr, sc);
    const int vb0 = (int)(uintptr_t)V_lds + v_rd_base(lane);
    struct { bf16x8 vs0, vs1, ks0, ks1; } sr_[1];
    const int NTe = (NT + 1) & ~1;
    const unsigned soff0 = (unsigned)(sr * (int)LDK + sc) * 2u, soff1 = soff0 + 32u * (unsigned)LDK * 2u;
#define SLOAD(i, k0) do { const char* vb_ = (const char*)Vh + (size_t)(k0) * LDK * 2; const char* kb_ = (const char*)Kh + (size_t)(k0) * LDK * 2; \
    sr_[i].vs0 = *(const bf16x8*)(vb_ + soff0); sr_[i].vs1 = *(const bf16x8*)(vb_ + soff1); sr_[i].ks0 = *(const bf16x8*)(kb_ + soff0); sr_[i].ks1 = *(const bf16x8*)(kb_ + soff1); } while (0)
#define SWRITE(b, i) do { *(LAS bf16x8*)(V_lds + (b) * SHM_V + vst0) = sr_[i].vs0;          \
    *(LAS bf16x8*)(V_lds + (b) * SHM_V + vst1) = sr_[i].vs1; const int kc = sc * 2;               \
    *(LAS bf16x8*)(K_lds + (b) * SHM_K + KSWZ(sr, kc)) = sr_[i].ks0;                       \
    *(LAS bf16x8*)(K_lds + (b) * SHM_K + KSWZ(32 + sr, kc)) = sr_[i].ks1; } while (0)
#define SWAIT() asm volatile("s_waitcnt vmcnt(0)" ::: "memory")
#define RESC(a) do { if (__any((a) < 1.f)) { if (hi == 0) al_l[r32] = (a); asm volatile("s_waitcnt lgkmcnt(0)" ::: "memory"); \
    _Pragma("unroll") for (int d = 0; d < 4; ++d) _Pragma("unroll") for (int r = 0; r < 16; ++r) o[d][r] *= al_l[crow(r, hi)]; } } while (0)
    const unsigned seloff = (unsigned)r32 * 1024u;
#define MASKW(jt) (((jt) < NT) ? *(const unsigned long long*)((const char*)(selw + (jt)) + seloff) : 0ull)
    f32x16 pA0, pA1, pB0, pB1; float mnA, mnB, alA, alB; bf16x8 pa0, pa1, pa2, pa3;
    unsigned long long mA, mB;
    constexpr int SE = 0, SO = 0;
    mA = MASKW(0);
    SLOAD(SE, 0); asm volatile("s_waitcnt vmcnt(0)" ::: "memory"); SWRITE(0, SE); __syncthreads();
    qkt(pA0, pA1, K_lds, qr, r32, hi); apply_mask(pA0, pA1, mA, hi); partialSM(pA0, pA1, m_reg, mnA, alA);
    SLOAD(SO, 64);
    SWAIT(); SWRITE(1, SO); __syncthreads();
    for (int j = 1; j + 1 < NTe; j += 2) {
        mB = MASKW(j);
        SBAR(); qkt(pB0, pB1, K_lds + SHM_K, qr, r32, hi);
        finishSM(pA0, pA1, alA, l_reg, pa0, pa1, pa2, pa3); SBAR();
        SLOAD(SO, (j + 1) * 64); SBAR();
        pv_d0(o, vb0, pa0, pa1, pa2, pa3); apply_mask(pB0, pB1, mB, hi); partialSM(pB0, pB1, m_reg, mnB, alB);
        __syncthreads(); SWAIT(); SWRITE(0, SE);
        RESC(alB); __syncthreads();
        mA = MASKW(j + 1);
        SBAR(); qkt(pA0, pA1, K_lds, qr, r32, hi);
        finishSM(pB0, pB1, alB, l_reg, pa0, pa1, pa2, pa3); SBAR();
        SLOAD(SE, (j + 2) * 64); SBAR();
        pv_d0(o, vb0 + SHM_V, pa0, pa1, pa2, pa3); apply_mask(pA0, pA1, mA, hi); partialSM(pA0, pA1, m_reg, mnA, alA);
        __syncthreads(); SWAIT(); SWRITE(1, SO);
        RESC(alA); __syncthreads();
    }
    mB = MASKW(NTe - 1);
    SBAR(); qkt(pB0, pB1, K_lds + SHM_K, qr, r32, hi);
    finishSM(pA0, pA1, alA, l_reg, pa0, pa1, pa2, pa3); SBAR();
    pv_d0(o, vb0, pa0, pa1, pa2, pa3); apply_mask(pB0, pB1, mB, hi); partialSM(pB0, pB1, m_reg, mnB, alB);
    __syncthreads(); RESC(alB);
    finishSM(pB0, pB1, alB, l_reg, pa0, pa1, pa2, pa3); SBAR();
    pv_d0(o, vb0 + SHM_V, pa0, pa1, pa2, pa3);
    if (hi == 0) li_l[r32] = l_reg; asm volatile("s_waitcnt lgkmcnt(0)" ::: "memory");
    float rli[16];
#pragma unroll
    for (int r = 0; r < 16; ++r) rli[r] = __builtin_amdgcn_rcpf(li_l[crow(r, hi)]);
#pragma unroll
    for (int r = 0; r < 16; ++r) { const int orow = crow(r, hi);
#pragma unroll
        for (int d0 = 0; d0 < 4; ++d0) ((unsigned char*)Ob)[(long)orow * 1024 + d0 * 32 + r32] = (unsigned char)(pk_fp8x4(clamp448(o[d0][r] * rli[r] * 32.f), 0.f, 0.f, 0.f) & 0xffu); }
#undef SLOAD
#undef SWRITE
#undef SWAIT
#undef RESC
#undef MASKW
}
}
DI void p7_dsa(const Frame& F) {
    const bf16_t* z = F.at<bf16_t>(WS_Z); const unsigned long long* sel = F.at<unsigned long long>(WS_SEL); bf16_t* oa = F.at<bf16_t>(WS_OA);
    const int r32 = F.lane & 31, hi = F.lane >> 5;
    for (int item = F.wg; item < NB * 2 * 64; item += F.G) {
        const int pi = item & 63, j = (item >> 6) & 1, b = item >> 7;
#pragma unroll 1
        for (int half = 0; half < 2; ++half) {
            const int c = half ? pi : 127 - pi;
            const size_t q0 = (size_t)b * SEQ + 64 * c + (F.wave & 1) * 32;
            const int head = j * 4 + (F.wave >> 1);
            __syncthreads();
            dsa::unit(z + (q0 + r32) * INWP + C_QA + head * 128 + hi * 8, z + (size_t)b * SEQ * INWP + C_KA + j * 128, z + (size_t)b * SEQ * INWP + C_VA + j * 128,
                      sel + q0 * 128, c + 1, (bf16_t*)((unsigned char*)oa + q0 * 1024 + head * 128), (LAS char*)F.lds);
        }
    }
}

struct MergedSched {
    pg8::TileOrder ord; unsigned OA, OB, WA, WB;
    DI bool next(int i, pg8::Unit& u) const { int pm, pn; if (!ord.tile(i >> 1, pm, pn)) return false; const int br = i & 1;
        u.pm = pm; u.pn = pn; u.e = 0; u.aux = br; u.A = (br ? OB : OA) + (unsigned)pm * 256u * 1024u; u.B = (br ? WB : WA) + (unsigned)pn * 256u * 1024u; return true; }
};
struct EpiMerged {
    static constexpr bool PERM = true;
    const unsigned char* GZ; unsigned char* O;
    static DI float g4(unsigned w, int j) { const f32x2 p = (j < 2) ? __builtin_amdgcn_cvt_pk_f32_fp8((int)w, false) : __builtin_amdgcn_cvt_pk_f32_fp8((int)w, true); return ((j & 1) ? p.y : p.x) * 0.0625f; }
    DI bool operator()(f32x4 (&acc)[2][2][4][2], const pg8::Unit& u, int wr, int wc, int fr, int fq) const {
        const int row0 = u.pm * 256 + wr * 64 + fr, col0 = u.pn * 256 + wc * 32 + 8 * fq;
        u32x2 gav[2][4][2], gbv[2][4][2];
#pragma unroll
        for (int ai = 0; ai < 2; ++ai)
#pragma unroll
            for (int m = 0; m < 4; ++m)
#pragma unroll
                for (int bj = 0; bj < 2; ++bj) { const size_t row = (size_t)(row0 + ai * 128 + m * 16); const int col = col0 + bj * 128;
                    gbv[ai][m][bj] = *(const u32x2*)(GZ + row * 4096 + 2048 + col); if (u.aux == 0) gav[ai][m][bj] = *(const u32x2*)(GZ + row * 4096 + col); else gav[ai][m][bj] = (u32x2){0u, 0u}; }
        if (u.aux != 0) {
#pragma unroll
            for (int ai = 0; ai < 2; ++ai)
#pragma unroll
                for (int m = 0; m < 4; ++m)
#pragma unroll
                    for (int bj = 0; bj < 2; ++bj) asm volatile("" : "+v"(gbv[ai][m][bj]));
        }
#pragma unroll
        for (int ai = 0; ai < 2; ++ai) {
#pragma unroll
            for (int m = 0; m < 4; ++m) { const size_t row = (size_t)(row0 + ai * 128 + m * 16);
#pragma unroll
                for (int bj = 0; bj < 2; ++bj) { const int col = col0 + bj * 128;
                    float f[8];
                    if (u.aux == 0) {
#pragma unroll
                        for (int j = 0; j < 8; ++j) { const float ga = g4(j < 4 ? gav[ai][m][bj].x : gav[ai][m][bj].y, j & 3), gb = g4(j < 4 ? gbv[ai][m][bj].x : gbv[ai][m][bj].y, j & 3);
                            f[j] = (1.f + __expf(-gb)) * __builtin_amdgcn_rcpf(1.f + __expf(-ga)); }
                    } else {
#pragma unroll
                        for (int j = 0; j < 8; ++j) { const float gb = g4(j < 4 ? gbv[ai][m][bj].x : gbv[ai][m][bj].y, j & 3); f[j] = __builtin_amdgcn_rcpf(1.f + __expf(-gb)); }
                    }
                    f32x4 v0 = acc[ai][bj][m][0], v1 = acc[ai][bj][m][1];
                    v0[0] *= f[0]; v0[1] *= f[1]; v0[2] *= f[2]; v0[3] *= f[3]; v1[0] *= f[4]; v1[1] *= f[5]; v1[2] *= f[6]; v1[3] *= f[7];
                    if (u.aux == 0) { acc[ai][bj][m][0] = v0; acc[ai][bj][m][1] = v1; }
                    else { u32x2 w; w.x = pk_fp8x4(clamp448(v0[0] * 16.f), clamp448(v0[1] * 16.f), clamp448(v0[2] * 16.f), clamp448(v0[3] * 16.f));
                        w.y = pk_fp8x4(clamp448(v1[0] * 16.f), clamp448(v1[1] * 16.f), clamp448(v1[2] * 16.f), clamp448(v1[3] * 16.f));
                        *(u32x2*)(O + row * DM + col) = w; } } }
        }
        return u.aux == 0;
    }
};

typedef int v4i32q __attribute__((ext_vector_type(4)));
constexpr int LDS_TAB = 131072;
DI void p10_rows(const Frame& F) {
    LAS float* cG1 = (LAS float*)F.lds; LAS float* cA1 = cG1 + DM; LAS float* cA2 = cA1 + DM; LAS float* cB2 = cA2 + DM;
    LAS float* lg = cB2 + DM;
    LAS int* se = (LAS int*)(lg + 128 * 33);
    const float* mod = F.at<float>(WS_MOD); const bf16_t* mix = F.at<bf16_t>(WS_MIX);
    bf16_t* h2h = F.at<bf16_t>(WS_H); bf16_t* h2l = F.at<bf16_t>(WS_H2LO); unsigned char* h2q = F.at<unsigned char>(WS_H2Q);
    for (int blk = F.wg; blk < T / 128; blk += F.G) {
        const int b = blk / 64;
        __syncthreads();
#pragma unroll
        for (int i = 0; i < 4; ++i) { const int col = F.tid * 4 + i; const float* mb = mod + (size_t)b * 12288;
            cG1[col] = F.kp->in[I_GPOSTMIX][col] * mb[4096 + col]; cA2[col] = F.kp->in[I_GPREFFN][col] * (1.0f + mb[8192 + col]); cB2[col] = mb[6144 + col]; }
        __syncthreads();
        const size_t rowb = (size_t)blk * 128 + F.wave * 16;
        f32x4 xv[8], xn[8]; u32x2 mw[8], mn[8];
        { const float* xr = F.kp->in[I_X] + rowb * DM + F.lane * 4; const bf16_t* mr = mix + rowb * DM + F.lane * 4;
#pragma unroll
          for (int q = 0; q < 8; ++q) { xv[q] = *(const f32x4*)(xr + q * 256); mw[q] = *(const u32x2*)(mr + q * 256); } }
        for (int i = 0; i < 16; ++i) {
            const size_t row = rowb + i;
            if (i + 1 < 16) { const float* xr = F.kp->in[I_X] + (row + 1) * DM + F.lane * 4; const bf16_t* mr = mix + (row + 1) * DM + F.lane * 4;
#pragma unroll
                for (int q = 0; q < 8; ++q) { xn[q] = *(const f32x4*)(xr + q * 256); mn[q] = *(const u32x2*)(mr + q * 256); } }
            float ss = 0.f;
#pragma unroll
            for (int q = 0; q < 8; ++q) { const float m0 = bflo(mw[q].x), m1 = bfhi(mw[q].x), m2 = bflo(mw[q].y), m3 = bfhi(mw[q].y); ss += m0 * m0 + m1 * m1 + m2 * m2 + m3 * m3; }
            ss = wave_sum(ss);
            const float rs1 = rsqrtf(ss * (1.0f / DM) + RMS_EPS);
            float s2 = 0.f; bf16_t* orow = F.at<bf16_t>(WS_X1B) + row * DM + F.lane * 4;
#pragma unroll
            for (int q = 0; q < 8; ++q) { const int col = q * 256 + F.lane * 4; const float mq[4] = {bflo(mw[q].x), bfhi(mw[q].x), bflo(mw[q].y), bfhi(mw[q].y)};
#pragma unroll
                for (int e = 0; e < 4; ++e) { xv[q][e] += mq[e] * rs1 * cG1[col + e]; s2 += xv[q][e] * xv[q][e]; }
                *(u32x2*)(orow + q * 256) = (u32x2){cvt_pk_bf16(xv[q][0], xv[q][1]), cvt_pk_bf16(xv[q][2], xv[q][3])}; }
            s2 = wave_sum(s2);
            const float rs2 = rsqrtf(s2 * (1.0f / DM) + RMS_EPS);
            int lz = F.lane * 4; asm volatile("" : "+v"(lz));
#pragma unroll
            for (int q = 0; q < 8; ++q) { const int col = q * 256 + lz; float h[4], lo[4]; unsigned hb[4];
#pragma unroll
                for (int e = 0; e < 4; ++e) { h[e] = xv[q][e] * rs2 * cA2[col + e] + cB2[col + e]; hb[e] = cvt_pk_bf16(h[e], 0.f) & 0xffffu; lo[e] = h[e] - __uint_as_float(hb[e] << 16); }
                u32x2 wh = {hb[0] | (hb[1] << 16), hb[2] | (hb[3] << 16)}; u32x2 wl = {cvt_pk_bf16(lo[0], lo[1]), cvt_pk_bf16(lo[2], lo[3])};
                *(u32x2*)(h2h + row * DM + col) = wh; *(u32x2*)(h2l + row * DM + col) = wl;
                *(unsigned*)(h2q + row * DM + col) = pk_fp8x4(clamp448(h[0]), clamp448(h[1]), clamp448(h[2]), clamp448(h[3])); }
#pragma unroll
            for (int q = 0; q < 8; ++q) { xv[q] = xn[q]; mw[q] = mn[q]; }
        }
        asm volatile("s_waitcnt vmcnt(0)" ::: "memory");
        if (F.tid >= 256 && F.tid < 288) se[512 + F.tid - 256] = 0;
        __syncthreads();
        {
            const int l = F.lane, m = l & 31, hi = l >> 5, g = F.wave & 3, kh = F.wave >> 2; const size_t r0 = (size_t)blk * 128 + g * 32;
            const bf16_t* ah = h2h + (r0 + m) * DM + kh * (DM / 2) + hi * 8; const bf16_t* al = h2l + (r0 + m) * DM + kh * (DM / 2) + hi * 8;
            const bf16_t* wh = F.at<bf16_t>(WS_WRT) + (size_t)m * DM + kh * (DM / 2) + hi * 8; const bf16_t* wl = wh + NE * DM;
            f32x16 acc = {};
#pragma unroll 4
            for (int kk = 0; kk < DM / 32; ++kk) { const bf16x8 a0 = *(const bf16x8*)(ah + kk * 16), a1 = *(const bf16x8*)(al + kk * 16), b0 = *(const bf16x8*)(wh + kk * 16), b1 = *(const bf16x8*)(wl + kk * 16);
                acc = MFMA32(a0, b0, acc); acc = MFMA32(a1, b0, acc); acc = MFMA32(a0, b1, acc); }
            const float br = F.kp->in[I_BR][m];
            if (kh == 0) {
#pragma unroll
                for (int r = 0; r < 16; ++r) lg[(g * 32 + (r & 3) + 8 * (r >> 2) + 4 * hi) * 33 + m] = acc[r] + br; }
            __syncthreads();
            if (kh == 1) {
#pragma unroll
                for (int r = 0; r < 16; ++r) lg[(g * 32 + (r & 3) + 8 * (r >> 2) + 4 * hi) * 33 + m] += acc[r]; }
        }
        __syncthreads();
        if (F.tid < 128) {
            float v[32];
#pragma unroll
            for (int e = 0; e < 32; ++e) v[e] = lg[F.tid * 33 + e];
            int te[4]; float tv[4];
#pragma unroll
            for (int k = 0; k < 4; ++k) { float best = -INFINITY; int bi = 0;
#pragma unroll
                for (int e = 0; e < 32; ++e) { if (v[e] > best) { best = v[e]; bi = e; } }
                te[k] = bi; tv[k] = best;
#pragma unroll
                for (int e = 0; e < 32; ++e) if (e == bi) v[e] = -INFINITY; }
            const float e1 = __expf(tv[1] - tv[0]), e2 = __expf(tv[2] - tv[0]), e3 = __expf(tv[3] - tv[0]); const float inv = 1.0f / (1.0f + e1 + e2 + e3);
            const size_t tok = (size_t)blk * 128 + F.tid;
            int* tep = F.at<int>(WS_TOPE) + tok * 4; float* twp = F.at<float>(WS_TOPW) + tok * 4;
            tep[0] = te[0]; tep[1] = te[1]; tep[2] = te[2]; tep[3] = te[3]; twp[0] = inv; twp[1] = e1 * inv; twp[2] = e2 * inv; twp[3] = e3 * inv;
#pragma unroll
            for (int k = 0; k < 4; ++k) __hip_atomic_fetch_add(se + 512 + te[k], 1, __ATOMIC_RELAXED, __HIP_MEMORY_SCOPE_WORKGROUP);
        }
        __syncthreads();
        if (F.tid < 32) F.at<int>(WS_CNT)[blk * 32 + F.tid] = se[512 + F.tid];
    }
}

DI void moe_tables(const Frame& F, int blk) {
    LAS int* tb = (LAS int*)(F.lds + LDS_TAB); LAS int* part = tb + 1024;
    __syncthreads();
    { const int e = F.tid & 31, g = F.tid >> 5; const int* cnt = F.at<int>(WS_CNT) + (g * 16) * 32 + e; int v[16];
#pragma unroll
      for (int j = 0; j < 16; ++j) v[j] = cnt[j * 32];
      int all = 0, bef = 0;
#pragma unroll
      for (int j = 0; j < 16; ++j) { all += v[j]; bef += (g * 16 + j < blk) ? v[j] : 0; }
      part[g * 32 + e] = all; part[512 + g * 32 + e] = bef; }
    __syncthreads();
    if (F.tid < 32) { int tot = 0, pre = 0;
#pragma unroll
        for (int g = 0; g < 16; ++g) { tot += part[g * 32 + F.tid]; pre += part[512 + g * 32 + F.tid]; }
        tb[F.tid] = tot; tb[160 + F.tid] = pre; tb[64 + F.tid] = (tot + 255) >> 8; }
    __syncthreads();
    if (F.tid == 0) { int rs = 0, us = 0; for (int e = 0; e < 32; ++e) { tb[32 + e] = rs; tb[96 + e] = us; rs += tb[64 + e] * 256; us += tb[64 + e]; } tb[96 + 32] = us; }
    __syncthreads();
}
DI void p11_sort(const Frame& F) {
    LAS int* tb = (LAS int*)(F.lds + LDS_TAB); LAS int* se = (LAS int*)F.lds; LAS int* pos = se + 512;
    int* rslot = F.at<int>(WS_RSLOT); float* rw = F.at<float>(WS_RW); const unsigned char* h2q = F.at<unsigned char>(WS_H2Q); unsigned char* hs = F.at<unsigned char>(WS_HS);
    for (int blk = F.wg; blk < T / 128; blk += F.G) {
        moe_tables(F, blk);
        se[F.tid] = F.at<int>(WS_TOPE)[(size_t)blk * 512 + F.tid];
        __syncthreads();
        {
            LAS int* wc = pos + 512;
            const int e = se[F.tid]; int rank = 0, mine = 0;
#pragma unroll 1
            for (int ee = 0; ee < 32; ++ee) { const unsigned long long mk = __ballot(e == ee);
                if (e == ee) { rank = __builtin_popcountll(mk & ((1ull << F.lane) - 1ull)); mine = __builtin_popcountll(mk); }
                if (F.lane == 0) wc[F.wave * 32 + ee] = __builtin_popcountll(mk); }
            (void)mine;
            __syncthreads();
            int before = 0;
            for (int w = 0; w < F.wave; ++w) before += wc[w * 32 + e];
            pos[F.tid] = tb[32 + e] + tb[160 + e] + before + rank;
        }
        __syncthreads();
        { const int p = pos[F.tid]; rslot[p] = blk * 512 + F.tid; rw[p] = F.at<float>(WS_TOPW)[(size_t)blk * 512 + F.tid]; }
        for (int t0 = F.wave * 8; t0 < 128; t0 += NWAVES * 8) {
            u32x4 v[8][2];
#pragma unroll
            for (int e = 0; e < 8; ++e) { const u32x4* src = (const u32x4*)(h2q + ((size_t)blk * 128 + t0 + e) * DM); v[e][0] = src[F.lane]; v[e][1] = src[64 + F.lane]; }
#pragma unroll
            for (int e = 0; e < 8; ++e)
#pragma unroll
                for (int k = 0; k < 4; ++k) { u32x4* dst = (u32x4*)(hs + (size_t)pos[(t0 + e) * 4 + k] * DM); dst[F.lane] = v[e][0]; dst[64 + F.lane] = v[e][1]; } }
        if (blk < 32) { const int e = blk, lo = tb[32 + e] + tb[e], hi_ = tb[32 + e] + tb[64 + e] * 256;
            for (int p = lo + F.tid; p < hi_; p += NTHR) { rslot[p] = -1; rw[p] = 0.f; }
            for (int p = lo + F.wave; p < hi_; p += NWAVES) { u32x4* dst = (u32x4*)(hs + (size_t)p * DM);
#pragma unroll
                for (int q = 0; q < 2; ++q) dst[q * 64 + F.lane] = (u32x4){0u, 0u, 0u, 0u}; } }
        __syncthreads();
    }
}

template <int NT_, int NROWS_B> DI void moe_units(const Frame& F, unsigned Abase, unsigned Bbase) {
    LAS int* tb = (LAS int*)(F.lds + LDS_TAB);
    const int total = tb[96 + 32] * NT_;
    int n = 0;
    for (int i = F.tid; ; i += NTHR) { const int L = i * F.G + F.wg; if (L >= total) break;
        int e = 0;
#pragma unroll 1
        for (int q = 1; q < 32; ++q) if (L >= tb[96 + q] * NT_) e = q;
        const int l = L - tb[96 + e] * NT_, mt = tb[64 + e], mi = l % mt, ni = l / mt, r0 = tb[32 + e] + mi * 256;
        tb[256 + 4 * i] = (int)(Abase + (unsigned)r0 * 2048u); tb[256 + 4 * i + 1] = (int)(Bbase + ((unsigned)e * NROWS_B + (unsigned)ni * 256u) * 2048u); tb[256 + 4 * i + 2] = r0 >> 8; tb[256 + 4 * i + 3] = (e << 8) | ni; }
    if (F.tid == 0) { const int mine = total > F.wg ? (total - F.wg + F.G - 1) / F.G : 0; tb[255] = mine; }
    (void)n;
    __syncthreads();
}
struct MoeSched {
    LAS const int* tb;
    DI bool next(int i, pg8::Unit& u) const {
        if (i >= __builtin_amdgcn_readfirstlane(tb[255])) return false;
        const v4i32q v = *(LAS const v4i32q*)(tb + 256 + 4 * i);
        u.A = (unsigned)__builtin_amdgcn_readfirstlane(v[0]); u.B = (unsigned)__builtin_amdgcn_readfirstlane(v[1]); u.pm = __builtin_amdgcn_readfirstlane(v[2]);
        const int w = __builtin_amdgcn_readfirstlane(v[3]); u.pn = w & 255; u.e = w >> 8; u.aux = 0; return true; }
};
DI void dense_units(const Frame& F, int nM, int nN, unsigned Abase, unsigned Bbase, unsigned RB) {
    LAS int* tb = (LAS int*)(F.lds + LDS_TAB);
    pg8::TileOrder ord; ord.init(nM, nN, F.G, F.wg);
    __syncthreads();
    int n = 0;
    for (int i = F.tid; ; i += NTHR) { int pm, pn; if (!ord.tile(i, pm, pn)) break;
        tb[256 + 4 * i] = (int)(Abase + (unsigned)pm * 256u * RB); tb[256 + 4 * i + 1] = (int)(Bbase + (unsigned)pn * 256u * RB); tb[256 + 4 * i + 2] = pm; tb[256 + 4 * i + 3] = pn; }
    if (F.tid == 0) { const int total = nM * nN; tb[255] = total > F.wg ? (total - F.wg + F.G - 1) / F.G : 0; }
    (void)n;
    __syncthreads();
}
DI u32x4 xpose4(unsigned d0, unsigned d1, unsigned d2, unsigned d3) {
    typedef unsigned u32x2v_ __attribute__((ext_vector_type(2)));
    const u32x2v_ a = __builtin_amdgcn_permlane16_swap(d0, d1, false, false), b = __builtin_amdgcn_permlane16_swap(d2, d3, false, false);
    const u32x2v_ x = __builtin_amdgcn_permlane32_swap(a.x, b.x, false, false), y = __builtin_amdgcn_permlane32_swap(a.y, b.y, false, false);
    u32x4 r; r.x = x.x; r.y = y.x; r.z = x.y; r.w = y.y; return r;
}
struct EpiMoe1 {
    static constexpr bool PERM = true;
    const float* b1; unsigned char* act;
    DI bool operator()(const f32x4 (&acc)[2][2][4][2], const pg8::Unit& u, int wr, int wc, int fr, int fq) const {
        const int row0 = u.pm * 256 + wr * 64 + fr, col0 = u.pn * 256 + wc * 32 + 8 * fq;
        f32x4 bva[2][2];
#pragma unroll
        for (int bj = 0; bj < 2; ++bj) { bva[bj][0] = *(const f32x4*)(b1 + (size_t)u.e * 4096 + col0 + bj * 128); bva[bj][1] = *(const f32x4*)(b1 + (size_t)u.e * 4096 + col0 + bj * 128 + 4); }
#pragma unroll
        for (int bj = 0; bj < 2; ++bj) {
            const f32x4 bv0 = bva[bj][0], bv1 = bva[bj][1];
#pragma unroll
            for (int ai = 0; ai < 2; ++ai) {
                unsigned d[4];
#pragma unroll
                for (int m = 0; m < 4; ++m) {
                    const f32x4 v0 = acc[ai][bj][m][0] + bv0, v1 = acc[ai][bj][m][1] + bv1;
                    float o[4];
#pragma unroll
                    for (int j = 0; j < 4; ++j) { const float g = fminf(j < 2 ? v0[2 * j] : v1[2 * j - 4], 7.0f), li = fminf(fmaxf(j < 2 ? v0[2 * j + 1] : v1[2 * j - 3], -7.0f), 7.0f);
                        o[j] = g * __builtin_amdgcn_rcpf(1.0f + __builtin_amdgcn_exp2f(g * (-1.702f * 1.44269504f))) * fmaf(li, 4.0f, 4.0f); }
                    d[m] = pk_fp8x4(o[0], o[1], o[2], o[3]); }
                *(u32x4*)(act + (size_t)(row0 + ai * 128 + fq * 16) * DFF + ((col0 - 8 * fq) >> 1) + bj * 64) = xpose4(d[0], d[1], d[2], d[3]); }
            asm volatile("" ::: "memory");
        }
        return false;
    }
};
struct EpiMoe2 {
    static constexpr bool PERM = true;
    const float* b2; const int* rslot; const float* rw; unsigned char* ys;
    DI bool operator()(const f32x4 (&acc)[2][2][4][2], const pg8::Unit& u, int wr, int wc, int fr, int fq) const {
        const int row0 = u.pm * 256 + wr * 64 + fr, col0 = u.pn * 256 + wc * 32 + 8 * fq;
        int slot[2][4]; float w[2][4]; f32x4 bv[2][2];
#pragma unroll
        for (int ai = 0; ai < 2; ++ai)
#pragma unroll
            for (int m = 0; m < 4; ++m) { const int row = row0 + ai * 128 + m * 16; slot[ai][m] = rslot[row]; w[ai][m] = rw[row]; }
#pragma unroll
        for (int bj = 0; bj < 2; ++bj) { bv[bj][0] = *(const f32x4*)(b2 + (size_t)u.e * 2048 + col0 + bj * 128); bv[bj][1] = *(const f32x4*)(b2 + (size_t)u.e * 2048 + col0 + bj * 128 + 4); }
#pragma unroll
        for (int ai = 0; ai < 2; ++ai)
#pragma unroll
            for (int m = 0; m < 4; ++m) asm volatile("" : "+v"(slot[ai][m]), "+v"(w[ai][m]));
#pragma unroll
        for (int bj = 0; bj < 2; ++bj) asm volatile("" : "+v"(bv[bj][0]), "+v"(bv[bj][1]));
        asm volatile("" ::: "memory");
#pragma unroll
        for (int ai = 0; ai < 2; ++ai) {
#pragma unroll
            for (int bj = 0; bj < 2; ++bj) {
                const f32x4 bv0 = bv[bj][0], bv1 = bv[bj][1];
#pragma unroll
                for (int m = 0; m < 4; ++m) {
                    if (slot[ai][m] >= 0) { const float ws_ = w[ai][m] * 16.f; const f32x4 v0 = (acc[ai][bj][m][0] + bv0) * ws_, v1 = (acc[ai][bj][m][1] + bv1) * ws_;
                        u32x2 q; q.x = pk_fp8x4(clamp448(v0[0]), clamp448(v0[1]), clamp448(v0[2]), clamp448(v0[3])); q.y = pk_fp8x4(clamp448(v1[0]), clamp448(v1[1]), clamp448(v1[2]), clamp448(v1[3]));
                        *(u32x2*)(ys + (size_t)slot[ai][m] * DM + col0 + bj * 128) = q; } }
            }
        }
        return false;
    }
};

DI void p14_final(const Frame& F) {
    LAS float* cG = (LAS float*)F.lds; const float* mod = F.at<float>(WS_MOD); const unsigned char* ys = F.at<unsigned char>(WS_YS);
    for (int blk = F.wg; blk < T / 128; blk += F.G) {
        const int b = blk / 64;
        __syncthreads();
#pragma unroll
        for (int i = 0; i < 4; ++i) { const int col = F.tid * 4 + i; cG[col] = F.kp->in[I_GPOSTFFN][col] * mod[(size_t)b * 12288 + 10240 + col]; }
        __syncthreads();
        const size_t rowb = (size_t)blk * 128 + F.wave * 16;
        unsigned yw[4][8], yn[4][8];
#pragma unroll
        for (int k = 0; k < 4; ++k)
#pragma unroll
            for (int q = 0; q < 8; ++q) yw[k][q] = *(const unsigned*)(ys + (rowb * 4 + k) * DM + q * 256 + F.lane * 4);
        u32x2 x1w[8], x1n[8];
#pragma unroll
        for (int q = 0; q < 8; ++q) x1w[q] = *(const u32x2*)(F.at<bf16_t>(WS_X1B) + rowb * DM + F.lane * 4 + q * 256);
        for (int i = 0; i < 16; ++i) {
            const size_t row = rowb + i;
            if (i + 1 < 16) {
#pragma unroll
                for (int k = 0; k < 4; ++k)
#pragma unroll
                    for (int q = 0; q < 8; ++q) yn[k][q] = *(const unsigned*)(ys + ((row + 1) * 4 + k) * DM + q * 256 + F.lane * 4);
#pragma unroll
                for (int q = 0; q < 8; ++q) x1n[q] = *(const u32x2*)(F.at<bf16_t>(WS_X1B) + (row + 1) * DM + F.lane * 4 + q * 256); }
            float* orow = F.kp->out + row * DM + F.lane * 4;
            f32x4 x1[8];
#pragma unroll
            for (int q = 0; q < 8; ++q) x1[q] = (f32x4){bflo(x1w[q].x), bfhi(x1w[q].x), bflo(x1w[q].y), bfhi(x1w[q].y)};
            f32x4 f[8]; float ss = 0.f;
#pragma unroll
            for (int q = 0; q < 8; ++q) { f[q] = (f32x4){0.f, 0.f, 0.f, 0.f};
#pragma unroll
                for (int k = 0; k < 4; ++k) { const unsigned w = yw[k][q]; const f32x2 lo = __builtin_amdgcn_cvt_pk_f32_fp8((int)w, false), hi = __builtin_amdgcn_cvt_pk_f32_fp8((int)w, true);
                    f[q] += (f32x4){lo.x, lo.y, hi.x, hi.y}; }
                f[q] *= 0.0625f;
                ss += f[q][0] * f[q][0] + f[q][1] * f[q][1] + f[q][2] * f[q][2] + f[q][3] * f[q][3]; }
            ss = wave_sum(ss);
            const float rs = rsqrtf(ss * (1.0f / DM) + RMS_EPS);
#pragma unroll
            for (int q = 0; q < 8; ++q) { const int col = q * 256 + F.lane * 4;
#pragma unroll
                for (int e = 0; e < 4; ++e) x1[q][e] += f[q][e] * rs * cG[col + e];
                *(f32x4*)(orow + q * 256) = x1[q]; }
#pragma unroll
            for (int k = 0; k < 4; ++k)
#pragma unroll
                for (int q = 0; q < 8; ++q) yw[k][q] = yn[k][q];
#pragma unroll
            for (int q = 0; q < 8; ++q) x1w[q] = x1n[q];
        }
    }
}

constexpr int N_PHASES = 15;
__global__ void __launch_bounds__(NTHR, 2) mega(Params p) {
    extern __shared__ __attribute__((aligned(16))) unsigned char lds_raw[];
    Frame F; F.kp = (KParams)__builtin_amdgcn_kernarg_segment_ptr(); F.ws = p.ws; F.lds = (LAS unsigned char*)lds_raw; F.tid = threadIdx.x; F.wave = __builtin_amdgcn_readfirstlane(threadIdx.x >> 6); F.lane = threadIdx.x & 63; F.G = gridDim.x; F.wg = blockIdx.x;
    volatile LAS unsigned* bst = (volatile LAS unsigned*)(F.lds + LDS_BYTES - 16);
    if (F.tid < 4) bst[F.tid] = 0u;
    __syncthreads();
    const int lo = p.ph_lo, hi = p.ph_hi;
    XcdBarrier bar; bar.bar = (unsigned*)(p.ws + WS_CTL); bar.x = 0; bar.st = bst;
    if (hi - lo > 1) bar = xcd_barrier_post((unsigned*)(p.ws + WS_CTL), bst);
#ifdef ONLY_PHASE
#define IN(k) ((k) == ONLY_PHASE)
#else
#ifdef SKIP_PHASE
#define IN(k) ((k) != SKIP_PHASE && lo <= (k) && (k) < hi)
#else
#define IN(k) (lo <= (k) && (k) < hi)
#endif
#endif
#define PH(k) if (IN(k)) { KParams kq_ = (KParams)__builtin_amdgcn_kernarg_segment_ptr(); asm volatile("" : "+s"(kq_)); F.kp = kq_; int t_ = threadIdx.x; asm volatile("" : "+v"(t_)); F.tid = t_; F.lane = t_ & 63; }
#define SEAM(k) do { if (IN(k) && IN((k) + 1)) xcd_barrier(bar); } while (0)
#ifndef DBG_DOUBLE
#define DBG_DOUBLE 0
#endif
#define PHASE(k, ...) PH(k) if (IN(k)) { { __VA_ARGS__ } if constexpr ((DBG_DOUBLE >> (k)) & 1) { xcd_barrier(bar); { __VA_ARGS__ } } }
    PHASE(0, p0_prologue(F);) SEAM(0);
    PHASE(1, p1_norm(F);) SEAM(1);
    PHASE(2, { dense_units(F, T / 256, (INB - NF8) / 256, (unsigned)WS_H, (unsigned)WS_WINT, 4096u); MoeSched S{(LAS const int*)(F.lds + LDS_TAB)};
          EpiStoreBf16 E{F.at<bf16_t>(WS_Z) + NF8, INWP, C_GA - NF8}; pg8::gemm_phase<2048, EpiStoreBf16, MoeSched>(F.lds, F.ws, S, E); }
        { dense_units(F, T / 256, (NF8 + 4096) / 256, (unsigned)WS_H8, (unsigned)WS_WING8, 2048u); MoeSched S{(LAS const int*)(F.lds + LDS_TAB)};
          EpiInFp8 E{F.at<bf16_t>(WS_Z), F.at<unsigned char>(WS_GZ)}; pg8::gemm_phase<1024, EpiInFp8, MoeSched, true, 122, 127>(F.lds, F.ws, S, E); }) SEAM(2);
    PHASE(3, p3_rope(F);) SEAM(3);
    PHASE(4, p4_indexer(F);) SEAM(4);
    PHASE(5, p5_select(F);)
    PHASE(6, p6_stick(F);) SEAM(6);
    PHASE(7, p7_dsa(F);) SEAM(7);
    PHASE(8, MergedSched S; S.ord.init(T / 256, DM / 256, F.G, F.wg); S.OA = (unsigned)WS_OA; S.OB = (unsigned)WS_OB; S.WA = (unsigned)WS_WAT; S.WB = (unsigned)WS_WBT;
        EpiMerged E{F.at<unsigned char>(WS_GZ), F.at<unsigned char>(WS_MERGED)}; pg8::gemm_phase<512, EpiMerged, MergedSched, true, 122, 122>(F.lds, F.ws, S, E);) SEAM(8);
    PHASE(9, dense_units(F, T / 256, DM / 256, (unsigned)WS_MERGED, (unsigned)WS_WOT, 2048u); MoeSched S{(LAS const int*)(F.lds + LDS_TAB)};
        EpiStoreBf16 E{F.at<bf16_t>(WS_MIX), DM, DM}; pg8::gemm_phase<1024, EpiStoreBf16, MoeSched, true, 122, 123>(F.lds, F.ws, S, E);) SEAM(9);
    PHASE(10, p10_rows(F);) SEAM(10);
    PHASE(11, p11_sort(F);) SEAM(11);
    PHASE(12, moe_tables(F, 0); moe_units<16, 4096>(F, (unsigned)WS_HS, (unsigned)WS_W1T); MoeSched S{(LAS const int*)(F.lds + LDS_TAB)};
        EpiMoe1 E{F.kp->in[I_B1], F.at<unsigned char>(WS_ACT)}; pg8::gemm_phase<1024, EpiMoe1, MoeSched, true, 122, 127>(F.lds, F.ws, S, E);) SEAM(12);
    PHASE(13, moe_tables(F, 0); moe_units<8, 2048>(F, (unsigned)WS_ACT, (unsigned)WS_W2T); MoeSched S{(LAS const int*)(F.lds + LDS_TAB)};
        EpiMoe2 E{F.kp->in[I_B2], F.at<int>(WS_RSLOT), F.at<float>(WS_RW), F.at<unsigned char>(WS_YS)}; pg8::gemm_phase<1024, EpiMoe2, MoeSched, true, 122, 125>(F.lds, F.ws, S, E);) SEAM(13);
    PHASE(14, p14_final(F);)
#undef IN
#undef SEAM
}


extern "C" void kernel_launch(void* const* d_in, const int* in_sizes, int n_in, void* d_out, int out_size, void* d_ws, size_t ws_size, hipStream_t stream) {
    static int grid = 0;
    if (grid == 0) {
        if (n_in != 19 || out_size != T * DM || ws_size < WS_END) { fprintf(stderr, "kernel_launch: unexpected shapes: n_in %d out %d ws %zu (need %zu)\n", n_in, out_size, ws_size, (size_t)WS_END); grid = -1; return; }
        int dev = 0, cus = 0, per_cu = 0;
        if (hipGetDevice(&dev) != hipSuccess || hipDeviceGetAttribute(&cus, hipDeviceAttributeMultiprocessorCount, dev) != hipSuccess) { grid = -1; return; }
        if (hipFuncSetAttribute((const void*)mega, hipFuncAttributeMaxDynamicSharedMemorySize, LDS_BYTES) != hipSuccess) { fprintf(stderr, "kernel_launch: hipFuncSetAttribute failed\n"); grid = -1; return; }
        if (hipOccupancyMaxActiveBlocksPerMultiprocessor(&per_cu, (const void*)mega, NTHR, LDS_BYTES) != hipSuccess || per_cu < 1) { fprintf(stderr, "kernel_launch: occupancy query says %d blocks per CU\n", per_cu); per_cu = 1; }
        (void)hipGetLastError();
        grid = cus;
    }
    if (grid < 0) return;
    (void)hipMemsetAsync((char*)d_ws + WS_CTL, 0, CTL_BYTES, stream);
    Params p{};
    for (int i = 0; i < 19; ++i) p.in[i] = (const float*)d_in[i];
    p.out = (float*)d_out; p.ws = (unsigned char*)d_ws;
#if MK_N_LAUNCHES == 1
    p.ph_lo = 0; p.ph_hi = N_PHASES;
    hipLaunchKernelGGL(mega, dim3(grid), dim3(NTHR), LDS_BYTES, stream, p);
#else
#ifndef DBG_LAST_PHASE
#define DBG_LAST_PHASE (N_PHASES - 1)
#endif
    for (int k = 0; k <= DBG_LAST_PHASE; ++k) { p.ph_lo = k; p.ph_hi = k + 1; hipLaunchKernelGGL(mega, dim3(grid), dim3(NTHR), LDS_BYTES, stream, p); }
#endif
    const hipError_t le = hipPeekAtLastError();
    if (le != hipSuccess) fprintf(stderr, "kernel_launch: launch failed: %s\n", hipGetErrorName(le));
}
```

```cpp
#include <hip/hip_runtime.h>
#include <cstdio>
#include <cstdint>

#ifndef DBG_DOUBLE
#define DBG_DOUBLE 0
#endif
#ifndef MK_N_LAUNCHES
#define MK_N_LAUNCHES 1
#endif

#define LAS __attribute__((address_space(3)))
typedef unsigned short bf16_t;
typedef short bf16x8 __attribute__((ext_vector_type(8)));
typedef short s16x4 __attribute__((ext_vector_type(4)));
typedef float f32x2 __attribute__((ext_vector_type(2)));
typedef float f32x4 __attribute__((ext_vector_type(4)));
typedef float f32x16 __attribute__((ext_vector_type(16)));
typedef unsigned u32x2 __attribute__((ext_vector_type(2)));
typedef unsigned u32x4 __attribute__((ext_vector_type(4)));
#define DI __device__ __forceinline__

constexpr int NB = 4, SEQ = 8192, T = NB * SEQ, DM = 2048;
constexpr int INW = 9808, INWP = 9984;
constexpr int INB = 5888;
constexpr int C_QA = 0, C_KA = 1024, C_VA = 1280, C_QB = 1536, C_KB = 2560, C_VB = 3584, C_QI = 4608, C_KI = 5632, C_WI = 5696, C_GA = 5712, C_GB = 7760;
constexpr int NE = 32, TOPK = 4, DFF = 2048, NSLOT = T * TOPK;
constexpr int MAXROWS = NSLOT + NE * 256;
constexpr float RMS_EPS = 1e-6f;
constexpr int NWAVES = 8, NTHR = 512;
constexpr int LDS_BYTES = 147456;

constexpr size_t al256(size_t x) { return (x + 255) / 256 * 256; }
constexpr size_t WS_CTL = 0;
constexpr size_t CTL_BYTES = 65536;
constexpr size_t WS_MODP = WS_CTL + CTL_BYTES;
constexpr size_t WS_MOD = WS_MODP + al256((size_t)32 * 4 * 12288 * 4);
constexpr size_t WS_WINT = WS_MOD + al256((size_t)4 * 12288 * 4);
constexpr size_t WS_WAT = WS_WINT + al256((size_t)INWP * DM * 2);
constexpr size_t WS_WBT = WS_WAT + al256((size_t)2048 * 1024 * 2);
constexpr size_t WS_WOT = WS_WBT + al256((size_t)2048 * 1024 * 2);
constexpr size_t WS_W1T = WS_WOT + al256((size_t)2048 * 2048 * 2);
constexpr size_t WS_W2T = WS_W1T + al256((size_t)NE * 4096 * 2048 * 2);
constexpr size_t WS_WRT = WS_W2T + al256((size_t)NE * 2048 * 2048 * 2);
constexpr int NF8 = 4608;
constexpr size_t WS_WING8 = WS_WRT + al256((size_t)2 * NE * DM * 2);
constexpr size_t WS_H8 = WS_WING8 + al256((size_t)(NF8 + 4096) * DM);
constexpr size_t WS_GZ = WS_H8 + al256((size_t)T * DM);
constexpr size_t WS_TOPE = WS_GZ + al256((size_t)T * 4096);
constexpr size_t WS_TOPW = WS_TOPE + al256((size_t)T * 4 * 4);
constexpr size_t WS_CNT = WS_TOPW + al256((size_t)T * 4 * 4);
constexpr size_t WS_RSLOT = WS_CNT + al256((size_t)256 * NE * 4);
constexpr size_t WS_RW = WS_RSLOT + al256((size_t)MAXROWS * 4);
constexpr size_t WS_H = WS_RW + al256((size_t)MAXROWS * 4);
constexpr size_t WS_Z = WS_H + al256((size_t)T * DM * 2);
constexpr size_t SC_PER_B = (size_t)4096 * 128 * 129 / 2;
constexpr size_t WS_SC = WS_Z + al256((size_t)T * INWP * 2);
constexpr size_t WS_KBF = WS_SC + al256(SC_PER_B * 4 * NB);
constexpr size_t WS_VBF = WS_KBF + al256((size_t)T * 1024 * 2);
constexpr size_t WS_KIDX = WS_VBF + al256((size_t)T * 1024 * 2);
constexpr size_t WS_WIF = WS_KIDX + al256((size_t)T * 64 * 2);
constexpr size_t WS_SEL = WS_WIF + al256((size_t)T * 16 * 4);
constexpr size_t WS_OA = WS_SEL + al256((size_t)T * 128 * 8);
constexpr size_t WS_OB = WS_OA + al256((size_t)T * 1024 * 2);
constexpr size_t WS_MERGED = WS_OB + al256((size_t)T * 1024 * 2);
constexpr size_t WS_MIX = WS_MERGED + al256((size_t)T * DM * 2);
constexpr size_t WS_ENDX = WS_MIX + al256((size_t)T * DM * 2);
constexpr size_t WS_X1B = WS_GZ;
constexpr size_t WS_H2LO = WS_Z;
constexpr size_t WS_H2Q = WS_H2LO + al256((size_t)T * DM * 2);
constexpr size_t WS_HS = WS_H2Q + al256((size_t)T * DM);
constexpr size_t WS_ACT = WS_HS + al256((size_t)MAXROWS * DM * 2);
constexpr size_t WS_YS = WS_ACT + al256((size_t)MAXROWS * DFF * 2);
constexpr size_t WS_ENDY = WS_YS + al256((size_t)NSLOT * DM * 2);
constexpr size_t WS_END = WS_ENDX > WS_ENDY ? WS_ENDX : WS_ENDY;
static_assert(WS_END < 0xffffffffull, "32-bit workspace offsets");
static_assert(WS_HS >= WS_Z + (size_t)T * DM * 2 && WS_HS + (size_t)MAXROWS * DM <= WS_SC, "map: h2lo, h2q, hs must stay inside the dead z buffer while merged/mix (further up) are live");

struct Params { const float* in[19]; float* out; unsigned char* ws; int ph_lo, ph_hi; };
enum { I_X = 0, I_C, I_POS, I_WADA, I_BADA, I_GPREMIX, I_GPOSTMIX, I_WIN, I_WA, I_WB, I_WOUT, I_GPREFFN, I_GPOSTFFN, I_WR, I_BR, I_W1, I_B1, I_W2, I_B2 };

#define XB_TMO      128
#define XB_XCNT(j)  (256  + 64 * (j))
#define XB_XSUB(j)  (1280 + 64 * (j))
#define XB_XGEN(j)  (2304 + 64 * (j))
#define XB_TOP      3328
#define XB_TOPGEN   3392
#define XCD_BAR_WORDS 3456
#define XB_SPIN_CAP (1u << 18)
__device__ __forceinline__ unsigned xb_ld(unsigned* p)              { return __hip_atomic_load(p, __ATOMIC_RELAXED, __HIP_MEMORY_SCOPE_AGENT); }
__device__ __forceinline__ unsigned xb_add(unsigned* p, unsigned v) { return __hip_atomic_fetch_add(p, v, __ATOMIC_RELAXED, __HIP_MEMORY_SCOPE_AGENT); }
__device__ __forceinline__ unsigned xb_xcc_id() { return (unsigned)__builtin_amdgcn_s_getreg((3 << 11) | 20) & 0xFu; }
#define XB_SPIN(cond, bar) do { unsigned _sp = 0; while (cond) { __builtin_amdgcn_s_sleep(1); \
    if ((++_sp & 255u) == 0u) { if (xb_ld(&(bar)[XB_TMO])) break; if (_sp > XB_SPIN_CAP) { atomicAdd(&(bar)[XB_TMO], 1u); break; } } } } while (0)
struct XcdBarrier { unsigned* bar; unsigned x; volatile LAS unsigned* st; };
__device__ __forceinline__ XcdBarrier xcd_barrier_post(unsigned* bar, volatile LAS unsigned* st) {
    XcdBarrier b; b.bar = bar; b.x = xb_xcc_id(); b.st = st;
    if (threadIdx.x == 0) (void)xb_add(&bar[XB_XCNT(b.x)], 1u);
    return b;
}
__device__ __forceinline__ void xcd_barrier_complete(unsigned* bar, unsigned x, unsigned& nloc, unsigned& nx) {
    const unsigned G = gridDim.x * gridDim.y * gridDim.z;
    unsigned sum, cnt, mine, sp = 0u;
    for (;;) {
        sum = 0u; cnt = 0u; mine = 0u;
#pragma unroll
        for (unsigned j = 0; j < 16; ++j) { const unsigned c = xb_ld(&bar[XB_XCNT(j)]); sum += c; cnt += (c > 0u) ? 1u : 0u; mine = (j == x) ? c : mine; }
        if (sum == G) break;
        __builtin_amdgcn_s_sleep(1);
        if ((++sp & 255u) == 0u) { if (xb_ld(&bar[XB_TMO])) break; if (sp > XB_SPIN_CAP) { atomicAdd(&bar[XB_TMO], 1u); break; } }
    }
    nloc = mine > 0u ? mine : 1u; nx = cnt > 0u ? cnt : 1u;
}
__device__ __forceinline__ void xcd_barrier(const XcdBarrier& b) {
    asm volatile("s_waitcnt vmcnt(0)" ::: "memory");
    __syncthreads();
    if (threadIdx.x == 0) {
        unsigned* bar = b.bar;
        __builtin_amdgcn_s_waitcnt(0);
        unsigned nloc = b.st[0], nx = b.st[1];
        if (nloc == 0u) { xcd_barrier_complete(bar, b.x, nloc, nx); b.st[0] = nloc; b.st[1] = nx; }
        const unsigned old = xb_add(&bar[XB_XSUB(b.x)], 1u);
        const unsigned gen = old / nloc;
        if (old + 1u == (gen + 1u) * nloc) {
            __builtin_amdgcn_fence(__ATOMIC_RELEASE, "agent");
            asm volatile("s_waitcnt vmcnt(0)" ::: "memory");
            const unsigned og = xb_add(&bar[XB_TOP], 1u);
            const unsigned tg = og / nx;
            if (og + 1u == (tg + 1u) * nx) xb_add(&bar[XB_TOPGEN], 1u);
            else XB_SPIN(xb_ld(&bar[XB_TOPGEN]) == tg, bar);
            __builtin_amdgcn_fence(__ATOMIC_ACQUIRE, "agent");
            xb_add(&bar[XB_XGEN(b.x)], 1u);
            asm volatile("s_waitcnt vmcnt(0)" ::: "memory");
        } else {
            XB_SPIN(xb_ld(&bar[XB_XGEN(b.x)]) == gen, bar);
            __builtin_amdgcn_fence(__ATOMIC_ACQUIRE, "agent");
            asm volatile("s_waitcnt vmcnt(0)" ::: "memory");
        }
    }
    __syncthreads();
}

typedef __bf16 bf16x2v __attribute__((ext_vector_type(2)));
DI unsigned cvt_pk_bf16(float lo, float hi) { const f32x2 v = {lo, hi}; const bf16x2v b = __builtin_convertvector(v, bf16x2v); return __builtin_bit_cast(unsigned, b); }
DI float bf2f(unsigned short b) { return __uint_as_float((unsigned)b << 16); }
DI float bflo(unsigned w) { return __uint_as_float(w << 16); }
DI float bfhi(unsigned w) { return __uint_as_float(w & 0xffff0000u); }
DI float wave_sum(float v) {
    v += __builtin_bit_cast(float, __builtin_amdgcn_update_dpp(0, __builtin_bit_cast(int, v), 0xB1, 0xF, 0xF, false));
    v += __builtin_bit_cast(float, __builtin_amdgcn_update_dpp(0, __builtin_bit_cast(int, v), 0x4E, 0xF, 0xF, false));
    v += __builtin_bit_cast(float, __builtin_amdgcn_update_dpp(0, __builtin_bit_cast(int, v), 0x141, 0xF, 0xF, false));
    v += __builtin_bit_cast(float, __builtin_amdgcn_update_dpp(0, __builtin_bit_cast(int, v), 0x140, 0xF, 0xF, false));
    { auto r = __builtin_amdgcn_permlane16_swap(__float_as_uint(v), __float_as_uint(v), false, false); v = __uint_as_float(r[0]) + __uint_as_float(r[1]); }
    { auto r = __builtin_amdgcn_permlane32_swap(__float_as_uint(v), __float_as_uint(v), false, false); v = __uint_as_float(r[0]) + __uint_as_float(r[1]); }
    return v;
}
DI float sigmoidf_(float x) { return 1.0f / (1.0f + __expf(-x)); }

namespace pg8 {
constexpr int BM = 256, BK = 64, HALF = 128, HTB = HALF * BK * 2, STAGE_BYTES = 8 * HTB;
__host__ __device__ __forceinline__ int lds_byte(int r, int c) { const int st = (r >> 4) * 2 + (c >> 5), rr = r & 15, cc = c & 31, ob = rr * 64 + cc * 2; return st * 1024 + (ob ^ (((ob >> 9) & 1) << 5)); }
__host__ __device__ __forceinline__ void stage_rc(int b, int& R, int& C) { const int st = b / 1024, sb = b % 1024, swz = sb ^ (((sb >> 9) & 1) << 5); R = (st >> 1) * 16 + swz / 64; C = (st & 1) * 32 + (swz % 64) / 2; }
__host__ __device__ __forceinline__ int perm32(int rho) { const int n = rho >> 4, i = rho & 15; return 8 * (i >> 2) + 4 * n + (i & 3); }

struct Unit { unsigned A, B; int pm, pn, e, aux; };

typedef int v8i32 __attribute__((ext_vector_type(8)));
typedef int v4i32 __attribute__((ext_vector_type(4)));
template <int K, class Epi, class Sched, bool FP8 = false, int SC_W = 127, int SC_A = 127>
__device__ __forceinline__ void gemm_phase(LAS unsigned char* lds, const unsigned char* wsbase, const Sched& S, const Epi& E) {
    const __amdgpu_buffer_rsrc_t rsrc = __builtin_amdgcn_make_buffer_rsrc((void*)wsbase, 0, 0xffffffff, 0x00020000);
    const int tid = threadIdx.x, wid = __builtin_amdgcn_readfirstlane(tid >> 6), lane = tid & 63, wr = wid >> 2, wc = wid & 3, fr = lane & 15, fq = lane >> 4;
    constexpr int nt = K / BK;
    unsigned voffA[2], voffB[2];
#pragma unroll
    for (int i = 0; i < 2; ++i) { int R, C; stage_rc(tid * 16 + i * 8192, R, C); const int Rb = Epi::PERM ? ((R & ~31) + perm32(R & 31)) : R;
        voffA[i] = (unsigned)(R * K + C) * 2u; voffB[i] = (unsigned)(Rb * K + C) * 2u; }
    constexpr unsigned kstep = (unsigned)(BK * 2);
    constexpr unsigned hstep = (unsigned)HALF * K * 2;
    const unsigned ldsw = (unsigned)wid * 1024u;
    const int aoff = lds_byte(wr * 64 + fr, fq * 8), boff = lds_byte(wc * 32 + fr, fq * 8);
#define PG8_SA(b, h) (((b) * 2 + (h)) * HTB)
#define PG8_SB(b, h) ((4 + (b) * 2 + (h)) * HTB)
#define PG8_STAGE(bufoff, gbase, voff) do { _Pragma("unroll") for (int _i = 0; _i < 2; ++_i) \
        __builtin_amdgcn_raw_ptr_buffer_load_lds(rsrc, (LAS void*)(lds + (bufoff) + ldsw + _i * 8192), 16, (int)(voff)[_i], (int)(gbase), 0, 0); } while (0)
#define PG8_CAT2(p0, p1) __builtin_shufflevector(*(const LAS v4i32*)(p0), *(const LAS v4i32*)(p1), 0, 1, 2, 3, 4, 5, 6, 7)
#define PG8_LDA(dst, b, h) do { _Pragma("unroll") for (int m = 0; m < 4; ++m) { if constexpr (FP8) dst##8[m] = PG8_CAT2(lds + PG8_SA(b, h) + aoff + m * 2048, lds + PG8_SA(b, h) + aoff + m * 2048 + 1024); \
        else { _Pragma("unroll") for (int k = 0; k < 2; ++k) dst[m][k] = *(const LAS bf16x8*)(lds + PG8_SA(b, h) + aoff + m * 2048 + k * 1024); } } } while (0)
#define PG8_LDB(dst, b, h) do { _Pragma("unroll") for (int n = 0; n < 2; ++n) { if constexpr (FP8) dst##8[n] = PG8_CAT2(lds + PG8_SB(b, h) + boff + n * 2048, lds + PG8_SB(b, h) + boff + n * 2048 + 1024); \
        else { _Pragma("unroll") for (int k = 0; k < 2; ++k) dst[n][k] = *(const LAS bf16x8*)(lds + PG8_SB(b, h) + boff + n * 2048 + k * 1024); } } } while (0)
#define PG8_CAT(x) __builtin_shufflevector(__builtin_bit_cast(v4i32, (x)[0]), __builtin_bit_cast(v4i32, (x)[1]), 0, 1, 2, 3, 4, 5, 6, 7)
#define PG8_MMA(ai, bj, At, Bt) do { __builtin_amdgcn_s_setprio(1); _Pragma("unroll") for (int m = 0; m < 4; ++m) _Pragma("unroll") for (int n = 0; n < 2; ++n) { \
        if constexpr (FP8) acc[ai][bj][m][n] = __builtin_amdgcn_mfma_scale_f32_16x16x128_f8f6f4(Bt##8[n], At##8[m], acc[ai][bj][m][n], 0, 0, 0, SC_W, 0, SC_A); \
        else { _Pragma("unroll") for (int k = 0; k < 2; ++k) acc[ai][bj][m][n] = __builtin_amdgcn_mfma_f32_16x16x32_bf16(Bt[n][k], At[m][k], acc[ai][bj][m][n], 0, 0, 0); } } \
        __builtin_amdgcn_s_setprio(0); } while (0)
#define PG8_WAIT_V(n) asm volatile("s_waitcnt vmcnt(" #n ")" ::: "memory")
#define PG8_WAIT_L(n) asm volatile("s_waitcnt lgkmcnt(" #n ")" ::: "memory")
#define PG8_BAR __builtin_amdgcn_s_barrier()
#define PG8_SCHED __builtin_amdgcn_sched_barrier(0)
    Unit cur, nxt; int ui = 0;
    if (!S.next(0, cur)) return;
    f32x4 acc[2][2][4][2];
#pragma unroll
    for (int a = 0; a < 2; ++a)
#pragma unroll
        for (int b = 0; b < 2; ++b)
#pragma unroll
            for (int m = 0; m < 4; ++m)
#pragma unroll
                for (int n = 0; n < 2; ++n) acc[a][b][m][n] = (f32x4){0.f, 0.f, 0.f, 0.f};
    bf16x8 At[4][2], B0[2][2], B1[2][2]; v8i32 At8[4], B08[2], B18[2];
    unsigned cA = (unsigned)__builtin_amdgcn_readfirstlane((int)cur.A), cB = (unsigned)__builtin_amdgcn_readfirstlane((int)cur.B);
    PG8_STAGE(PG8_SB(0, 0), cB, voffB); PG8_STAGE(PG8_SB(0, 1), cB + hstep, voffB); PG8_STAGE(PG8_SA(0, 0), cA, voffA); PG8_STAGE(PG8_SA(0, 1), cA + hstep, voffA);
    if (wr == 1) PG8_BAR;
    PG8_WAIT_V(2); PG8_BAR;
    PG8_STAGE(PG8_SB(1, 0), cB + kstep, voffB); PG8_STAGE(PG8_SA(1, 0), cA + kstep, voffA); PG8_STAGE(PG8_SB(1, 1), cB + hstep + kstep, voffB);
    PG8_WAIT_V(6); PG8_BAR;
    for (;;) {
        const bool has_next = S.next(ui + 1, nxt);
        const unsigned nA = has_next ? (unsigned)__builtin_amdgcn_readfirstlane((int)nxt.A) : cA, nB = has_next ? (unsigned)__builtin_amdgcn_readfirstlane((int)nxt.B) : cB;
#pragma unroll 1
        for (int t = 0; t < nt; t += 2) {
            const bool last = (t == nt - 2);
            const unsigned a1 = cA + (unsigned)(t + 1) * kstep;
            const unsigned a2 = last ? nA : cA + (unsigned)(t + 2) * kstep, b2 = last ? nB : cB + (unsigned)(t + 2) * kstep;
            const unsigned a3 = a2 + kstep, b3 = b2 + kstep;
            PG8_LDB(B0, 0, 0); PG8_LDB(B1, 0, 1); PG8_SCHED; PG8_LDA(At, 0, 0); PG8_STAGE(PG8_SA(1, 1), a1 + hstep, voffA);
            PG8_WAIT_V(8); PG8_WAIT_L(0); PG8_BAR; PG8_MMA(0, 0, At, B0); PG8_MMA(0, 1, At, B1); PG8_BAR; PG8_SCHED;
            PG8_LDA(At, 0, 1); PG8_STAGE(PG8_SB(0, 0), b2, voffB); PG8_STAGE(PG8_SB(0, 1), b2 + hstep, voffB); PG8_STAGE(PG8_SA(0, 0), a2, voffA);
            PG8_WAIT_V(8); PG8_WAIT_L(0); PG8_BAR; PG8_MMA(1, 0, At, B0); PG8_MMA(1, 1, At, B1); PG8_BAR; PG8_SCHED;
            PG8_LDB(B0, 1, 0); PG8_LDB(B1, 1, 1); PG8_SCHED; PG8_LDA(At, 1, 0); PG8_STAGE(PG8_SA(0, 1), a2 + hstep, voffA);
            PG8_WAIT_V(8); PG8_WAIT_L(0); PG8_BAR; PG8_MMA(0, 0, At, B0); PG8_MMA(0, 1, At, B1); PG8_BAR; PG8_SCHED;
            PG8_LDA(At, 1, 1); PG8_STAGE(PG8_SB(1, 0), b3, voffB); PG8_STAGE(PG8_SB(1, 1), b3 + hstep, voffB); PG8_STAGE(PG8_SA(1, 0), a3, voffA);
            PG8_WAIT_V(8); PG8_WAIT_L(0); PG8_BAR; PG8_MMA(1, 0, At, B0); PG8_MMA(1, 1, At, B1); PG8_BAR; PG8_SCHED;
        }
        if (wr == 0) PG8_BAR;
        int tl_ = threadIdx.x; asm volatile("" : "+v"(tl_));
        const bool keep = E(acc, cur, wr, wc, tl_ & 15, (tl_ & 63) >> 4);
        if (!has_next) break;
        if (!keep) {
#pragma unroll
        for (int a = 0; a < 2; ++a)
#pragma unroll
            for (int b = 0; b < 2; ++b)
#pragma unroll
                for (int m = 0; m < 4; ++m)
#pragma unroll
                    for (int n = 0; n < 2; ++n) acc[a][b][m][n] = (f32x4){0.f, 0.f, 0.f, 0.f};
        }
        cur = nxt; cA = nA; cB = nB; ++ui;
        if (wr == 1) PG8_BAR;
    }
    PG8_WAIT_V(0);
    PG8_BAR;
#undef PG8_SA
#undef PG8_SB
#undef PG8_STAGE
#undef PG8_LDA
#undef PG8_LDB
#undef PG8_MMA
#undef PG8_CAT
#undef PG8_CAT2
#undef PG8_WAIT_V
#undef PG8_WAIT_L
#undef PG8_BAR
#undef PG8_SCHED
}

struct TileOrder {
    int nM, nN, nwg, G, c;
    DI void init(int nM_, int nN_, int G_, int c_) { nM = nM_; nN = nN_; nwg = nM * nN; G = G_; c = c_; }
    DI bool tile(int i, int& pm, int& pn) const {
        const long L = (long)i * G + c; if (L >= nwg) return false;
        int wgid = (int)L; { const int q = nwg / 8, r = nwg % 8, xcd = wgid % 8, off = wgid / 8; wgid = (xcd < r ? xcd * (q + 1) : r * (q + 1) + (xcd - r) * q) + off; }
        const int nig = 8 * nN, gid = wgid / nig, fm = gid * 8, gsz = (nM - fm) < 8 ? (nM - fm) : 8;
        pm = fm + ((wgid % nig) % gsz); pn = (wgid % nig) / gsz; return true;
    }
};
}

typedef const __attribute__((address_space(4))) Params* KParams;
struct Frame {
    KParams kp; unsigned char* ws; LAS unsigned char* lds; int tid, wave, lane, G, wg;
    template <class Tp> DI Tp* at(size_t off) const { return (Tp*)(ws + off); }
};

DI void p0_modpart(const Frame& F, int item) {
    const int ks = item / 6, jt = item % 6;
    LAS float* sl = (LAS float*)F.lds;
    __syncthreads();
    if (F.tid < 256) { const int b = F.tid >> 6, k = F.tid & 63; const float cv = F.kp->in[I_C][b * DM + ks * 64 + k]; sl[F.tid] = cv / (1.0f + __expf(-cv)); }
    __syncthreads();
    const int j0 = jt * 2048 + F.tid * 4;
    const float* w = F.kp->in[I_WADA] + (size_t)(ks * 64) * 12288 + j0;
    f32x4 a0 = {0, 0, 0, 0}, a1 = a0, a2 = a0, a3 = a0;
#pragma unroll 8
    for (int k = 0; k < 64; ++k) { const f32x4 v = *(const f32x4*)(w + (size_t)k * 12288);
        a0 += v * sl[k]; a1 += v * sl[64 + k]; a2 += v * sl[128 + k]; a3 += v * sl[192 + k]; }
    float* o = F.at<float>(WS_MODP) + (size_t)ks * 4 * 12288 + j0;
    *(f32x4*)(o) = a0; *(f32x4*)(o + 12288) = a1; *(f32x4*)(o + 2 * 12288) = a2; *(f32x4*)(o + 3 * 12288) = a3;
}
DI void p0_cvt_tile(const Frame& F, const float* __restrict__ src, bf16_t* __restrict__ dst, int K, int Nsrc, int kt, int ntile) {
    LAS float* tl = (LAS float*)F.lds;
    __syncthreads();
    const int k0 = kt * 64, n0 = ntile * 128;
    {
        const int c4 = (F.tid & 31) * 4, r0 = F.tid >> 5;
#pragma unroll
        for (int i = 0; i < 4; ++i) { const int r = r0 + 16 * i; f32x4 v = {0, 0, 0, 0};
            if (n0 + c4 < Nsrc) v = *(const f32x4*)(src + (size_t)(k0 + r) * Nsrc + n0 + c4);
            tl[r * 129 + c4] = v[0]; tl[r * 129 + c4 + 1] = v[1]; tl[r * 129 + c4 + 2] = v[2]; tl[r * 129 + c4 + 3] = v[3]; }
    }
    __syncthreads();
    {
        const int kc = F.tid & 7;
#pragma unroll
        for (int i = 0; i < 2; ++i) { const int n = (F.tid >> 3) + 64 * i;
            float v[8];
#pragma unroll
            for (int j = 0; j < 8; ++j) v[j] = tl[(kc * 8 + j) * 129 + n];
            u32x4 w = {cvt_pk_bf16(v[0], v[1]), cvt_pk_bf16(v[2], v[3]), cvt_pk_bf16(v[4], v[5]), cvt_pk_bf16(v[6], v[7])};
            *(u32x4*)(dst + (size_t)(n0 + n) * K + k0 + kc * 8) = w; }
    }
}
DI unsigned pk_fp8x4(float a, float b, float c, float d) { int w = 0; w = __builtin_amdgcn_cvt_pk_fp8_f32(a, b, w, false); w = __builtin_amdgcn_cvt_pk_fp8_f32(c, d, w, true); return (unsigned)w; }
DI float clamp448(float x) { return __builtin_amdgcn_fmed3f(x, -448.f, 448.f); }
DI void p0_cvt_tile_fp8(const Frame& F, const float* __restrict__ src, unsigned char* __restrict__ dst, int K, int N, int kt, int ntile) {
    LAS float* tl = (LAS float*)F.lds;
    __syncthreads();
    const int k0 = kt * 128, n0 = ntile * 128;
    {
        const int c4 = (F.tid & 31) * 4, r0 = F.tid >> 5;
#pragma unroll
        for (int i = 0; i < 8; ++i) { const int r = r0 + 16 * i; const f32x4 v = *(const f32x4*)(src + (size_t)(k0 + r) * N + n0 + c4);
            tl[r * 129 + c4] = v[0]; tl[r * 129 + c4 + 1] = v[1]; tl[r * 129 + c4 + 2] = v[2]; tl[r * 129 + c4 + 3] = v[3]; }
    }
    __syncthreads();
    {
        const int n = F.tid & 127, kc = F.tid >> 7;
        unsigned w[8];
#pragma unroll
        for (int j = 0; j < 8; ++j) { const LAS float* p = tl + (kc * 32 + j * 4) * 129 + n;
            w[j] = pk_fp8x4(clamp448(p[0] * 32.f), clamp448(p[129] * 32.f), clamp448(p[258] * 32.f), clamp448(p[387] * 32.f)); }
        unsigned char* o = dst + (size_t)(n0 + n) * K + k0 + kc * 32;
        *(u32x4*)o = (u32x4){w[0], w[1], w[2], w[3]}; *(u32x4*)(o + 16) = (u32x4){w[4], w[5], w[6], w[7]};
    }
}
constexpr int CV_NB = (INB - NF8) / 128, CV_NF = NF8 / 128, CV_N0 = 32 * CV_NB + 16 * CV_NF + 16 * 32, CV_N1 = 8 * 16, CV_N2 = 8 * 16, CV_N3 = 16 * 16, CV_N4 = 0, CV_N5 = 0;
constexpr int CV_S1 = CV_N0, CV_S2 = CV_S1 + CV_N1, CV_S3 = CV_S2 + CV_N2, CV_S4 = CV_S3 + CV_N3, CV_S5 = CV_S4 + CV_N4, CV_TOT = CV_S5 + CV_N5;
DI void p0_prologue(const Frame& F) {
    for (int it = F.wg; it < 192; it += F.G) p0_modpart(F, it);
    for (int i = F.wg * NTHR + F.tid; i < NE * DM; i += F.G * NTHR) { const int e = i / DM, k = i % DM; const float v = F.kp->in[I_WR][(size_t)k * NE + e];
        const unsigned hi = cvt_pk_bf16(v, 0.f) & 0xffffu; const float r = v - __uint_as_float(hi << 16);
        F.at<bf16_t>(WS_WRT)[i] = (bf16_t)hi; F.at<bf16_t>(WS_WRT)[NE * DM + i] = (bf16_t)(cvt_pk_bf16(r, 0.f) & 0xffffu); }
    for (int it = F.wg; it < CV_TOT; it += F.G) {
        int j = it;
        Frame F2 = F; { KParams kq_ = F.kp; asm volatile("" : "+s"(kq_)); F2.kp = kq_; }
        if (j < 32 * CV_NB) { p0_cvt_tile(F, F2.kp->in[I_WIN] + NF8, F.at<bf16_t>(WS_WINT), 2048, INW, j / CV_NB, j % CV_NB); continue; }
        if (j < 32 * CV_NB + 16 * CV_NF) { const int r = j - 32 * CV_NB; p0_cvt_tile_fp8(F, F2.kp->in[I_WIN], F.at<unsigned char>(WS_WING8), 2048, INW, r / CV_NF, r % CV_NF); continue; }
        if (j < CV_N0) { const int r = j - 32 * CV_NB - 16 * CV_NF; p0_cvt_tile_fp8(F, F2.kp->in[I_WIN] + C_GA, F.at<unsigned char>(WS_WING8) + (size_t)NF8 * DM, 2048, INW, r / 32, r % 32); continue; }
        j -= CV_N0;
        if (j < CV_N1) { p0_cvt_tile_fp8(F, F2.kp->in[I_WA], F.at<unsigned char>(WS_WAT), 1024, 2048, j / 16, j % 16); continue; }
        j -= CV_N1;
        if (j < CV_N2) { p0_cvt_tile_fp8(F, F2.kp->in[I_WB], F.at<unsigned char>(WS_WBT), 1024, 2048, j / 16, j % 16); continue; }
        j -= CV_N2;
        p0_cvt_tile_fp8(F, F2.kp->in[I_WOUT], F.at<unsigned char>(WS_WOT), 2048, 2048, j / 16, j % 16);
    }
}

DI float mod_sum(const Frame& F, int b, int j) {
    const float* mp = F.at<float>(WS_MODP) + (size_t)b * 12288 + j; float s = F.kp->in[I_BADA][j]; float v[32];
#pragma unroll
    for (int ks = 0; ks < 32; ++ks) v[ks] = mp[(size_t)ks * 4 * 12288];
#pragma unroll
    for (int ks = 0; ks < 32; ++ks) s += v[ks];
    return s;
}
DI void p1_norm(const Frame& F) {
    LAS float* sA = (LAS float*)F.lds; LAS float* sB = sA + DM;
    for (int o = F.wg * NTHR + F.tid; o < 4 * 12288; o += F.G * NTHR) F.at<float>(WS_MOD)[o] = mod_sum(F, o / 12288, o % 12288);
    for (int blk = F.wg; blk < T / 128; blk += F.G) {
        const int b = blk / 64;
        __syncthreads();
        {
            const int col = F.tid * 4; const float* mp = F.at<float>(WS_MODP) + (size_t)b * 12288 + col;
            f32x4 a1 = *(const f32x4*)(F.kp->in[I_BADA] + 2048 + col), a0 = *(const f32x4*)(F.kp->in[I_BADA] + col);
#pragma unroll 8
            for (int ks = 0; ks < 32; ++ks) { a1 += *(const f32x4*)(mp + (size_t)ks * 4 * 12288 + 2048); a0 += *(const f32x4*)(mp + (size_t)ks * 4 * 12288); }
            const f32x4 g = *(const f32x4*)(F.kp->in[I_GPREMIX] + col);
#pragma unroll
            for (int i = 0; i < 4; ++i) { sA[col + i] = g[i] * (1.0f + a1[i]); sB[col + i] = a0[i]; }
        }
        __syncthreads();
        const size_t rowb = (size_t)blk * 128 + F.wave * 16;
        f32x4 v[8], vn[8];
        { const float* xr = F.kp->in[I_X] + rowb * DM + F.lane * 4;
#pragma unroll
          for (int q = 0; q < 8; ++q) v[q] = *(const f32x4*)(xr + q * 256); }
        for (int i = 0; i < 16; ++i) {
            const size_t row = rowb + i;
            if (i + 1 < 16) { const float* xr = F.kp->in[I_X] + (row + 1) * DM + F.lane * 4;
#pragma unroll
                for (int q = 0; q < 8; ++q) vn[q] = *(const f32x4*)(xr + q * 256); }
            float ss = 0.f;
#pragma unroll
            for (int q = 0; q < 8; ++q) ss += v[q][0] * v[q][0] + v[q][1] * v[q][1] + v[q][2] * v[q][2] + v[q][3] * v[q][3];
            ss = wave_sum(ss);
            const float rstd = rsqrtf(ss * (1.0f / DM) + RMS_EPS);
            bf16_t* hr = F.at<bf16_t>(WS_H) + row * DM + F.lane * 4;
#pragma unroll
            for (int q = 0; q < 8; ++q) { const int col = q * 256 + F.lane * 4;
                const float o0 = v[q][0] * rstd * sA[col] + sB[col], o1 = v[q][1] * rstd * sA[col + 1] + sB[col + 1], o2 = v[q][2] * rstd * sA[col + 2] + sB[col + 2], o3 = v[q][3] * rstd * sA[col + 3] + sB[col + 3];
                u32x2 w = {cvt_pk_bf16(o0, o1), cvt_pk_bf16(o2, o3)}; *(u32x2*)(hr + q * 256) = w;
                *(unsigned*)(F.at<unsigned char>(WS_H8) + row * DM + col) = pk_fp8x4(clamp448(o0), clamp448(o1), clamp448(o2), clamp448(o3)); }
#pragma unroll
            for (int q = 0; q < 8; ++q) v[q] = vn[q];
        }
    }
}

struct EpiStoreBf16 {
    static constexpr bool PERM = true;
    bf16_t* O; int ldc; int colmax;
    DI bool operator()(const f32x4 (&acc)[2][2][4][2], const pg8::Unit& u, int wr, int wc, int fr, int fq) const {
        const int row0 = u.pm * 256 + wr * 64 + fr, col0 = u.pn * 256 + wc * 32 + 8 * fq;
#pragma unroll
        for (int ai = 0; ai < 2; ++ai)
#pragma unroll
            for (int m = 0; m < 4; ++m) { bf16_t* rowp = O + (size_t)(row0 + ai * 128 + m * 16) * ldc + col0;
#pragma unroll
                for (int bj = 0; bj < 2; ++bj) { const f32x4 v0 = acc[ai][bj][m][0], v1 = acc[ai][bj][m][1];
                    u32x4 w; w.x = cvt_pk_bf16(v0[0], v0[1]); w.y = cvt_pk_bf16(v0[2], v0[3]); w.z = cvt_pk_bf16(v1[0], v1[1]); w.w = cvt_pk_bf16(v1[2], v1[3]);
                    if (col0 + bj * 128 < colmax) *(u32x4*)(rowp + bj * 128) = w; } }
        return false;
    }
};
template <int SCALE> struct EpiStoreFp8 {
    static constexpr bool PERM = true;
    unsigned char* O; int ldc;
    DI bool operator()(const f32x4 (&acc)[2][2][4][2], const pg8::Unit& u, int wr, int wc, int fr, int fq) const {
        const int row0 = u.pm * 256 + wr * 64 + fr, col0 = u.pn * 256 + wc * 32 + 8 * fq;
#pragma unroll
        for (int ai = 0; ai < 2; ++ai)
#pragma unroll
            for (int m = 0; m < 4; ++m) { unsigned char* rowp = O + (size_t)(row0 + ai * 128 + m * 16) * ldc + col0;
#pragma unroll
                for (int bj = 0; bj < 2; ++bj) { const f32x4 v0 = acc[ai][bj][m][0] * (float)SCALE, v1 = acc[ai][bj][m][1] * (float)SCALE;
                    u32x2 w; w.x = pk_fp8x4(clamp448(v0[0]), clamp448(v0[1]), clamp448(v0[2]), clamp448(v0[3])); w.y = pk_fp8x4(clamp448(v1[0]), clamp448(v1[1]), clamp448(v1[2]), clamp448(v1[3]));
                    *(u32x2*)(rowp + bj * 128) = w; } }
        return false;
    }
};
struct EpiInFp8 {
    static constexpr bool PERM = true;
    bf16_t* Z; unsigned char* GZ;
    DI bool operator()(const f32x4 (&acc)[2][2][4][2], const pg8::Unit& u, int wr, int wc, int fr, int fq) const {
        const int row0 = u.pm * 256 + wr * 64 + fr, colt = wc * 32 + 8 * fq;
        if (u.pn < NF8 / 256) {
#pragma unroll
            for (int ai = 0; ai < 2; ++ai)
#pragma unroll
                for (int m = 0; m < 4; ++m) { bf16_t* rowp = Z + (size_t)(row0 + ai * 128 + m * 16) * INWP + u.pn * 256 + colt;
#pragma unroll
                    for (int bj = 0; bj < 2; ++bj) { const f32x4 v0 = acc[ai][bj][m][0], v1 = acc[ai][bj][m][1];
                        u32x4 w; w.x = cvt_pk_bf16(v0[0], v0[1]); w.y = cvt_pk_bf16(v0[2], v0[3]); w.z = cvt_pk_bf16(v1[0], v1[1]); w.w = cvt_pk_bf16(v1[2], v1[3]);
                        *(u32x4*)(rowp + bj * 128) = w; } }
        } else {
#pragma unroll
            for (int ai = 0; ai < 2; ++ai)
#pragma unroll
                for (int m = 0; m < 4; ++m) { unsigned char* rowp = GZ + (size_t)(row0 + ai * 128 + m * 16) * 4096 + (u.pn - NF8 / 256) * 256 + colt;
#pragma unroll
                    for (int bj = 0; bj < 2; ++bj) { const f32x4 v0 = acc[ai][bj][m][0] * 16.f, v1 = acc[ai][bj][m][1] * 16.f;
                        u32x2 w; w.x = pk_fp8x4(clamp448(v0[0]), clamp448(v0[1]), clamp448(v0[2]), clamp448(v0[3])); w.y = pk_fp8x4(clamp448(v1[0]), clamp448(v1[1]), clamp448(v1[2]), clamp448(v1[3]));
                        *(u32x2*)(rowp + bj * 128) = w; } }
        }
        return false;
    }
};
template <int K> struct DenseSched {
    pg8::TileOrder ord; unsigned A, Bt;
    DI bool next(int i, pg8::Unit& u) const { int pm, pn; if (!ord.tile(i, pm, pn)) return false;
        u.pm = pm; u.pn = pn; u.e = 0; u.aux = 0; u.A = A + (unsigned)pm * 256u * K * 2u; u.B = Bt + (unsigned)pn * 256u * K * 2u; return true; }
};

DI size_t kidx_off(size_t row, int d) { return ((((row >> 5) * 4 + (size_t)(d >> 4)) * 64) + (size_t)(((d >> 3) & 1) * 32) + (row & 31)) * 8 + (size_t)(d & 7); }
DI void p3_rope(const Frame& F) {
    LAS float* cs = (LAS float*)F.lds;
    bf16_t* z = F.at<bf16_t>(WS_Z); bf16_t* kidx = F.at<bf16_t>(WS_KIDX); float* wif = F.at<float>(WS_WIF);
    bf16_t* kbF = F.at<bf16_t>(WS_KBF); bf16_t* vbF = F.at<bf16_t>(WS_VBF);
    const int* pos = (const int*)F.kp->in[I_POS];
    for (int item = F.wg; item < T / 32; item += F.G) {
        const int b = item >> 8, blk = item & 255, s0 = blk * 32; const size_t row0 = (size_t)b * SEQ + s0;
        __syncthreads();
        for (int e = F.tid; e < 32 * 24; e += NTHR) { const int tok = e / 24, a = e % 24;
            const float ex = a < 16 ? -(float)a * (1.0f / 16.0f) : -(float)(a - 16) * (1.0f / 8.0f);
            const float inv = __builtin_powf(500000.0f, ex);
            const float ang = (float)pos[row0 + tok] * inv;
            const double ad = (double)ang; const double kq = __builtin_rint(ad * 0.15915494309189535); const float r = (float)(ad - kq * 6.283185307179586);
            cs[e * 2] = __cosf(r); cs[e * 2 + 1] = __sinf(r); }
        __syncthreads();
        {
            const int tok = F.tid >> 4, u = F.tid & 15, u7 = u & 7; bf16_t* zr = z + (row0 + tok) * INWP;
            const float c16 = cs[(tok * 24 + u) * 2], s16 = cs[(tok * 24 + u) * 2 + 1], c8 = cs[(tok * 24 + 16 + u7) * 2], s8 = cs[(tok * 24 + 16 + u7) * 2 + 1];
            float x1[19], x2[19];
#pragma unroll
            for (int it = 0; it < 19; ++it) { const int c1 = it < 8 ? C_QA + it * 128 + u : it < 10 ? C_KA + (it - 8) * 128 + u : it < 18 ? C_QI + (2 * (it - 10) + (u >> 3)) * 64 + u7 : C_KI + u7;
                const int dist = it < 10 ? 16 : 8; x1[it] = bf2f(zr[c1]); x2[it] = bf2f(zr[c1 + dist]); }
#pragma unroll
            for (int it = 0; it < 18; ++it) { const int c1 = it < 8 ? C_QA + it * 128 + u : it < 10 ? C_KA + (it - 8) * 128 + u : C_QI + (2 * (it - 10) + (u >> 3)) * 64 + u7;
                const int dist = it < 10 ? 16 : 8; const float cc = it < 10 ? c16 : c8, sn = it < 10 ? s16 : s8;
                zr[c1] = (bf16_t)(cvt_pk_bf16(x1[it] * cc - x2[it] * sn, 0.f) & 0xffffu); zr[c1 + dist] = (bf16_t)(cvt_pk_bf16(x2[it] * cc + x1[it] * sn, 0.f) & 0xffffu); }
            if (u < 8) { kidx[kidx_off(row0 + tok, u7)] = (bf16_t)(cvt_pk_bf16(x1[18] * c8 - x2[18] * s8, 0.f) & 0xffffu); kidx[kidx_off(row0 + tok, u7 + 8)] = (bf16_t)(cvt_pk_bf16(x2[18] * c8 + x1[18] * s8, 0.f) & 0xffffu); }
        }
        {
            unsigned short v[4];
#pragma unroll
            for (int it = 0; it < 4; ++it) { const int j = F.tid + it * NTHR, tok = j >> 6, q = j & 63; const bf16_t* zr = z + (row0 + tok) * INWP; v[it] = q < 48 ? zr[C_KI + 16 + q] : zr[C_WI + q - 48]; }
#pragma unroll
            for (int it = 0; it < 4; ++it) { const int j = F.tid + it * NTHR, tok = j >> 6, q = j & 63;
                if (q < 48) kidx[kidx_off(row0 + tok, 16 + q)] = v[it]; else wif[(row0 + tok) * 16 + (q - 48)] = bf2f(v[it]); }
        }
        {
            u32x4 v[8];
#pragma unroll
            for (int i = 0; i < 8; ++i) { const int id = F.tid + NTHR * i, l = id & 63, kk = (id >> 6) & 7, h = id >> 9; v[i] = *(const u32x4*)(z + (row0 + (l & 31)) * INWP + C_KB + h * 128 + kk * 16 + (l >> 5) * 8); }
#pragma unroll
            for (int i = 0; i < 8; ++i) { const int id = F.tid + NTHR * i, l = id & 63, kk = (id >> 6) & 7, h = id >> 9; *(u32x4*)(kbF + ((((size_t)(b * 8 + h) * 256 + blk) * 8 + kk) * 64 + l) * 8) = v[i]; }
        }
#pragma unroll
        for (int i0 = 0; i0 < 8; i0 += 4) {
            unsigned short e[4][8];
#pragma unroll
            for (int i = 0; i < 4; ++i) { const int id = F.tid + NTHR * (i0 + i), l = id & 63, sb = (id >> 6) & 1, db = (id >> 7) & 3, h = id >> 9;
                const bf16_t* vp = z + (row0 + 16 * sb + 4 * (l >> 5)) * INWP + C_VB + h * 128 + 32 * db + (l & 31);
#pragma unroll
                for (int j = 0; j < 8; ++j) e[i][j] = vp[(size_t)(8 * (j >> 2) + (j & 3)) * INWP]; }
#pragma unroll
            for (int i = 0; i < 4; ++i) { const int id = F.tid + NTHR * (i0 + i), l = id & 63, sb = (id >> 6) & 1, db = (id >> 7) & 3, h = id >> 9;
                u32x4 w = {(unsigned)e[i][0] | ((unsigned)e[i][1] << 16), (unsigned)e[i][2] | ((unsigned)e[i][3] << 16), (unsigned)e[i][4] | ((unsigned)e[i][5] << 16), (unsigned)e[i][6] | ((unsigned)e[i][7] << 16)};
                *(u32x4*)(vbF + (((((size_t)(b * 8 + h) * 256 + blk) * 4 + db) * 2 + sb) * 64 + l) * 8) = w; }
        }
    }
}

#define MFMA32(a, b, c) __builtin_amdgcn_mfma_f32_32x32x16_bf16((a), (b), (c), 0, 0, 0)
DI void idx_chunk(const Frame& F, int b, int c) {
    const int l = F.lane, m = l & 31, hi = l >> 5, q = (m >> 2) & 1, head = ((m >> 3) << 2) | (m & 3);
    const int t0 = 64 * c + 8 * F.wave;
    const bf16_t* z = F.at<bf16_t>(WS_Z); const float* wif = F.at<float>(WS_WIF);
    bf16x8 Aq[4][4]; f32x4 wv[4][4];
#pragma unroll
    for (int p = 0; p < 4; ++p) { const bf16_t* qp = z + ((size_t)b * SEQ + t0 + 2 * p + q) * INWP + C_QI + head * 64 + hi * 8;
#pragma unroll
        for (int kk = 0; kk < 4; ++kk) Aq[p][kk] = *(const bf16x8*)(qp + kk * 16);
        const float* wp = wif + ((size_t)b * SEQ + t0 + 2 * p + hi) * 16;
#pragma unroll
        for (int r4 = 0; r4 < 4; ++r4) wv[p][r4] = *(const f32x4*)(wp + 4 * r4); }
    const int nblk = 2 * (c + 1), L = 64 * (c + 1);
    const bf16x8* kf = F.at<bf16x8>(WS_KIDX) + ((size_t)b * SEQ >> 5) * 4 * 64 + l;
    float* scb = F.at<float>(WS_SC) + (size_t)b * SC_PER_B + (size_t)2048 * c * (c + 1) + (size_t)(8 * F.wave + hi) * L + m;
    bf16x8 Bc[4], Bn[4];
#pragma unroll
    for (int kk = 0; kk < 4; ++kk) Bc[kk] = kf[kk * 64];
    auto blk_iter = [&](int blk) __attribute__((always_inline)) {
        { const bf16x8* kn = kf + (size_t)(blk + 1 < nblk ? blk + 1 : blk) * 4 * 64;
#pragma unroll
          for (int kk = 0; kk < 4; ++kk) Bn[kk] = kn[kk * 64]; }
#pragma unroll
        for (int p = 0; p < 4; ++p) {
            f32x16 acc = {};
#pragma unroll
            for (int kk = 0; kk < 4; ++kk) acc = MFMA32(Aq[p][kk], Bc[kk], acc);
            float sc_ = 0.f;
#pragma unroll
            for (int r = 0; r < 16; ++r) sc_ = fmaf(__int_as_float(max(__float_as_int(acc[r]), 0)), wv[p][r >> 2][r & 3], sc_);
            scb[(size_t)(2 * p) * L + blk * 32] = sc_;
            if (p & 1) __builtin_amdgcn_sched_barrier(0);
        }
#pragma unroll
        for (int kk = 0; kk < 4; ++kk) Bc[kk] = Bn[kk];
    };
    blk_iter(0);
#pragma unroll 1
    for (int blk = 1; blk < nblk; ++blk) blk_iter(blk);
}
DI void p4_indexer(const Frame& F) {
    for (int item = F.wg; item < 256; item += F.G) { const int b = item >> 6, pi = item & 63; idx_chunk(F, b, pi); idx_chunk(F, b, 127 - pi); }
}

DI unsigned f2key(float f) { const unsigned u = __float_as_uint(f); return u ^ ((unsigned)((int)u >> 31) | 0x80000000u); }
DI unsigned umed3(unsigned a, unsigned b, unsigned c) { const unsigned mx = a > b ? a : b, mn = a > b ? b : a; const unsigned t = mx < c ? mx : c; return mn > t ? mn : t; }
DI int wave_allsum(int v) {
    v += __builtin_amdgcn_update_dpp(0, v, 0xB1, 0xF, 0xF, false);
    v += __builtin_amdgcn_update_dpp(0, v, 0x4E, 0xF, 0xF, false);
    v += __builtin_amdgcn_update_dpp(0, v, 0x141, 0xF, 0xF, false);
    v += __builtin_amdgcn_update_dpp(0, v, 0x140, 0xF, 0xF, false);
    { auto r = __builtin_amdgcn_permlane16_swap((unsigned)v, (unsigned)v, false, false); v = (int)(r[0] + r[1]); }
    { auto r = __builtin_amdgcn_permlane32_swap((unsigned)v, (unsigned)v, false, false); v = (int)(r[0] + r[1]); }
    return v;
}
template <int NBITS> DI int wave_total(int pl) { int tot = 0;
#pragma unroll
    for (int b = 0; b < NBITS; ++b) tot += __popcll(__ballot((pl >> b) & 1)) << b;
    return tot; }
constexpr int NCVW = 2, NPW = NWAVES - NCVW;
constexpr int CVJ1 = NE * 32 * 64, CVJ2 = NE * 32 * 32, CVJ = CVJ1 + CVJ2;
struct CvJob { const float* src; unsigned char* dst; int N; };
DI CvJob cv_job(const Frame& F, int job) {
    CvJob J;
    if (job < CVJ1) { const int e = job >> 11, r = job & 2047, kt = r >> 6, nt = r & 63; J.N = 4096;
        J.src = F.kp->in[I_W1] + (size_t)e * 2048 * 4096 + (size_t)(kt * 64) * 4096 + nt * 64; J.dst = F.at<unsigned char>(WS_W1T) + (size_t)e * 4096 * 2048 + (size_t)(nt * 64) * 2048 + kt * 64; }
    else { const int j2 = job - CVJ1, e = j2 >> 10, r = j2 & 1023, kt = r >> 5, nt = r & 31; J.N = 2048;
        J.src = F.kp->in[I_W2] + (size_t)e * 2048 * 2048 + (size_t)(kt * 64) * 2048 + nt * 64; J.dst = F.at<unsigned char>(WS_W2T) + (size_t)e * 2048 * 2048 + (size_t)(nt * 64) * 2048 + kt * 64; }
    return J;
}
DI void cv_load(const CvJob& J, int l, f32x4 (&v)[16]) {
    const float* p = J.src + (size_t)((l >> 4) * 8) * J.N + (l & 15) * 4;
#pragma unroll
    for (int h = 0; h < 2; ++h)
#pragma unroll
        for (int i = 0; i < 8; ++i) v[h * 8 + i] = *(const f32x4*)(p + (size_t)(h * 32 + i) * J.N);
}
DI void cv_finish(const CvJob& J, int l, const f32x4 (&v)[16], LAS unsigned char* Tl) {
    const int c4 = (l & 15) * 4, g = l >> 4;
#pragma unroll
    for (int h = 0; h < 2; ++h)
#pragma unroll
        for (int q = 0; q < 2; ++q)
#pragma unroll
            for (int j = 0; j < 4; ++j)
                *(LAS unsigned*)(Tl + (c4 + j) * 80 + h * 32 + g * 8 + q * 4) = pk_fp8x4(clamp448(v[h * 8 + q * 4][j] * 32.f), clamp448(v[h * 8 + q * 4 + 1][j] * 32.f), clamp448(v[h * 8 + q * 4 + 2][j] * 32.f), clamp448(v[h * 8 + q * 4 + 3][j] * 32.f));
    u32x4 o[4];
#pragma unroll
    for (int p = 0; p < 4; ++p) o[p] = *(LAS const u32x4*)(Tl + ((l >> 2) + 16 * p) * 80 + (l & 3) * 16);
#pragma unroll
    for (int p = 0; p < 4; ++p) *(u32x4*)(J.dst + (size_t)((l >> 2) + 16 * p) * 2048 + (l & 3) * 16) = o[p];
}
DI void cv_stream(const Frame& F) {
    const int cw = F.wg * NCVW + (F.wave - NPW), ncw = F.G * NCVW, l = F.lane;
    LAS unsigned char* Tl = F.lds + 8192 + F.wave * 16640;
#pragma unroll 1
    for (int job = cw; job < CVJ; job += 6 * ncw) {
        f32x4 va[16], vb[16], vc[16];
        const int j1 = job + ncw, j2 = job + 2 * ncw, j3 = job + 3 * ncw, j4 = job + 4 * ncw, j5 = job + 5 * ncw;
        const CvJob J0 = cv_job(F, job), J1 = cv_job(F, j1 < CVJ ? j1 : job), J2 = cv_job(F, j2 < CVJ ? j2 : job);
#define CV_SB __builtin_amdgcn_sched_barrier(0)
        cv_load(J0, l, va); CV_SB; cv_load(J1, l, vb); CV_SB; cv_load(J2, l, vc); CV_SB;
        cv_finish(J0, l, va, Tl); CV_SB;
        const CvJob J3 = cv_job(F, j3 < CVJ ? j3 : job); cv_load(J3, l, va); CV_SB;
        if (j1 < CVJ) cv_finish(J1, l, vb, Tl);
        CV_SB;
        const CvJob J4 = cv_job(F, j4 < CVJ ? j4 : job); cv_load(J4, l, vb); CV_SB;
        if (j2 < CVJ) cv_finish(J2, l, vc, Tl);
        CV_SB;
        const CvJob J5 = cv_job(F, j5 < CVJ ? j5 : job); cv_load(J5, l, vc); CV_SB;
        if (j3 < CVJ) cv_finish(J3, l, va, Tl);
        CV_SB;
        if (j4 < CVJ) cv_finish(J4, l, vb, Tl);
        CV_SB;
        if (j5 < CVJ) cv_finish(J5, l, vc, Tl);
#undef CV_SB
    }
}
DI int p56_grab(LAS int* ctr, int lane) { int j = 0; if (lane == 0) j = __hip_atomic_fetch_add(ctr, 1, __ATOMIC_RELAXED, __HIP_MEMORY_SCOPE_WORKGROUP); return __builtin_amdgcn_readfirstlane(j); }
constexpr int P56_CTR = LDS_BYTES - 64;
DI void p5_select(const Frame& F) {
    { LAS int* ctr0 = (LAS int*)(F.lds + P56_CTR); if (F.tid < 2) ctr0[F.tid] = 0; __syncthreads(); }
    if (F.wave >= NPW) cv_stream(F);
    unsigned long long* sel = F.at<unsigned long long>(WS_SEL); const float* sc = F.at<float>(WS_SC);
    const int lane = F.lane;
    LAS int* ctr = (LAS int*)(F.lds + P56_CTR);
    LAS unsigned long long* wsl = (LAS unsigned long long*)(F.lds + F.wave * 1024);
    LAS unsigned* cl = (LAS unsigned*)(F.lds + 8192 + F.wave * 16640);
    for (;;) {
        const int row = p56_grab(ctr, lane) * F.G + F.wg; if (row >= T) break;
        const int b = row >> 13, t = row & 8191, c = t >> 6;
        if (c < 4) { if (lane <= c) sel[(size_t)row * 128 + lane] = ~0ull; continue; }
        const float* rowp = sc + (size_t)b * SC_PER_B + (size_t)2048 * c * (c + 1) + (size_t)(t & 63) * 64 * (c + 1);
        unsigned k[128];
        {
            float kf[128];
#pragma unroll
            for (int g = 0; g < 8; ++g) { const float* rg_ = rowp + ((g * 16 <= c) ? g * 1024 : 0);
#pragma unroll
                for (int i = 0; i < 16; ++i) kf[g * 16 + i] = rg_[(unsigned)(i * 64 + lane)]; }
#pragma unroll
            for (int i = 0; i < 128; ++i) k[i] = (i <= c) ? f2key(kf[i]) : 0u;
        }
        unsigned ta = 0u, tb = 0u, tc = 0u, td = 0u;
#pragma unroll
        for (int g = 0; g < 4; ++g) { if (g * 32 <= c) {
#pragma unroll
            for (int i = g * 32; i < g * 32 + 32; ++i) { const unsigned x = k[i]; const unsigned nd = umed3(tc, td, x), nc = umed3(tb, tc, x), nb = umed3(ta, tb, x); ta = ta > x ? ta : x; tb = nb; tc = nc; td = nd; } } }
        unsigned L = td;
#pragma unroll
        for (int o = 32; o >= 1; o >>= 1) { const unsigned y = (unsigned)__shfl_xor((int)L, o); L = L < y ? L : y; }
        unsigned wa = (unsigned)lane * 4u;
#pragma unroll
        for (int g = 0; g < 4; ++g) { if (g * 32 <= c) {
#pragma unroll
            for (int i = g * 32; i < g * 32 + 32; ++i) { *(LAS unsigned*)((LAS char*)cl + wa) = k[i]; wa += (k[i] >= L && wa < 64u * 256u) ? 256u : 0u; } } }
        const int npl = (int)(wa >> 8);
        int mx = npl;
#pragma unroll
        for (int o = 32; o >= 1; o >>= 1) { const int y = __shfl_xor(mx, o); mx = mx > y ? mx : y; }
        asm volatile("s_waitcnt lgkmcnt(0)" ::: "memory");
        unsigned U = ta;
#pragma unroll
        for (int o = 32; o >= 1; o >>= 1) { const unsigned y = (unsigned)__shfl_xor((int)U, o); U = U > y ? U : y; }
        const unsigned dif = (unsigned)__builtin_amdgcn_readfirstlane((int)(L ^ U));
        const int hb = dif ? 31 - __builtin_clz(dif) : -1;
        unsigned pfx = (hb >= 31) ? 0u : (hb < 0 ? L : (L & ~((2u << hb) - 1u)));
        int cge, cgt;
        if (mx <= 24) {
            unsigned cc[24];
#pragma unroll
            for (int j = 0; j < 24; ++j) { const unsigned v = cl[j * 64 + lane]; cc[j] = (j < npl) ? v : 0u; asm volatile("" : "+v"(cc[j])); }
            for (int bit = hb; bit >= 0; --bit) { const unsigned cand = pfx | (1u << bit); int pl = 0;
#pragma unroll
                for (int j = 0; j < 24; ++j) pl += (cc[j] >= cand) ? 1 : 0;
                pfx = (wave_allsum(pl) >= 256) ? cand : pfx; }
            int p1 = 0, p2 = 0;
#pragma unroll
            for (int j = 0; j < 24; ++j) { p1 += (cc[j] >= pfx) ? 1 : 0; p2 += (cc[j] > pfx) ? 1 : 0; }
            cge = __builtin_amdgcn_readfirstlane(wave_allsum(p1)); cgt = __builtin_amdgcn_readfirstlane(wave_allsum(p2));
        } else {
            for (int bit = hb; bit >= 0; --bit) { const unsigned cand = pfx | (1u << bit); int pl = 0;
#pragma unroll
                for (int i = 0; i < 128; ++i) pl += (k[i] >= cand) ? 1 : 0;
                pfx = (wave_allsum(pl) >= 256) ? cand : pfx; }
            unsigned thrc = pfx; asm volatile("" : "+v"(thrc));
            int p1 = 0, p2 = 0;
#pragma unroll
            for (int i = 0; i < 128; ++i) { p1 += (k[i] >= thrc) ? 1 : 0; p2 += (k[i] > thrc) ? 1 : 0; }
            cge = __builtin_amdgcn_readfirstlane(wave_allsum(p1)); cgt = __builtin_amdgcn_readfirstlane(wave_allsum(p2));
        }
        const unsigned prefix = (unsigned)__builtin_amdgcn_readfirstlane((int)pfx);
        const unsigned thr = prefix;
        if (cge == 256) {
#pragma unroll
            for (int g = 0; g < 32; ++g) { if ((g >> 3) * 32 <= c) { unsigned long long w4[4];
#pragma unroll
                for (int j = 0; j < 4; ++j) w4[j] = __ballot(k[g * 4 + j] >= thr);
                if (lane == 0) {
#pragma unroll
                    for (int j = 0; j < 4; ++j) wsl[g * 4 + j] = w4[j]; }
                __builtin_amdgcn_sched_barrier(0); } }
        } else {
            const int allowed = 256 - cgt; int R = 0;
#pragma unroll
            for (int i = 0; i < 128; ++i) {
                unsigned long long gtm = __ballot(k[i] > thr), tm = __ballot(k[i] == thr);
                const int nt = __popcll(tm);
                if (R + nt > allowed) { int keepn = allowed - R; if (keepn < 0) keepn = 0; while (__popcll(tm) > keepn) tm &= ~(1ull << (63 - __clzll(tm))); }
                R += nt;
                const unsigned long long word = gtm | tm;
                if (lane == 0) wsl[i] = word;
                if ((i & 3) == 3) __builtin_amdgcn_sched_barrier(0);
            }
        }
        asm volatile("s_waitcnt lgkmcnt(0)" ::: "memory");
        if (lane <= c) sel[(size_t)row * 128 + lane] = wsl[lane];
        if (lane + 64 <= c) sel[(size_t)row * 128 + 64 + lane] = wsl[64 + lane];
    }
}

DI bf16x8 pack8(const f32x16& x, int s) {
    const u32x4 p = {cvt_pk_bf16(x[8 * s], x[8 * s + 1]), cvt_pk_bf16(x[8 * s + 2], x[8 * s + 3]), cvt_pk_bf16(x[8 * s + 4], x[8 * s + 5]), cvt_pk_bf16(x[8 * s + 6], x[8 * s + 7])};
    return __builtin_bit_cast(bf16x8, p);
}
DI void p6_stick(const Frame& F) {
    const int l = F.lane, n = l & 31, hi = l >> 5;
    const bf16_t* z = F.at<bf16_t>(WS_Z); const bf16x8* kbF = F.at<bf16x8>(WS_KBF); const bf16x8* vbF = F.at<bf16x8>(WS_VBF); bf16_t* ob = F.at<bf16_t>(WS_OB);
    constexpr float C2 = 0.088388347648318440f * 1.4426950408889634f;
    LAS int* ctr = (LAS int*)(F.lds + P56_CTR) + 1;
    for (;;) {
        const int u = p56_grab(ctr, l) * F.G + F.wg; if (u >= NB * 8 * 256) break;
        const int qt = 255 - (u >> 5), bh = u & 31, b = bh >> 3, h = bh & 7, t0 = qt * 32;
        bf16x8 Bq[8];
        { const bf16_t* qp = z + ((size_t)b * SEQ + t0 + n) * INWP + C_QB + h * 128 + hi * 8;
#pragma unroll
          for (int kk = 0; kk < 8; ++kk) Bq[kk] = *(const bf16x8*)(qp + kk * 16); }
        f32x16 oT[4] = {};
        float carry = 0.f;
        bf16x8 Kn[8];
        { const bf16x8* kc0 = kbF + (((size_t)(b * 8 + h) * 256 + qt) * 8) * 64 + l;
#pragma unroll
          for (int kk = 0; kk < 8; ++kk) Kn[kk] = kc0[kk * 64]; }
        bf16x8 Vn[8];
        { const bf16x8* vc0 = vbF + (((size_t)(b * 8 + h) * 256 + qt) * 8) * 64 + l;
#pragma unroll
          for (int kk = 0; kk < 8; ++kk) Vn[kk] = vc0[kk * 64]; }
        for (int kb = qt; kb >= 0; --kb) {
            const bf16x8* kc = kbF + (((size_t)(b * 8 + h) * 256 + (kb > 0 ? kb - 1 : 0)) * 8) * 64 + l;
            const bf16x8* vc = vbF + (((size_t)(b * 8 + h) * 256 + (kb > 0 ? kb - 1 : 0)) * 8) * 64 + l;
            bf16x8 Ka[8], Va[8];
#pragma unroll
            for (int kk = 0; kk < 8; ++kk) { Ka[kk] = Kn[kk]; Va[kk] = Vn[kk]; }
#pragma unroll
            for (int kk = 0; kk < 8; ++kk) Kn[kk] = kc[kk * 64];
#pragma unroll
            for (int kk = 0; kk < 8; ++kk) Vn[kk] = vc[kk * 64];
            f32x16 S = {};
#pragma unroll
            for (int kk = 0; kk < 8; ++kk) S = MFMA32(Ka[kk], Bq[kk], S);
            const bool diag = (kb == qt);
            float lk[16], lb[16];
#pragma unroll
            for (int r = 0; r < 16; ++r) {
                const float z2 = S[r] * C2;
                const float e = __builtin_amdgcn_exp2f(-__builtin_fabsf(z2));
                const float sp = fmaxf(z2, 0.f) + __builtin_amdgcn_logf(1.0f + e);
                const int srel = (r & 3) + 8 * (r >> 2) + 4 * hi;
                const bool causal = !diag || (srel < n);
                lk[r] = causal ? -sp : 0.f; lb[r] = z2 - sp;
                S[r] = causal ? 0.f : -1e30f;
            }
            float G[4];
#pragma unroll
            for (int q = 0; q < 4; ++q) G[q] = (lk[4 * q] + lk[4 * q + 1]) + (lk[4 * q + 2] + lk[4 * q + 3]);
            float Ev[4], Ov[4];
#pragma unroll
            for (int q = 0; q < 4; ++q) { auto rr = __builtin_amdgcn_permlane32_swap(__float_as_uint(G[q]), __float_as_uint(G[q]), false, false); Ev[q] = __uint_as_float(rr[0]); Ov[q] = __uint_as_float(rr[1]); }
            float Rq[4]; Rq[3] = 0.f; Rq[2] = Ev[3] + Ov[3]; Rq[1] = Rq[2] + (Ev[2] + Ov[2]); Rq[0] = Rq[1] + (Ev[1] + Ov[1]);
            const float tot = Rq[0] + (Ev[0] + Ov[0]);
#pragma unroll
            for (int q = 0; q < 4; ++q) {
                const float base = carry + Rq[q] + (hi ? 0.f : Ov[q]);
                const float g3 = base, g2 = g3 + lk[4 * q + 3], g1 = g2 + lk[4 * q + 2], g0 = g1 + lk[4 * q + 1];
                S[4 * q + 3] = __builtin_amdgcn_exp2f(lb[4 * q + 3] + g3 + S[4 * q + 3]);
                S[4 * q + 2] = __builtin_amdgcn_exp2f(lb[4 * q + 2] + g2 + S[4 * q + 2]);
                S[4 * q + 1] = __builtin_amdgcn_exp2f(lb[4 * q + 1] + g1 + S[4 * q + 1]);
                S[4 * q + 0] = __builtin_amdgcn_exp2f(lb[4 * q + 0] + g0 + S[4 * q + 0]);
            }
            carry += tot;
            const bf16x8 P0 = pack8(S, 0), P1 = pack8(S, 1);
#pragma unroll
            for (int db = 0; db < 4; ++db) { oT[db] = MFMA32(Va[db * 2], P0, oT[db]); oT[db] = MFMA32(Va[db * 2 + 1], P1, oT[db]); }
            if (__all(carry < -150.5f)) break;
        }
        unsigned char* op = (unsigned char*)ob + ((size_t)b * SEQ + t0 + n) * 1024 + h * 128 + 4 * hi;
#pragma unroll
        for (int db = 0; db < 4; ++db)
#pragma unroll
            for (int q = 0; q < 4; ++q) *(unsigned*)(op + 32 * db + 8 * q) = pk_fp8x4(clamp448(oT[db][4 * q] * 32.f), clamp448(oT[db][4 * q + 1] * 32.f), clamp448(oT[db][4 * q + 2] * 32.f), clamp448(oT[db][4 * q + 3] * 32.f));
    }
}

namespace dsa {
constexpr float SCALE = 0.088388347648318440f, THR = 8.f;
constexpr int SHM_V = 64 * 128 * 2, SHM_K = 64 * 128 * 2, SHM_ATTN = 2 * SHM_V + 2 * SHM_K + 8 * 64 * 4;
#define KSWZ(row, colB) ((row) * 256 + ((colB) ^ (((row) & 7) << 4)))
#define SBAR() __builtin_amdgcn_sched_barrier(0)
DI int crow(int r, int hi) { return (r & 3) + 8 * (r >> 2) + 4 * hi; }
DI void apply_mask(f32x16& p0, f32x16& p1, unsigned long long w, int hi) {
    const unsigned lo = (unsigned)w >> (4 * hi), up = (unsigned)(w >> 32) >> (4 * hi);
#pragma unroll
    for (int r = 0; r < 16; ++r) { const int bp = (r & 3) + 8 * (r >> 2);
        const unsigned t0 = (unsigned)(((int)(lo << (31 - bp))) >> 31), t1 = (unsigned)(((int)(up << (31 - bp))) >> 31);
        p0[r] = __uint_as_float((__float_as_uint(p0[r]) & t0) | (~t0 & 0xff800000u));
        p1[r] = __uint_as_float((__float_as_uint(p1[r]) & t1) | (~t1 & 0xff800000u)); }
}
DI void partialSM(f32x16& p0, f32x16& p1, float& m_reg, float& mn, float& alpha) {
    constexpr float C = SCALE * 1.4426950408889634f;
    float pmax = p0[0];
#pragma unroll
    for (int r = 1; r < 16; ++r) pmax = fmaxf(pmax, p0[r]);
#pragma unroll
    for (int r = 0; r < 16; ++r) pmax = fmaxf(pmax, p1[r]);
    { auto rr = __builtin_amdgcn_permlane32_swap(__float_as_uint(pmax), __float_as_uint(pmax), false, false);
      pmax = fmaxf(__uint_as_float(rr[0]), __uint_as_float(rr[1])); }
    if (__builtin_expect(__all(pmax - m_reg <= THR / SCALE), 1)) { mn = m_reg; alpha = 1.f; }
    else { mn = fmaxf(m_reg, pmax); alpha = __builtin_amdgcn_exp2f((m_reg - mn) * C); m_reg = mn; }
    const float mnC = -mn * C;
#pragma unroll
    for (int r = 0; r < 16; ++r) p0[r] = fmaf(p0[r], C, mnC);
#pragma unroll
    for (int r = 0; r < 16; ++r) p1[r] = fmaf(p1[r], C, mnC);
#pragma unroll
    for (int r = 0; r < 16; ++r) p0[r] = __builtin_amdgcn_exp2f(p0[r]);
}
DI void finishSM(f32x16& p0, f32x16& p1, float alpha, float& l_reg, bf16x8& pa0, bf16x8& pa1, bf16x8& pa2, bf16x8& pa3) {
#pragma unroll
    for (int r = 0; r < 16; ++r) p1[r] = __builtin_amdgcn_exp2f(p1[r]);
    float ps = 0;
#pragma unroll
    for (int r = 0; r < 16; ++r) ps += p0[r];
#pragma unroll
    for (int r = 0; r < 16; ++r) ps += p1[r];
    { auto rr = __builtin_amdgcn_permlane32_swap(__float_as_uint(ps), __float_as_uint(ps), false, false);
      ps = __uint_as_float(rr[0]) + __uint_as_float(rr[1]); }
    l_reg = l_reg * alpha + ps;
#define PK4(P, BASE, OUT) do { unsigned a0 = cvt_pk_bf16(P[BASE + 0], P[BASE + 1]), a1 = cvt_pk_bf16(P[BASE + 2], P[BASE + 3]);   \
    unsigned b0 = cvt_pk_bf16(P[BASE + 4], P[BASE + 5]), b1 = cvt_pk_bf16(P[BASE + 6], P[BASE + 7]);                              \
    auto r0 = __builtin_amdgcn_permlane32_swap(a0, b0, false, false); auto r1 = __builtin_amdgcn_permlane32_swap(a1, b1, false, false); \
    u32x4 w = {r0[0], r1[0], r0[1], r1[1]}; OUT = __builtin_bit_cast(bf16x8, w); } while (0)
    PK4(p0, 0, pa0); PK4(p0, 8, pa1); PK4(p1, 0, pa2); PK4(p1, 8, pa3);
#undef PK4
}
DI void qkt(f32x16& p0, f32x16& p1, LAS const char* Ks, const bf16x8* qr, int r32, int hi) {
    p0 = f32x16{}; p1 = f32x16{};
#pragma unroll
    for (int d0 = 0; d0 < 8; ++d0) { const int cb = (d0 * 16 + hi * 8) * 2;
        const bf16x8 b0 = *(LAS const bf16x8*)(Ks + KSWZ(r32, cb));
        const bf16x8 b1 = *(LAS const bf16x8*)(Ks + KSWZ(32 + r32, cb));
        p0 = MFMA32(b0, qr[d0], p0);
        p1 = MFMA32(b1, qr[d0], p1); }
}
DI int v_st(int k, int c) { const int kk = (k & ~0xC) | ((k & 4) << 1) | ((k & 8) >> 1); return ((kk >> 3) * 4 + (c >> 5)) * 512 + ((kk & 7) * 32 + (c & 31)) * 2; }
DI int v_rd_base(int lane) { return ((lane & 3) << 3) | (((lane >> 2) & 3) << 6) | (((lane >> 4) & 1) << 5) | (((lane >> 5) & 1) << 8); }
constexpr int v_rd_off(int d0, int ks, int half) { return d0 * 512 + ks * 4096 + half * 2048; }
template <int OFF> DI s16x4 tr_read(int vb) { s16x4 r; asm volatile("ds_read_b64_tr_b16 %0, %1 offset:%2" : "=&v"(r) : "v"(vb), "i"(OFF) : "memory"); return r; }
template <int D0> DI void pv_one(f32x16& od, int vb, bf16x8 pa0, bf16x8 pa1, bf16x8 pa2, bf16x8 pa3) {
    const s16x4 l0 = tr_read<v_rd_off(D0, 0, 0)>(vb), h0 = tr_read<v_rd_off(D0, 0, 1)>(vb), l1 = tr_read<v_rd_off(D0, 1, 0)>(vb), h1 = tr_read<v_rd_off(D0, 1, 1)>(vb);
    const s16x4 l2 = tr_read<v_rd_off(D0, 2, 0)>(vb), h2 = tr_read<v_rd_off(D0, 2, 1)>(vb), l3 = tr_read<v_rd_off(D0, 3, 0)>(vb), h3 = tr_read<v_rd_off(D0, 3, 1)>(vb);
    asm volatile("s_waitcnt lgkmcnt(0)" ::: "memory"); SBAR();
#define PKV(L, H) (bf16x8){L[0], L[1], L[2], L[3], H[0], H[1], H[2], H[3]}
    od = MFMA32(pa0, PKV(l0, h0), od);
    od = MFMA32(pa1, PKV(l1, h1), od);
    od = MFMA32(pa2, PKV(l2, h2), od);
    od = MFMA32(pa3, PKV(l3, h3), od);
#undef PKV
}
DI void pv_d0(f32x16* o, int vb, bf16x8 pa0, bf16x8 pa1, bf16x8 pa2, bf16x8 pa3) {
    pv_one<0>(o[0], vb, pa0, pa1, pa2, pa3); pv_one<1>(o[1], vb, pa0, pa1, pa2, pa3); pv_one<2>(o[2], vb, pa0, pa1, pa2, pa3); pv_one<3>(o[3], vb, pa0, pa1, pa2, pa3);
}
DI void unit(const bf16_t* __restrict__ Qw, const bf16_t* __restrict__ Kh, const bf16_t* __restrict__ Vh, const unsigned long long* __restrict__ selw, int NT,
             bf16_t* __restrict__ Ob, LAS char* lds) {
    const int tid = threadIdx.x, wid = tid >> 6, lane = tid & 63, r32 = lane & 31, hi = lane >> 5;
    constexpr long LDK = INWP;
    LAS char* V_lds = lds; LAS char* K_lds = lds + 2 * SHM_V;
    LAS float* wsl = (LAS float*)(lds + 2 * SHM_V + 2 * SHM_K) + wid * 64; LAS float* li_l = wsl; LAS float* al_l = wsl + 32;
    float m_reg = -1e30f, l_reg = 0; f32x16 o[4] = {}; bf16x8 qr[8];
#pragma unroll
    for (int d0 = 0; d0 < 8; ++d0) qr[d0] = *(const bf16x8*)(Qw + d0 * 16);
    const int sr = tid >> 4, sc = (tid & 15) * 8, vst0 = v_st(sr, sc), vst1 = v_st(32 + sr, sc);
    const int vb0 = (int)(uintptr_t)V_lds + v_rd_base(lane);
    struct { bf16x8 vs0, vs1, ks0, ks1; } sr_[1];
    const int NTe = (NT + 1) & ~1;
    const unsigned soff0 = (unsigned)(sr * (int)LDK + sc) * 2u, soff1 = soff0 + 32u * (unsigned)LDK * 2u;
#define SLOAD(i, k0) do { const char* vb_ = (const char*)Vh + (size_t)(k0) * LDK * 2; const char* kb_ = (const char*)Kh + (size_t)(k0) * LDK * 2; \
    sr_[i].vs0 = *(const bf16x8*)(vb_ + soff0); sr_[i].vs1 = *(const bf16x8*)(vb_ + soff1); sr_[i].ks0 = *(const bf16x8*)(kb_ + soff0); sr_[i].ks1 = *(const bf16x8*)(kb_ + soff1); } while (0)
#define SWRITE(b, i) do { *(LAS bf16x8*)(V_lds + (b) * SHM_V + vst0) = sr_[i].vs0;          \
    *(LAS bf16x8*)(V_lds + (b) * SHM_V + vst1) = sr_[i].vs1; const int kc = sc * 2;               \
    *(LAS bf16x8*)(K_lds + (b) * SHM_K + KSWZ(sr, kc)) = sr_[i].ks0;                       \
    *(LAS bf16x8*)(K_lds + (b) * SHM_K + KSWZ(32 + sr, kc)) = sr_[i].ks1; } while (0)
#define SWAIT() asm volatile("s_waitcnt vmcnt(0)" ::: "memory")
#define RESC(a) do { if (__any((a) < 1.f)) { if (hi == 0) al_l[r32] = (a); asm volatile("s_waitcnt lgkmcnt(0)" ::: "memory"); \
    _Pragma("unroll") for (int d = 0; d < 4; ++d) _Pragma("unroll") for (int r = 0; r < 16; ++r) o[d][r] *= al_l[crow(r, hi)]; } } while (0)
    const unsigned seloff = (unsigned)r32 * 1024u;
#define MASKW(jt) (((jt) < NT) ? *(const unsigned long long*)((const char*)(selw + (jt)) + seloff) : 0ull)
    f32x16 pA0, pA1, pB0, pB1; float mnA, mnB, alA, alB; bf16x8 pa0, pa1, pa2, pa3;
    unsigned long long mA, mB;
    constexpr int SE = 0, SO = 0;
    mA = MASKW(0);
    SLOAD(SE, 0); asm volatile("s_waitcnt vmcnt(0)" ::: "memory"); SWRITE(0, SE); __syncthreads();
    qkt(pA0, pA1, K_lds, qr, r32, hi); apply_mask(pA0, pA1, mA, hi); partialSM(pA0, pA1, m_reg, mnA, alA);
    SLOAD(SO, 64);
    SWAIT(); SWRITE(1, SO); __syncthreads();
    for (int j = 1; j + 1 < NTe; j += 2) {
        mB = MASKW(j);
        SBAR(); qkt(pB0, pB1, K_lds + SHM_K, qr, r32, hi);
        finishSM(pA0, pA1, alA, l_reg, pa0, pa1, pa2, pa3); SBAR();
        SLOAD(SO, (j + 1) * 64); SBAR();
        pv_d0(o, vb0, pa0, pa1, pa2, pa3); apply_mask(pB0, pB1, mB, hi); partialSM(pB0, pB1, m_reg, mnB, alB);
        __syncthreads(); SWAIT(); SWRITE(0, SE);
        RESC(alB); __syncthreads();
        mA = MASKW(j + 1);
        SBAR(); qkt(pA0, pA1, K_lds, qr, r32, hi);
        finishSM(pB0, pB1, alB, l_reg, pa0, pa1, pa2, pa3); SBAR();
        SLOAD(SE, (j + 2) * 64); SBAR();
        pv_d0(o, vb0 + SHM_V, pa0, pa1, pa2, pa3); apply_mask(pA0, pA1, mA, hi); partialSM(pA0, pA1, m_reg, mnA, alA);
        __syncthreads(); SWAIT(); SWRITE(1, SO);
        RESC(alA); __syncthreads();
    }
    mB = MASKW(NTe - 1);
    SBAR(); qkt(pB0, pB1, K_lds + SHM_K, qr, r32, hi);
    finishSM(pA0, pA1, alA, l_reg, pa0, pa1, pa2, pa3); SBAR();
    pv_d0(o, vb0, pa0, pa1, pa2, pa3); apply_mask(pB0, pB1, mB, hi); partialSM(pB0, pB1, m_reg, mnB, alB);
    __syncthreads(); RESC(alB);
    finishSM(pB0, pB1, alB, l_reg, pa0, pa1, pa2, pa3); SBAR();
    pv_d0(o, vb0 + SHM_V, pa0, pa1, pa2, pa3);
    if (hi == 0) li_l[r32] = l_reg; asm volatile("s_waitcnt lgkmcnt(0)" ::: "memory");
    float rli[16];
#pragma unroll
    for (int r = 0; r < 16; ++r) rli[r] = __builtin_amdgcn_rcpf(li_l[crow(r, hi)]);
#pragma unroll
    for (int r = 0; r < 16; ++r) { const int orow = crow(r, hi);
#pragma unroll
        for (int d0 = 0; d0 < 4; ++d0) ((unsigned char*)Ob)[(long)orow * 1024 + d0 * 32 + r32] = (unsigned char)(pk_fp8x4(clamp448(o[d0][r] * rli[r] * 32.f), 0.f, 0.f, 0.f) & 0xffu); }
#undef SLOAD
#undef SWRITE
#undef SWAIT
#undef RESC
#undef MASKW
}
}
DI void p7_dsa(const Frame& F) {
    const bf16_t* z = F.at<bf16_t>(WS_Z); const unsigned long long* sel = F.at<unsigned long long>(WS_SEL); bf16_t* oa = F.at<bf16_t>(WS_OA);
    const int r32 = F.lane & 31, hi = F.lane >> 5;
    for (int item = F.wg; item < NB * 2 * 64; item += F.G) {
        const int pi = item & 63, j = (item >> 6) & 1, b = item >> 7;
#pragma unroll 1
        for (int half = 0; half < 2; ++half) {
            const int c = half ? pi : 127 - pi;
            const size_t q0 = (size_t)b * SEQ + 64 * c + (F.wave & 1) * 32;
            const int head = j * 4 + (F.wave >> 1);
            __syncthreads();
            dsa::unit(z + (q0 + r32) * INWP + C_QA + head * 128 + hi * 8, z + (size_t)b * SEQ * INWP + C_KA + j * 128, z + (size_t)b * SEQ * INWP + C_VA + j * 128,
                      sel + q0 * 128, c + 1, (bf16_t*)((unsigned char*)oa + q0 * 1024 + head * 128), (LAS char*)F.lds);
        }
    }
}

struct MergedSched {
    pg8::TileOrder ord; unsigned OA, OB, WA, WB;
    DI bool next(int i, pg8::Unit& u) const { int pm, pn; if (!ord.tile(i >> 1, pm, pn)) return false; const int br = i & 1;
        u.pm = pm; u.pn = pn; u.e = 0; u.aux = br; u.A = (br ? OB : OA) + (unsigned)pm * 256u * 1024u; u.B = (br ? WB : WA) + (unsigned)pn * 256u * 1024u; return true; }
};
struct EpiMerged {
    static constexpr bool PERM = true;
    const unsigned char* GZ; unsigned char* O;
    static DI float g4(unsigned w, int j) { const f32x2 p = (j < 2) ? __builtin_amdgcn_cvt_pk_f32_fp8((int)w, false) : __builtin_amdgcn_cvt_pk_f32_fp8((int)w, true); return ((j & 1) ? p.y : p.x) * 0.0625f; }
    DI bool operator()(f32x4 (&acc)[2][2][4][2], const pg8::Unit& u, int wr, int wc, int fr, int fq) const {
        const int row0 = u.pm * 256 + wr * 64 + fr, col0 = u.pn * 256 + wc * 32 + 8 * fq;
        u32x2 gav[2][4][2], gbv[2][4][2];
#pragma unroll
        for (int ai = 0; ai < 2; ++ai)
#pragma unroll
            for (int m = 0; m < 4; ++m)
#pragma unroll
                for (int bj = 0; bj < 2; ++bj) { const size_t row = (size_t)(row0 + ai * 128 + m * 16); const int col = col0 + bj * 128;
                    gbv[ai][m][bj] = *(const u32x2*)(GZ + row * 4096 + 2048 + col); if (u.aux == 0) gav[ai][m][bj] = *(const u32x2*)(GZ + row * 4096 + col); else gav[ai][m][bj] = (u32x2){0u, 0u}; }
        if (u.aux != 0) {
#pragma unroll
            for (int ai = 0; ai < 2; ++ai)
#pragma unroll
                for (int m = 0; m < 4; ++m)
#pragma unroll
                    for (int bj = 0; bj < 2; ++bj) asm volatile("" : "+v"(gbv[ai][m][bj]));
        }
#pragma unroll
        for (int ai = 0; ai < 2; ++ai) {
#pragma unroll
            for (int m = 0; m < 4; ++m) { const size_t row = (size_t)(row0 + ai * 128 + m * 16);
#pragma unroll
                for (int bj = 0; bj < 2; ++bj) { const int col = col0 + bj * 128;
                    float f[8];
                    if (u.aux == 0) {
#pragma unroll
                        for (int j = 0; j < 8; ++j) { const float ga = g4(j < 4 ? gav[ai][m][bj].x : gav[ai][m][bj].y, j & 3), gb = g4(j < 4 ? gbv[ai][m][bj].x : gbv[ai][m][bj].y, j & 3);
                            f[j] = (1.f + __expf(-gb)) * __builtin_amdgcn_rcpf(1.f + __expf(-ga)); }
                    } else {
#pragma unroll
                        for (int j = 0; j < 8; ++j) { const float gb = g4(j < 4 ? gbv[ai][m][bj].x : gbv[ai][m][bj].y, j & 3); f[j] = __builtin_amdgcn_rcpf(1.f + __expf(-gb)); }
                    }
                    f32x4 v0 = acc[ai][bj][m][0], v1 = acc[ai][bj][m][1];
                    v0[0] *= f[0]; v0[1] *= f[1]; v0[2] *= f[2]; v0[3] *= f[3]; v1[0] *= f[4]; v1[1] *= f[5]; v1[2] *= f[6]; v1[3] *= f[7];
                    if (u.aux == 0) { acc[ai][bj][m][0] = v0; acc[ai][bj][m][1] = v1; }
                    else { u32x2 w; w.x = pk_fp8x4(clamp448(v0[0] * 16.f), clamp448(v0[1] * 16.f), clamp448(v0[2] * 16.f), clamp448(v0[3] * 16.f));
                        w.y = pk_fp8x4(clamp448(v1[0] * 16.f), clamp448(v1[1] * 16.f), clamp448(v1[2] * 16.f), clamp448(v1[3] * 16.f));
                        *(u32x2*)(O + row * DM + col) = w; } } }
        }
        return u.aux == 0;
    }
};

typedef int v4i32q __attribute__((ext_vector_type(4)));
constexpr int LDS_TAB = 131072;
DI void p10_rows(const Frame& F) {
    LAS float* cG1 = (LAS float*)F.lds; LAS float* cA1 = cG1 + DM; LAS float* cA2 = cA1 + DM; LAS float* cB2 = cA2 + DM;
    LAS float* lg = cB2 + DM;
    LAS int* se = (LAS int*)(lg + 128 * 33);
    const float* mod = F.at<float>(WS_MOD); const bf16_t* mix = F.at<bf16_t>(WS_MIX);
    bf16_t* h2h = F.at<bf16_t>(WS_H); bf16_t* h2l = F.at<bf16_t>(WS_H2LO); unsigned char* h2q = F.at<unsigned char>(WS_H2Q);
    for (int blk = F.wg; blk < T / 128; blk += F.G) {
        const int b = blk / 64;
        __syncthreads();
#pragma unroll
        for (int i = 0; i < 4; ++i) { const int col = F.tid * 4 + i; const float* mb = mod + (size_t)b * 12288;
            cG1[col] = F.kp->in[I_GPOSTMIX][col] * mb[4096 + col]; cA2[col] = F.kp->in[I_GPREFFN][col] * (1.0f + mb[8192 + col]); cB2[col] = mb[6144 + col]; }
        __syncthreads();
        const size_t rowb = (size_t)blk * 128 + F.wave * 16;
        f32x4 xv[8], xn[8]; u32x2 mw[8], mn[8];
        { const float* xr = F.kp->in[I_X] + rowb * DM + F.lane * 4; const bf16_t* mr = mix + rowb * DM + F.lane * 4;
#pragma unroll
          for (int q = 0; q < 8; ++q) { xv[q] = *(const f32x4*)(xr + q * 256); mw[q] = *(const u32x2*)(mr + q * 256); } }
        for (int i = 0; i < 16; ++i) {
            const size_t row = rowb + i;
            if (i + 1 < 16) { const float* xr = F.kp->in[I_X] + (row + 1) * DM + F.lane * 4; const bf16_t* mr = mix + (row + 1) * DM + F.lane * 4;
#pragma unroll
                for (int q = 0; q < 8; ++q) { xn[q] = *(const f32x4*)(xr + q * 256); mn[q] = *(const u32x2*)(mr + q * 256); } }
            float ss = 0.f;
#pragma unroll
            for (int q = 0; q < 8; ++q) { const float m0 = bflo(mw[q].x), m1 = bfhi(mw[q].x), m2 = bflo(mw[q].y), m3 = bfhi(mw[q].y); ss += m0 * m0 + m1 * m1 + m2 * m2 + m3 * m3; }
            ss = wave_sum(ss);
            const float rs1 = rsqrtf(ss * (1.0f / DM) + RMS_EPS);
            float s2 = 0.f; bf16_t* orow = F.at<bf16_t>(WS_X1B) + row * DM + F.lane * 4;
#pragma unroll
            for (int q = 0; q < 8; ++q) { const int col = q * 256 + F.lane * 4; const float mq[4] = {bflo(mw[q].x), bfhi(mw[q].x), bflo(mw[q].y), bfhi(mw[q].y)};
#pragma unroll
                for (int e = 0; e < 4; ++e) { xv[q][e] += mq[e] * rs1 * cG1[col + e]; s2 += xv[q][e] * xv[q][e]; }
                *(u32x2*)(orow + q * 256) = (u32x2){cvt_pk_bf16(xv[q][0], xv[q][1]), cvt_pk_bf16(xv[q][2], xv[q][3])}; }
            s2 = wave_sum(s2);
            const float rs2 = rsqrtf(s2 * (1.0f / DM) + RMS_EPS);
            int lz = F.lane * 4; asm volatile("" : "+v"(lz));
#pragma unroll
            for (int q = 0; q < 8; ++q) { const int col = q * 256 + lz; float h[4], lo[4]; unsigned hb[4];
#pragma unroll
                for (int e = 0; e < 4; ++e) { h[e] = xv[q][e] * rs2 * cA2[col + e] + cB2[col + e]; hb[e] = cvt_pk_bf16(h[e], 0.f) & 0xffffu; lo[e] = h[e] - __uint_as_float(hb[e] << 16); }
                u32x2 wh = {hb[0] | (hb[1] << 16), hb[2] | (hb[3] << 16)}; u32x2 wl = {cvt_pk_bf16(lo[0], lo[1]), cvt_pk_bf16(lo[2], lo[3])};
                *(u32x2*)(h2h + row * DM + col) = wh; *(u32x2*)(h2l + row * DM + col) = wl;
                *(unsigned*)(h2q + row * DM + col) = pk_fp8x4(clamp448(h[0]), clamp448(h[1]), clamp448(h[2]), clamp448(h[3])); }
#pragma unroll
            for (int q = 0; q < 8; ++q) { xv[q] = xn[q]; mw[q] = mn[q]; }
        }
        asm volatile("s_waitcnt vmcnt(0)" ::: "memory");
        if (F.tid >= 256 && F.tid < 288) se[512 + F.tid - 256] = 0;
        __syncthreads();
        if (F.wave < 4) {
            const int l = F.lane, m = l & 31, hi = l >> 5; const size_t r0 = (size_t)blk * 128 + F.wave * 32;
            const bf16_t* ah = h2h + (r0 + m) * DM + hi * 8; const bf16_t* al = h2l + (r0 + m) * DM + hi * 8;
            const bf16_t* wh = F.at<bf16_t>(WS_WRT) + (size_t)m * DM + hi * 8; const bf16_t* wl = wh + NE * DM;
            f32x16 acc = {};
#pragma unroll 4
            for (int kk = 0; kk < DM / 16; ++kk) { const bf16x8 a0 = *(const bf16x8*)(ah + kk * 16), a1 = *(const bf16x8*)(al + kk * 16), b0 = *(const bf16x8*)(wh + kk * 16), b1 = *(const bf16x8*)(wl + kk * 16);
                acc = MFMA32(a0, b0, acc); acc = MFMA32(a1, b0, acc); acc = MFMA32(a0, b1, acc); }
            const float br = F.kp->in[I_BR][m];
#pragma unroll
            for (int r = 0; r < 16; ++r) lg[(F.wave * 32 + (r & 3) + 8 * (r >> 2) + 4 * hi) * 33 + m] = acc[r] + br;
        }
        __syncthreads();
        if (F.tid < 128) {
            float v[32];
#pragma unroll
            for (int e = 0; e < 32; ++e) v[e] = lg[F.tid * 33 + e];
            int te[4]; float tv[4];
#pragma unroll
            for (int k = 0; k < 4; ++k) { float best = -INFINITY; int bi = 0;
#pragma unroll
                for (int e = 0; e < 32; ++e) { if (v[e] > best) { best = v[e]; bi = e; } }
                te[k] = bi; tv[k] = best;
#pragma unroll
                for (int e = 0; e < 32; ++e) if (e == bi) v[e] = -INFINITY; }
            const float e1 = __expf(tv[1] - tv[0]), e2 = __expf(tv[2] - tv[0]), e3 = __expf(tv[3] - tv[0]); const float inv = 1.0f / (1.0f + e1 + e2 + e3);
            const size_t tok = (size_t)blk * 128 + F.tid;
            int* tep = F.at<int>(WS_TOPE) + tok * 4; float* twp = F.at<float>(WS_TOPW) + tok * 4;
            tep[0] = te[0]; tep[1] = te[1]; tep[2] = te[2]; tep[3] = te[3]; twp[0] = inv; twp[1] = e1 * inv; twp[2] = e2 * inv; twp[3] = e3 * inv;
#pragma unroll
            for (int k = 0; k < 4; ++k) __hip_atomic_fetch_add(se + 512 + te[k], 1, __ATOMIC_RELAXED, __HIP_MEMORY_SCOPE_WORKGROUP);
        }
        __syncthreads();
        if (F.tid < 32) F.at<int>(WS_CNT)[blk * 32 + F.tid] = se[512 + F.tid];
    }
}

DI void moe_tables(const Frame& F, int blk) {
    LAS int* tb = (LAS int*)(F.lds + LDS_TAB); LAS int* part = tb + 1024;
    __syncthreads();
    { const int e = F.tid & 31, g = F.tid >> 5; const int* cnt = F.at<int>(WS_CNT) + (g * 16) * 32 + e; int v[16];
#pragma unroll
      for (int j = 0; j < 16; ++j) v[j] = cnt[j * 32];
      int all = 0, bef = 0;
#pragma unroll
      for (int j = 0; j < 16; ++j) { all += v[j]; bef += (g * 16 + j < blk) ? v[j] : 0; }
      part[g * 32 + e] = all; part[512 + g * 32 + e] = bef; }
    __syncthreads();
    if (F.tid < 32) { int tot = 0, pre = 0;
#pragma unroll
        for (int g = 0; g < 16; ++g) { tot += part[g * 32 + F.tid]; pre += part[512 + g * 32 + F.tid]; }
        tb[F.tid] = tot; tb[160 + F.tid] = pre; tb[64 + F.tid] = (tot + 255) >> 8; }
    __syncthreads();
    if (F.tid == 0) { int rs = 0, us = 0; for (int e = 0; e < 32; ++e) { tb[32 + e] = rs; tb[96 + e] = us; rs += tb[64 + e] * 256; us += tb[64 + e]; } tb[96 + 32] = us; }
    __syncthreads();
}
DI void p11_sort(const Frame& F) {
    LAS int* tb = (LAS int*)(F.lds + LDS_TAB); LAS int* se = (LAS int*)F.lds; LAS int* pos = se + 512;
    int* rslot = F.at<int>(WS_RSLOT); float* rw = F.at<float>(WS_RW); const unsigned char* h2q = F.at<unsigned char>(WS_H2Q); unsigned char* hs = F.at<unsigned char>(WS_HS);
    for (int blk = F.wg; blk < T / 128; blk += F.G) {
        moe_tables(F, blk);
        se[F.tid] = F.at<int>(WS_TOPE)[(size_t)blk * 512 + F.tid];
        __syncthreads();
        {
            LAS int* wc = pos + 512;
            const int e = se[F.tid]; int rank = 0, mine = 0;
#pragma unroll 1
            for (int ee = 0; ee < 32; ++ee) { const unsigned long long mk = __ballot(e == ee);
                if (e == ee) { rank = __builtin_popcountll(mk & ((1ull << F.lane) - 1ull)); mine = __builtin_popcountll(mk); }
                if (F.lane == 0) wc[F.wave * 32 + ee] = __builtin_popcountll(mk); }
            (void)mine;
            __syncthreads();
            int before = 0;
            for (int w = 0; w < F.wave; ++w) before += wc[w * 32 + e];
            pos[F.tid] = tb[32 + e] + tb[160 + e] + before + rank;
        }
        __syncthreads();
        { const int p = pos[F.tid]; rslot[p] = blk * 512 + F.tid; rw[p] = F.at<float>(WS_TOPW)[(size_t)blk * 512 + F.tid]; }
        for (int t0 = F.wave * 8; t0 < 128; t0 += NWAVES * 8) {
            u32x4 v[8][2];
#pragma unroll
            for (int e = 0; e < 8; ++e) { const u32x4* src = (const u32x4*)(h2q + ((size_t)blk * 128 + t0 + e) * DM); v[e][0] = src[F.lane]; v[e][1] = src[64 + F.lane]; }
#pragma unroll
            for (int e = 0; e < 8; ++e)
#pragma unroll
                for (int k = 0; k < 4; ++k) { u32x4* dst = (u32x4*)(hs + (size_t)pos[(t0 + e) * 4 + k] * DM); dst[F.lane] = v[e][0]; dst[64 + F.lane] = v[e][1]; } }
        if (blk < 32) { const int e = blk, lo = tb[32 + e] + tb[e], hi_ = tb[32 + e] + tb[64 + e] * 256;
            for (int p = lo + F.tid; p < hi_; p += NTHR) { rslot[p] = -1; rw[p] = 0.f; }
            for (int p = lo + F.wave; p < hi_; p += NWAVES) { u32x4* dst = (u32x4*)(hs + (size_t)p * DM);
#pragma unroll
                for (int q = 0; q < 2; ++q) dst[q * 64 + F.lane] = (u32x4){0u, 0u, 0u, 0u}; } }
        __syncthreads();
    }
}

template <int NT_, int NROWS_B> DI void moe_units(const Frame& F, unsigned Abase, unsigned Bbase) {
    LAS int* tb = (LAS int*)(F.lds + LDS_TAB);
    const int total = tb[96 + 32] * NT_;
    int n = 0;
    for (int i = F.tid; ; i += NTHR) { const int L = i * F.G + F.wg; if (L >= total) break;
        int e = 0;
#pragma unroll 1
        for (int q = 1; q < 32; ++q) if (L >= tb[96 + q] * NT_) e = q;
        const int l = L - tb[96 + e] * NT_, mt = tb[64 + e], mi = l % mt, ni = l / mt, r0 = tb[32 + e] + mi * 256;
        tb[256 + 4 * i] = (int)(Abase + (unsigned)r0 * 2048u); tb[256 + 4 * i + 1] = (int)(Bbase + ((unsigned)e * NROWS_B + (unsigned)ni * 256u) * 2048u); tb[256 + 4 * i + 2] = r0 >> 8; tb[256 + 4 * i + 3] = (e << 8) | ni; }
    if (F.tid == 0) { const int mine = total > F.wg ? (total - F.wg + F.G - 1) / F.G : 0; tb[255] = mine; }
    (void)n;
    __syncthreads();
}
struct MoeSched {
    LAS const int* tb;
    DI bool next(int i, pg8::Unit& u) const {
        if (i >= __builtin_amdgcn_readfirstlane(tb[255])) return false;
        const v4i32q v = *(LAS const v4i32q*)(tb + 256 + 4 * i);
        u.A = (unsigned)__builtin_amdgcn_readfirstlane(v[0]); u.B = (unsigned)__builtin_amdgcn_readfirstlane(v[1]); u.pm = __builtin_amdgcn_readfirstlane(v[2]);
        const int w = __builtin_amdgcn_readfirstlane(v[3]); u.pn = w & 255; u.e = w >> 8; u.aux = 0; return true; }
};
DI void dense_units(const Frame& F, int nM, int nN, unsigned Abase, unsigned Bbase, unsigned RB) {
    LAS int* tb = (LAS int*)(F.lds + LDS_TAB);
    pg8::TileOrder ord; ord.init(nM, nN, F.G, F.wg);
    __syncthreads();
    int n = 0;
    for (int i = F.tid; ; i += NTHR) { int pm, pn; if (!ord.tile(i, pm, pn)) break;
        tb[256 + 4 * i] = (int)(Abase + (unsigned)pm * 256u * RB); tb[256 + 4 * i + 1] = (int)(Bbase + (unsigned)pn * 256u * RB); tb[256 + 4 * i + 2] = pm; tb[256 + 4 * i + 3] = pn; }
    if (F.tid == 0) { const int total = nM * nN; tb[255] = total > F.wg ? (total - F.wg + F.G - 1) / F.G : 0; }
    (void)n;
    __syncthreads();
}
DI u32x4 xpose4(unsigned d0, unsigned d1, unsigned d2, unsigned d3) {
    typedef unsigned u32x2v_ __attribute__((ext_vector_type(2)));
    const u32x2v_ a = __builtin_amdgcn_permlane16_swap(d0, d1, false, false), b = __builtin_amdgcn_permlane16_swap(d2, d3, false, false);
    const u32x2v_ x = __builtin_amdgcn_permlane32_swap(a.x, b.x, false, false), y = __builtin_amdgcn_permlane32_swap(a.y, b.y, false, false);
    u32x4 r; r.x = x.x; r.y = y.x; r.z = x.y; r.w = y.y; return r;
}
struct EpiMoe1 {
    static constexpr bool PERM = true;
    const float* b1; unsigned char* act;
    DI bool operator()(const f32x4 (&acc)[2][2][4][2], const pg8::Unit& u, int wr, int wc, int fr, int fq) const {
        const int row0 = u.pm * 256 + wr * 64 + fr, col0 = u.pn * 256 + wc * 32 + 8 * fq;
        f32x4 bva[2][2];
#pragma unroll
        for (int bj = 0; bj < 2; ++bj) { bva[bj][0] = *(const f32x4*)(b1 + (size_t)u.e * 4096 + col0 + bj * 128); bva[bj][1] = *(const f32x4*)(b1 + (size_t)u.e * 4096 + col0 + bj * 128 + 4); }
#pragma unroll
        for (int bj = 0; bj < 2; ++bj) {
            const f32x4 bv0 = bva[bj][0], bv1 = bva[bj][1];
#pragma unroll
            for (int ai = 0; ai < 2; ++ai) {
                unsigned d[4];
#pragma unroll
                for (int m = 0; m < 4; ++m) {
                    const f32x4 v0 = acc[ai][bj][m][0] + bv0, v1 = acc[ai][bj][m][1] + bv1;
                    float o[4];
#pragma unroll
                    for (int j = 0; j < 4; ++j) { const float g = fminf(j < 2 ? v0[2 * j] : v1[2 * j - 4], 7.0f), li = fminf(fmaxf(j < 2 ? v0[2 * j + 1] : v1[2 * j - 3], -7.0f), 7.0f);
                        o[j] = g * __builtin_amdgcn_rcpf(1.0f + __builtin_amdgcn_exp2f(g * (-1.702f * 1.44269504f))) * fmaf(li, 4.0f, 4.0f); }
                    d[m] = pk_fp8x4(o[0], o[1], o[2], o[3]); }
                *(u32x4*)(act + (size_t)(row0 + ai * 128 + fq * 16) * DFF + ((col0 - 8 * fq) >> 1) + bj * 64) = xpose4(d[0], d[1], d[2], d[3]); }
            asm volatile("" ::: "memory");
        }
        return false;
    }
};
struct EpiMoe2 {
    static constexpr bool PERM = true;
    const float* b2; const int* rslot; const float* rw; unsigned char* ys;
    DI bool operator()(const f32x4 (&acc)[2][2][4][2], const pg8::Unit& u, int wr, int wc, int fr, int fq) const {
        const int row0 = u.pm * 256 + wr * 64 + fr, col0 = u.pn * 256 + wc * 32 + 8 * fq;
        int slot[2][4]; float w[2][4]; f32x4 bv[2][2];
#pragma unroll
        for (int ai = 0; ai < 2; ++ai)
#pragma unroll
            for (int m = 0; m < 4; ++m) { const int row = row0 + ai * 128 + m * 16; slot[ai][m] = rslot[row]; w[ai][m] = rw[row]; }
#pragma unroll
        for (int bj = 0; bj < 2; ++bj) { bv[bj][0] = *(const f32x4*)(b2 + (size_t)u.e * 2048 + col0 + bj * 128); bv[bj][1] = *(const f32x4*)(b2 + (size_t)u.e * 2048 + col0 + bj * 128 + 4); }
#pragma unroll
        for (int ai = 0; ai < 2; ++ai)
#pragma unroll
            for (int m = 0; m < 4; ++m) asm volatile("" : "+v"(slot[ai][m]), "+v"(w[ai][m]));
#pragma unroll
        for (int bj = 0; bj < 2; ++bj) asm volatile("" : "+v"(bv[bj][0]), "+v"(bv[bj][1]));
        asm volatile("" ::: "memory");
#pragma unroll
        for (int ai = 0; ai < 2; ++ai) {
#pragma unroll
            for (int bj = 0; bj < 2; ++bj) {
                const f32x4 bv0 = bv[bj][0], bv1 = bv[bj][1];
#pragma unroll
                for (int m = 0; m < 4; ++m) {
                    if (slot[ai][m] >= 0) { const float ws_ = w[ai][m] * 16.f; const f32x4 v0 = (acc[ai][bj][m][0] + bv0) * ws_, v1 = (acc[ai][bj][m][1] + bv1) * ws_;
                        u32x2 q; q.x = pk_fp8x4(clamp448(v0[0]), clamp448(v0[1]), clamp448(v0[2]), clamp448(v0[3])); q.y = pk_fp8x4(clamp448(v1[0]), clamp448(v1[1]), clamp448(v1[2]), clamp448(v1[3]));
                        *(u32x2*)(ys + (size_t)slot[ai][m] * DM + col0 + bj * 128) = q; } }
            }
        }
        return false;
    }
};

DI void p14_final(const Frame& F) {
    LAS float* cG = (LAS float*)F.lds; const float* mod = F.at<float>(WS_MOD); const unsigned char* ys = F.at<unsigned char>(WS_YS);
    for (int blk = F.wg; blk < T / 128; blk += F.G) {
        const int b = blk / 64;
        __syncthreads();
#pragma unroll
        for (int i = 0; i < 4; ++i) { const int col = F.tid * 4 + i; cG[col] = F.kp->in[I_GPOSTFFN][col] * mod[(size_t)b * 12288 + 10240 + col]; }
        __syncthreads();
        const size_t rowb = (size_t)blk * 128 + F.wave * 16;
        unsigned yw[4][8], yn[4][8];
#pragma unroll
        for (int k = 0; k < 4; ++k)
#pragma unroll
            for (int q = 0; q < 8; ++q) yw[k][q] = *(const unsigned*)(ys + (rowb * 4 + k) * DM + q * 256 + F.lane * 4);
        u32x2 x1w[8], x1n[8];
#pragma unroll
        for (int q = 0; q < 8; ++q) x1w[q] = *(const u32x2*)(F.at<bf16_t>(WS_X1B) + rowb * DM + F.lane * 4 + q * 256);
        for (int i = 0; i < 16; ++i) {
            const size_t row = rowb + i;
            if (i + 1 < 16) {
#pragma unroll
                for (int k = 0; k < 4; ++k)
#pragma unroll
                    for (int q = 0; q < 8; ++q) yn[k][q] = *(const unsigned*)(ys + ((row + 1) * 4 + k) * DM + q * 256 + F.lane * 4);
#pragma unroll
                for (int q = 0; q < 8; ++q) x1n[q] = *(const u32x2*)(F.at<bf16_t>(WS_X1B) + (row + 1) * DM + F.lane * 4 + q * 256); }
            float* orow = F.kp->out + row * DM + F.lane * 4;
            f32x4 x1[8];
#pragma unroll
            for (int q = 0; q < 8; ++q) x1[q] = (f32x4){bflo(x1w[q].x), bfhi(x1w[q].x), bflo(x1w[q].y), bfhi(x1w[q].y)};
            f32x4 f[8]; float ss = 0.f;
#pragma unroll
            for (int q = 0; q < 8; ++q) { f[q] = (f32x4){0.f, 0.f, 0.f, 0.f};
#pragma unroll
                for (int k = 0; k < 4; ++k) { const unsigned w = yw[k][q]; const f32x2 lo = __builtin_amdgcn_cvt_pk_f32_fp8((int)w, false), hi = __builtin_amdgcn_cvt_pk_f32_fp8((int)w, true);
                    f[q] += (f32x4){lo.x, lo.y, hi.x, hi.y}; }
                f[q] *= 0.0625f;
                ss += f[q][0] * f[q][0] + f[q][1] * f[q][1] + f[q][2] * f[q][2] + f[q][3] * f[q][3]; }
            ss = wave_sum(ss);
            const float rs = rsqrtf(ss * (1.0f / DM) + RMS_EPS);
#pragma unroll
            for (int q = 0; q < 8; ++q) { const int col = q * 256 + F.lane * 4;
#pragma unroll
                for (int e = 0; e < 4; ++e) x1[q][e] += f[q][e] * rs * cG[col + e];
                *(f32x4*)(orow + q * 256) = x1[q]; }
#pragma unroll
            for (int k = 0; k < 4; ++k)
#pragma unroll
                for (int q = 0; q < 8; ++q) yw[k][q] = yn[k][q];
#pragma unroll
            for (int q = 0; q < 8; ++q) x1w[q] = x1n[q];
        }
    }
}

constexpr int N_PHASES = 15;
__global__ void __launch_bounds__(NTHR, 2) mega(Params p) {
    extern __shared__ __attribute__((aligned(16))) unsigned char lds_raw[];
    Frame F; F.kp = (KParams)__builtin_amdgcn_kernarg_segment_ptr(); F.ws = p.ws; F.lds = (LAS unsigned char*)lds_raw; F.tid = threadIdx.x; F.wave = __builtin_amdgcn_readfirstlane(threadIdx.x >> 6); F.lane = threadIdx.x & 63; F.G = gridDim.x; F.wg = blockIdx.x;
    volatile LAS unsigned* bst = (volatile LAS unsigned*)(F.lds + LDS_BYTES - 16);
    if (F.tid < 4) bst[F.tid] = 0u;
    __syncthreads();
    const int lo = p.ph_lo, hi = p.ph_hi;
    XcdBarrier bar; bar.bar = (unsigned*)(p.ws + WS_CTL); bar.x = 0; bar.st = bst;
    if (hi - lo > 1) bar = xcd_barrier_post((unsigned*)(p.ws + WS_CTL), bst);
#ifdef ONLY_PHASE
#define IN(k) ((k) == ONLY_PHASE)
#else
#ifdef SKIP_PHASE
#define IN(k) ((k) != SKIP_PHASE && lo <= (k) && (k) < hi)
#else
#define IN(k) (lo <= (k) && (k) < hi)
#endif
#endif
#define PH(k) if (IN(k)) { KParams kq_ = (KParams)__builtin_amdgcn_kernarg_segment_ptr(); asm volatile("" : "+s"(kq_)); F.kp = kq_; int t_ = threadIdx.x; asm volatile("" : "+v"(t_)); F.tid = t_; F.lane = t_ & 63; }
#define SEAM(k) do { if (IN(k) && IN((k) + 1)) xcd_barrier(bar); } while (0)
#ifndef DBG_DOUBLE
#define DBG_DOUBLE 0
#endif
#define PHASE(k, ...) PH(k) if (IN(k)) { { __VA_ARGS__ } if constexpr ((DBG_DOUBLE >> (k)) & 1) { xcd_barrier(bar); { __VA_ARGS__ } } }
    PHASE(0, p0_prologue(F);) SEAM(0);
    PHASE(1, p1_norm(F);) SEAM(1);
    PHASE(2, { dense_units(F, T / 256, (INB - NF8) / 256, (unsigned)WS_H, (unsigned)WS_WINT, 4096u); MoeSched S{(LAS const int*)(F.lds + LDS_TAB)};
          EpiStoreBf16 E{F.at<bf16_t>(WS_Z) + NF8, INWP, C_GA - NF8}; pg8::gemm_phase<2048, EpiStoreBf16, MoeSched>(F.lds, F.ws, S, E); }
        { dense_units(F, T / 256, (NF8 + 4096) / 256, (unsigned)WS_H8, (unsigned)WS_WING8, 2048u); MoeSched S{(LAS const int*)(F.lds + LDS_TAB)};
          EpiInFp8 E{F.at<bf16_t>(WS_Z), F.at<unsigned char>(WS_GZ)}; pg8::gemm_phase<1024, EpiInFp8, MoeSched, true, 122, 127>(F.lds, F.ws, S, E); }) SEAM(2);
    PHASE(3, p3_rope(F);) SEAM(3);
    PHASE(4, p4_indexer(F);) SEAM(4);
    PHASE(5, p5_select(F);)
    PHASE(6, p6_stick(F);) SEAM(6);
    PHASE(7, p7_dsa(F);) SEAM(7);
    PHASE(8, MergedSched S; S.ord.init(T / 256, DM / 256, F.G, F.wg); S.OA = (unsigned)WS_OA; S.OB = (unsigned)WS_OB; S.WA = (unsigned)WS_WAT; S.WB = (unsigned)WS_WBT;
        EpiMerged E{F.at<unsigned char>(WS_GZ), F.at<unsigned char>(WS_MERGED)}; pg8::gemm_phase<512, EpiMerged, MergedSched, true, 122, 122>(F.lds, F.ws, S, E);) SEAM(8);
    PHASE(9, dense_units(F, T / 256, DM / 256, (unsigned)WS_MERGED, (unsigned)WS_WOT, 2048u); MoeSched S{(LAS const int*)(F.lds + LDS_TAB)};
        EpiStoreBf16 E{F.at<bf16_t>(WS_MIX), DM, DM}; pg8::gemm_phase<1024, EpiStoreBf16, MoeSched, true, 122, 123>(F.lds, F.ws, S, E);) SEAM(9);
    PHASE(10, p10_rows(F);) SEAM(10);
    PHASE(11, p11_sort(F);) SEAM(11);
    PHASE(12, moe_tables(F, 0); moe_units<16, 4096>(F, (unsigned)WS_HS, (unsigned)WS_W1T); MoeSched S{(LAS const int*)(F.lds + LDS_TAB)};
        EpiMoe1 E{F.kp->in[I_B1], F.at<unsigned char>(WS_ACT)}; pg8::gemm_phase<1024, EpiMoe1, MoeSched, true, 122, 127>(F.lds, F.ws, S, E);) SEAM(12);
    PHASE(13, moe_tables(F, 0); moe_units<8, 2048>(F, (unsigned)WS_ACT, (unsigned)WS_W2T); MoeSched S{(LAS const int*)(F.lds + LDS_TAB)};
        EpiMoe2 E{F.kp->in[I_B2], F.at<int>(WS_RSLOT), F.at<float>(WS_RW), F.at<unsigned char>(WS_YS)}; pg8::gemm_phase<1024, EpiMoe2, MoeSched, true, 122, 125>(F.lds, F.ws, S, E);) SEAM(13);
    PHASE(14, p14_final(F);)
#undef IN
#undef SEAM
}


extern "C" void kernel_launch(void* const* d_in, const int* in_sizes, int n_in, void* d_out, int out_size, void* d_ws, size_t ws_size, hipStream_t stream) {
    static int grid = 0;
    if (grid == 0) {
        if (n_in != 19 || out_size != T * DM || ws_size < WS_END) { fprintf(stderr, "kernel_launch: unexpected shapes: n_in %d out %d ws %zu (need %zu)\n", n_in, out_size, ws_size, (size_t)WS_END); grid = -1; return; }
        int dev = 0, cus = 0, per_cu = 0;
        if (hipGetDevice(&dev) != hipSuccess || hipDeviceGetAttribute(&cus, hipDeviceAttributeMultiprocessorCount, dev) != hipSuccess) { grid = -1; return; }
        if (hipFuncSetAttribute((const void*)mega, hipFuncAttributeMaxDynamicSharedMemorySize, LDS_BYTES) != hipSuccess) { fprintf(stderr, "kernel_launch: hipFuncSetAttribute failed\n"); grid = -1; return; }
        if (hipOccupancyMaxActiveBlocksPerMultiprocessor(&per_cu, (const void*)mega, NTHR, LDS_BYTES) != hipSuccess || per_cu < 1) { fprintf(stderr, "kernel_launch: occupancy query says %d blocks per CU\n", per_cu); per_cu = 1; }
        (void)hipGetLastError();
        grid = cus;
    }
    if (grid < 0) return;
    (void)hipMemsetAsync((char*)d_ws + WS_CTL, 0, CTL_BYTES, stream);
    Params p{};
    for (int i = 0; i < 19; ++i) p.in[i] = (const float*)d_in[i];
    p.out = (float*)d_out; p.ws = (unsigned char*)d_ws;
#if MK_N_LAUNCHES == 1
    p.ph_lo = 0; p.ph_hi = N_PHASES;
    hipLaunchKernelGGL(mega, dim3(grid), dim3(NTHR), LDS_BYTES, stream, p);
#else
#ifndef DBG_LAST_PHASE
#define DBG_LAST_PHASE (N_PHASES - 1)
#endif
    for (int k = 0; k <= DBG_LAST_PHASE; ++k) { p.ph_lo = k; p.ph_hi = k + 1; hipLaunchKernelGGL(mega, dim3(grid), dim3(NTHR), LDS_BYTES, stream, p); }
#endif
    const hipError_t le = hipPeekAtLastError();
    if (le != hipSuccess) fprintf(stderr, "kernel_launch: launch failed: %s\n", hipGetErrorName(le));
}
```

```cpp
#include <hip/hip_runtime.h>
#include <cstdio>
#include <cstdint>

#ifndef DBG_DOUBLE
#define DBG_DOUBLE 0
#endif
#ifndef MK_N_LAUNCHES
#define MK_N_LAUNCHES 1
#endif

#define LAS __attribute__((address_space(3)))
typedef unsigned short bf16_t;
typedef short bf16x8 __attribute__((ext_vector_type(8)));
typedef short s16x4 __attribute__((ext_vector_type(4)));
typedef float f32x2 __attribute__((ext_vector_type(2)));
typedef float f32x4 __attribute__((ext_vector_type(4)));
typedef float f32x16 __attribute__((ext_vector_type(16)));
typedef unsigned u32x2 __attribute__((ext_vector_type(2)));
typedef unsigned u32x4 __attribute__((ext_vector_type(4)));
#define DI __device__ __forceinline__

constexpr int NB = 4, SEQ = 8192, T = NB * SEQ, DM = 2048;
constexpr int INW = 9808, INWP = 9984;
constexpr int INB = 5888;
constexpr int C_QA = 0, C_KA = 1024, C_VA = 1280, C_QB = 1536, C_KB = 2560, C_VB = 3584, C_QI = 4608, C_KI = 5632, C_WI = 5696, C_GA = 5712, C_GB = 7760;
constexpr int NE = 32, TOPK = 4, DFF = 2048, NSLOT = T * TOPK;
constexpr int MAXROWS = NSLOT + NE * 256;
constexpr float RMS_EPS = 1e-6f;
constexpr int NWAVES = 8, NTHR = 512;
constexpr int LDS_BYTES = 147456;

constexpr size_t al256(size_t x) { return (x + 255) / 256 * 256; }
constexpr size_t WS_CTL = 0;
constexpr size_t CTL_BYTES = 65536;
constexpr size_t WS_MODP = WS_CTL + CTL_BYTES;
constexpr size_t WS_MOD = WS_MODP + al256((size_t)32 * 4 * 12288 * 4);
constexpr size_t WS_WINT = WS_MOD + al256((size_t)4 * 12288 * 4);
constexpr size_t WS_WAT = WS_WINT + al256((size_t)INWP * DM * 2);
constexpr size_t WS_WBT = WS_WAT + al256((size_t)2048 * 1024 * 2);
constexpr size_t WS_WOT = WS_WBT + al256((size_t)2048 * 1024 * 2);
constexpr size_t WS_W1T = WS_WOT + al256((size_t)2048 * 2048 * 2);
constexpr size_t WS_W2T = WS_W1T + al256((size_t)NE * 4096 * 2048 * 2);
constexpr size_t WS_WRT = WS_W2T + al256((size_t)NE * 2048 * 2048 * 2);
constexpr int NF8 = 4608;
constexpr size_t WS_WING8 = WS_WRT + al256((size_t)2 * NE * DM * 2);
constexpr size_t WS_H8 = WS_WING8 + al256((size_t)(NF8 + 4096) * DM);
constexpr size_t WS_GZ = WS_H8 + al256((size_t)T * DM);
constexpr size_t WS_TOPE = WS_GZ + al256((size_t)T * 4096);
constexpr size_t WS_TOPW = WS_TOPE + al256((size_t)T * 4 * 4);
constexpr size_t WS_CNT = WS_TOPW + al256((size_t)T * 4 * 4);
constexpr size_t WS_RSLOT = WS_CNT + al256((size_t)256 * NE * 4);
constexpr size_t WS_RW = WS_RSLOT + al256((size_t)MAXROWS * 4);
constexpr size_t WS_H = WS_RW + al256((size_t)MAXROWS * 4);
constexpr size_t WS_Z = WS_H + al256((size_t)T * DM * 2);
constexpr size_t SC_PER_B = (size_t)4096 * 128 * 129 / 2;
constexpr size_t WS_SC = WS_Z + al256((size_t)T * INWP * 2);
constexpr size_t WS_KBF = WS_SC + al256(SC_PER_B * 4 * NB);
constexpr size_t WS_VBF = WS_KBF + al256((size_t)T * 1024 * 2);
constexpr size_t WS_KIDX = WS_VBF + al256((size_t)T * 1024 * 2);
constexpr size_t WS_WIF = WS_KIDX + al256((size_t)T * 64 * 2);
constexpr size_t WS_SEL = WS_WIF + al256((size_t)T * 16 * 4);
constexpr size_t WS_OA = WS_SEL + al256((size_t)T * 128 * 8);
constexpr size_t WS_OB = WS_OA + al256((size_t)T * 1024 * 2);
constexpr size_t WS_MERGED = WS_OB + al256((size_t)T * 1024 * 2);
constexpr size_t WS_MIX = WS_MERGED + al256((size_t)T * DM * 2);
constexpr size_t WS_ENDX = WS_MIX + al256((size_t)T * DM * 2);
constexpr size_t WS_X1B = WS_GZ;
constexpr size_t WS_H2LO = WS_Z;
constexpr size_t WS_H2Q = WS_H2LO + al256((size_t)T * DM * 2);
constexpr size_t WS_HS = WS_H2Q + al256((size_t)T * DM);
constexpr size_t WS_ACT = WS_HS + al256((size_t)MAXROWS * DM * 2);
constexpr size_t WS_YS = WS_ACT + al256((size_t)MAXROWS * DFF * 2);
constexpr size_t WS_ENDY = WS_YS + al256((size_t)NSLOT * DM * 2);
constexpr size_t WS_END = WS_ENDX > WS_ENDY ? WS_ENDX : WS_ENDY;
static_assert(WS_END < 0xffffffffull, "32-bit workspace offsets");
static_assert(WS_HS >= WS_Z + (size_t)T * DM * 2 && WS_HS + (size_t)MAXROWS * DM <= WS_SC, "map: h2lo, h2q, hs must stay inside the dead z buffer while merged/mix (further up) are live");

struct Params { const float* in[19]; float* out; unsigned char* ws; int ph_lo, ph_hi; };
enum { I_X = 0, I_C, I_POS, I_WADA, I_BADA, I_GPREMIX, I_GPOSTMIX, I_WIN, I_WA, I_WB, I_WOUT, I_GPREFFN, I_GPOSTFFN, I_WR, I_BR, I_W1, I_B1, I_W2, I_B2 };

#define XB_TMO      128
#define XB_XCNT(j)  (256  + 64 * (j))
#define XB_XSUB(j)  (1280 + 64 * (j))
#define XB_XGEN(j)  (2304 + 64 * (j))
#define XB_TOP      3328
#define XB_TOPGEN   3392
#define XCD_BAR_WORDS 3456
#define XB_SPIN_CAP (1u << 18)
__device__ __forceinline__ unsigned xb_ld(unsigned* p)              { return __hip_atomic_load(p, __ATOMIC_RELAXED, __HIP_MEMORY_SCOPE_AGENT); }
__device__ __forceinline__ unsigned xb_add(unsigned* p, unsigned v) { return __hip_atomic_fetch_add(p, v, __ATOMIC_RELAXED, __HIP_MEMORY_SCOPE_AGENT); }
__device__ __forceinline__ unsigned xb_xcc_id() { return (unsigned)__builtin_amdgcn_s_getreg((3 << 11) | 20) & 0xFu; }
#define XB_SPIN(cond, bar) do { unsigned _sp = 0; while (cond) { __builtin_amdgcn_s_sleep(1); \
    if ((++_sp & 255u) == 0u) { if (xb_ld(&(bar)[XB_TMO])) break; if (_sp > XB_SPIN_CAP) { atomicAdd(&(bar)[XB_TMO], 1u); break; } } } } while (0)
struct XcdBarrier { unsigned* bar; unsigned x; volatile LAS unsigned* st; };
__device__ __forceinline__ XcdBarrier xcd_barrier_post(unsigned* bar, volatile LAS unsigned* st) {
    XcdBarrier b; b.bar = bar; b.x = xb_xcc_id(); b.st = st;
    if (threadIdx.x == 0) (void)xb_add(&bar[XB_XCNT(b.x)], 1u);
    return b;
}
__device__ __forceinline__ void xcd_barrier_complete(unsigned* bar, unsigned x, unsigned& nloc, unsigned& nx) {
    const unsigned G = gridDim.x * gridDim.y * gridDim.z;
    unsigned sum, cnt, mine, sp = 0u;
    for (;;) {
        sum = 0u; cnt = 0u; mine = 0u;
#pragma unroll
        for (unsigned j = 0; j < 16; ++j) { const unsigned c = xb_ld(&bar[XB_XCNT(j)]); sum += c; cnt += (c > 0u) ? 1u : 0u; mine = (j == x) ? c : mine; }
        if (sum == G) break;
        __builtin_amdgcn_s_sleep(1);
        if ((++sp & 255u) == 0u) { if (xb_ld(&bar[XB_TMO])) break; if (sp > XB_SPIN_CAP) { atomicAdd(&bar[XB_TMO], 1u); break; } }
    }
    nloc = mine > 0u ? mine : 1u; nx = cnt > 0u ? cnt : 1u;
}
__device__ __forceinline__ void xcd_barrier(const XcdBarrier& b) {
    asm volatile("s_waitcnt vmcnt(0)" ::: "memory");
    __syncthreads();
    if (threadIdx.x == 0) {
        unsigned* bar = b.bar;
        __builtin_amdgcn_s_waitcnt(0);
        unsigned nloc = b.st[0], nx = b.st[1];
        if (nloc == 0u) { xcd_barrier_complete(bar, b.x, nloc, nx); b.st[0] = nloc; b.st[1] = nx; }
        const unsigned old = xb_add(&bar[XB_XSUB(b.x)], 1u);
        const unsigned gen = old / nloc;
        if (old + 1u == (gen + 1u) * nloc) {
            __builtin_amdgcn_fence(__ATOMIC_RELEASE, "agent");
            asm volatile("s_waitcnt vmcnt(0)" ::: "memory");
            const unsigned og = xb_add(&bar[XB_TOP], 1u);
            const unsigned tg = og / nx;
            if (og + 1u == (tg + 1u) * nx) xb_add(&bar[XB_TOPGEN], 1u);
            else XB_SPIN(xb_ld(&bar[XB_TOPGEN]) == tg, bar);
            __builtin_amdgcn_fence(__ATOMIC_ACQUIRE, "agent");
            xb_add(&bar[XB_XGEN(b.x)], 1u);
            asm volatile("s_waitcnt vmcnt(0)" ::: "memory");
        } else {
            XB_SPIN(xb_ld(&bar[XB_XGEN(b.x)]) == gen, bar);
            __builtin_amdgcn_fence(__ATOMIC_ACQUIRE, "agent");
            asm volatile("s_waitcnt vmcnt(0)" ::: "memory");
        }
    }
    __syncthreads();
}

typedef __bf16 bf16x2v __attribute__((ext_vector_type(2)));
DI unsigned cvt_pk_bf16(float lo, float hi) { const f32x2 v = {lo, hi}; const bf16x2v b = __builtin_convertvector(v, bf16x2v); return __builtin_bit_cast(unsigned, b); }
DI float bf2f(unsigned short b) { return __uint_as_float((unsigned)b << 16); }
DI float bflo(unsigned w) { return __uint_as_float(w << 16); }
DI float bfhi(unsigned w) { return __uint_as_float(w & 0xffff0000u); }
DI float wave_sum(float v) {
    v += __builtin_bit_cast(float, __builtin_amdgcn_update_dpp(0, __builtin_bit_cast(int, v), 0xB1, 0xF, 0xF, false));
    v += __builtin_bit_cast(float, __builtin_amdgcn_update_dpp(0, __builtin_bit_cast(int, v), 0x4E, 0xF, 0xF, false));
    v += __builtin_bit_cast(float, __builtin_amdgcn_update_dpp(0, __builtin_bit_cast(int, v), 0x141, 0xF, 0xF, false));
    v += __builtin_bit_cast(float, __builtin_amdgcn_update_dpp(0, __builtin_bit_cast(int, v), 0x140, 0xF, 0xF, false));
    { auto r = __builtin_amdgcn_permlane16_swap(__float_as_uint(v), __float_as_uint(v), false, false); v = __uint_as_float(r[0]) + __uint_as_float(r[1]); }
    { auto r = __builtin_amdgcn_permlane32_swap(__float_as_uint(v), __float_as_uint(v), false, false); v = __uint_as_float(r[0]) + __uint_as_float(r[1]); }
    return v;
}
DI float sigmoidf_(float x) { return 1.0f / (1.0f + __expf(-x)); }

namespace pg8 {
constexpr int BM = 256, BK = 64, HALF = 128, HTB = HALF * BK * 2, STAGE_BYTES = 8 * HTB;
__host__ __device__ __forceinline__ int lds_byte(int r, int c) { const int st = (r >> 4) * 2 + (c >> 5), rr = r & 15, cc = c & 31, ob = rr * 64 + cc * 2; return st * 1024 + (ob ^ (((ob >> 9) & 1) << 5)); }
__host__ __device__ __forceinline__ void stage_rc(int b, int& R, int& C) { const int st = b / 1024, sb = b % 1024, swz = sb ^ (((sb >> 9) & 1) << 5); R = (st >> 1) * 16 + swz / 64; C = (st & 1) * 32 + (swz % 64) / 2; }
__host__ __device__ __forceinline__ int perm32(int rho) { const int n = rho >> 4, i = rho & 15; return 8 * (i >> 2) + 4 * n + (i & 3); }

struct Unit { unsigned A, B; int pm, pn, e, aux; };

typedef int v8i32 __attribute__((ext_vector_type(8)));
typedef int v4i32 __attribute__((ext_vector_type(4)));
template <int K, class Epi, class Sched, bool FP8 = false, int SC_W = 127, int SC_A = 127>
__device__ __forceinline__ void gemm_phase(LAS unsigned char* lds, const unsigned char* wsbase, const Sched& S, const Epi& E) {
    const __amdgpu_buffer_rsrc_t rsrc = __builtin_amdgcn_make_buffer_rsrc((void*)wsbase, 0, 0xffffffff, 0x00020000);
    const int tid = threadIdx.x, wid = __builtin_amdgcn_readfirstlane(tid >> 6), lane = tid & 63, wr = wid >> 2, wc = wid & 3, fr = lane & 15, fq = lane >> 4;
    constexpr int nt = K / BK;
    unsigned voffA[2], voffB[2];
#pragma unroll
    for (int i = 0; i < 2; ++i) { int R, C; stage_rc(tid * 16 + i * 8192, R, C); const int Rb = Epi::PERM ? ((R & ~31) + perm32(R & 31)) : R;
        voffA[i] = (unsigned)(R * K + C) * 2u; voffB[i] = (unsigned)(Rb * K + C) * 2u; }
    constexpr unsigned kstep = (unsigned)(BK * 2);
    constexpr unsigned hstep = (unsigned)HALF * K * 2;
    const unsigned ldsw = (unsigned)wid * 1024u;
    const int aoff = lds_byte(wr * 64 + fr, fq * 8), boff = lds_byte(wc * 32 + fr, fq * 8);
#define PG8_SA(b, h) (((b) * 2 + (h)) * HTB)
#define PG8_SB(b, h) ((4 + (b) * 2 + (h)) * HTB)
#define PG8_STAGE(bufoff, gbase, voff) do { _Pragma("unroll") for (int _i = 0; _i < 2; ++_i) \
        __builtin_amdgcn_raw_ptr_buffer_load_lds(rsrc, (LAS void*)(lds + (bufoff) + ldsw + _i * 8192), 16, (int)(voff)[_i], (int)(gbase), 0, 0); } while (0)
#define PG8_CAT2(p0, p1) __builtin_shufflevector(*(const LAS v4i32*)(p0), *(const LAS v4i32*)(p1), 0, 1, 2, 3, 4, 5, 6, 7)
#define PG8_LDA(dst, b, h) do { _Pragma("unroll") for (int m = 0; m < 4; ++m) { if constexpr (FP8) dst##8[m] = PG8_CAT2(lds + PG8_SA(b, h) + aoff + m * 2048, lds + PG8_SA(b, h) + aoff + m * 2048 + 1024); \
        else { _Pragma("unroll") for (int k = 0; k < 2; ++k) dst[m][k] = *(const LAS bf16x8*)(lds + PG8_SA(b, h) + aoff + m * 2048 + k * 1024); } } } while (0)
#define PG8_LDB(dst, b, h) do { _Pragma("unroll") for (int n = 0; n < 2; ++n) { if constexpr (FP8) dst##8[n] = PG8_CAT2(lds + PG8_SB(b, h) + boff + n * 2048, lds + PG8_SB(b, h) + boff + n * 2048 + 1024); \
        else { _Pragma("unroll") for (int k = 0; k < 2; ++k) dst[n][k] = *(const LAS bf16x8*)(lds + PG8_SB(b, h) + boff + n * 2048 + k * 1024); } } } while (0)
#define PG8_CAT(x) __builtin_shufflevector(__builtin_bit_cast(v4i32, (x)[0]), __builtin_bit_cast(v4i32, (x)[1]), 0, 1, 2, 3, 4, 5, 6, 7)
#define PG8_MMA(ai, bj, At, Bt) do { __builtin_amdgcn_s_setprio(1); _Pragma("unroll") for (int m = 0; m < 4; ++m) _Pragma("unroll") for (int n = 0; n < 2; ++n) { \
        if constexpr (FP8) acc[ai][bj][m][n] = __builtin_amdgcn_mfma_scale_f32_16x16x128_f8f6f4(Bt##8[n], At##8[m], acc[ai][bj][m][n], 0, 0, 0, SC_W, 0, SC_A); \
        else { _Pragma("unroll") for (int k = 0; k < 2; ++k) acc[ai][bj][m][n] = __builtin_amdgcn_mfma_f32_16x16x32_bf16(Bt[n][k], At[m][k], acc[ai][bj][m][n], 0, 0, 0); } } \
        __builtin_amdgcn_s_setprio(0); } while (0)
#define PG8_WAIT_V(n) asm volatile("s_waitcnt vmcnt(" #n ")" ::: "memory")
#define PG8_WAIT_L(n) asm volatile("s_waitcnt lgkmcnt(" #n ")" ::: "memory")
#define PG8_BAR __builtin_amdgcn_s_barrier()
#define PG8_SCHED __builtin_amdgcn_sched_barrier(0)
    Unit cur, nxt; int ui = 0;
    if (!S.next(0, cur)) return;
    f32x4 acc[2][2][4][2];
#pragma unroll
    for (int a = 0; a < 2; ++a)
#pragma unroll
        for (int b = 0; b < 2; ++b)
#pragma unroll
            for (int m = 0; m < 4; ++m)
#pragma unroll
                for (int n = 0; n < 2; ++n) acc[a][b][m][n] = (f32x4){0.f, 0.f, 0.f, 0.f};
    bf16x8 At[4][2], B0[2][2], B1[2][2]; v8i32 At8[4], B08[2], B18[2];
    unsigned cA = (unsigned)__builtin_amdgcn_readfirstlane((int)cur.A), cB = (unsigned)__builtin_amdgcn_readfirstlane((int)cur.B);
    PG8_STAGE(PG8_SB(0, 0), cB, voffB); PG8_STAGE(PG8_SB(0, 1), cB + hstep, voffB); PG8_STAGE(PG8_SA(0, 0), cA, voffA); PG8_STAGE(PG8_SA(0, 1), cA + hstep, voffA);
    if (wr == 1) PG8_BAR;
    PG8_WAIT_V(2); PG8_BAR;
    PG8_STAGE(PG8_SB(1, 0), cB + kstep, voffB); PG8_STAGE(PG8_SA(1, 0), cA + kstep, voffA); PG8_STAGE(PG8_SB(1, 1), cB + hstep + kstep, voffB);
    PG8_WAIT_V(6); PG8_BAR;
    for (;;) {
        const bool has_next = S.next(ui + 1, nxt);
        const unsigned nA = has_next ? (unsigned)__builtin_amdgcn_readfirstlane((int)nxt.A) : cA, nB = has_next ? (unsigned)__builtin_amdgcn_readfirstlane((int)nxt.B) : cB;
#pragma unroll 1
        for (int t = 0; t < nt; t += 2) {
            const bool last = (t == nt - 2);
            const unsigned a1 = cA + (unsigned)(t + 1) * kstep;
            const unsigned a2 = last ? nA : cA + (unsigned)(t + 2) * kstep, b2 = last ? nB : cB + (unsigned)(t + 2) * kstep;
            const unsigned a3 = a2 + kstep, b3 = b2 + kstep;
            PG8_LDB(B0, 0, 0); PG8_LDB(B1, 0, 1); PG8_SCHED; PG8_LDA(At, 0, 0); PG8_STAGE(PG8_SA(1, 1), a1 + hstep, voffA);
            PG8_WAIT_V(8); PG8_WAIT_L(0); PG8_BAR; PG8_MMA(0, 0, At, B0); PG8_MMA(0, 1, At, B1); PG8_BAR; PG8_SCHED;
            PG8_LDA(At, 0, 1); PG8_STAGE(PG8_SB(0, 0), b2, voffB); PG8_STAGE(PG8_SB(0, 1), b2 + hstep, voffB); PG8_STAGE(PG8_SA(0, 0), a2, voffA);
            PG8_WAIT_V(8); PG8_WAIT_L(0); PG8_BAR; PG8_MMA(1, 0, At, B0); PG8_MMA(1, 1, At, B1); PG8_BAR; PG8_SCHED;
            PG8_LDB(B0, 1, 0); PG8_LDB(B1, 1, 1); PG8_SCHED; PG8_LDA(At, 1, 0); PG8_STAGE(PG8_SA(0, 1), a2 + hstep, voffA);
            PG8_WAIT_V(8); PG8_WAIT_L(0); PG8_BAR; PG8_MMA(0, 0, At, B0); PG8_MMA(0, 1, At, B1); PG8_BAR; PG8_SCHED;
            PG8_LDA(At, 1, 1); PG8_STAGE(PG8_SB(1, 0), b3, voffB); PG8_STAGE(PG8_SB(1, 1), b3 + hstep, voffB); PG8_STAGE(PG8_SA(1, 0), a3, voffA);
            PG8_WAIT_V(8); PG8_WAIT_L(0); PG8_BAR; PG8_MMA(1, 0, At, B0); PG8_MMA(1, 1, At, B1); PG8_BAR; PG8_SCHED;
        }
        if (wr == 0) PG8_BAR;
        int tl_ = threadIdx.x; asm volatile("" : "+v"(tl_));
        const bool keep = E(acc, cur, wr, wc, tl_ & 15, (tl_ & 63) >> 4);
        if (!has_next) break;
        if (!keep) {
#pragma unroll
        for (int a = 0; a < 2; ++a)
#pragma unroll
            for (int b = 0; b < 2; ++b)
#pragma unroll
                for (int m = 0; m < 4; ++m)
#pragma unroll
                    for (int n = 0; n < 2; ++n) acc[a][b][m][n] = (f32x4){0.f, 0.f, 0.f, 0.f};
        }
        cur = nxt; cA = nA; cB = nB; ++ui;
        if (wr == 1) PG8_BAR;
    }
    PG8_WAIT_V(0);
    PG8_BAR;
#undef PG8_SA
#undef PG8_SB
#undef PG8_STAGE
#undef PG8_LDA
#undef PG8_LDB
#undef PG8_MMA
#undef PG8_CAT
#undef PG8_CAT2
#undef PG8_WAIT_V
#undef PG8_WAIT_L
#undef PG8_BAR
#undef PG8_SCHED
}

struct TileOrder {
    int nM, nN, nwg, G, c;
    DI void init(int nM_, int nN_, int G_, int c_) { nM = nM_; nN = nN_; nwg = nM * nN; G = G_; c = c_; }
    DI bool tile(int i, int& pm, int& pn) const {
        const long L = (long)i * G + c; if (L >= nwg) return false;
        int wgid = (int)L; { const int q = nwg / 8, r = nwg % 8, xcd = wgid % 8, off = wgid / 8; wgid = (xcd < r ? xcd * (q + 1) : r * (q + 1) + (xcd - r) * q) + off; }
        const int nig = 8 * nN, gid = wgid / nig, fm = gid * 8, gsz = (nM - fm) < 8 ? (nM - fm) : 8;
        pm = fm + ((wgid % nig) % gsz); pn = (wgid % nig) / gsz; return true;
    }
};
}

typedef const __attribute__((address_space(4))) Params* KParams;
struct Frame {
    KParams kp; unsigned char* ws; LAS unsigned char* lds; int tid, wave, lane, G, wg;
    template <class Tp> DI Tp* at(size_t off) const { return (Tp*)(ws + off); }
};

DI void p0_modpart(const Frame& F, int item) {
    const int ks = item / 6, jt = item % 6;
    LAS float* sl = (LAS float*)F.lds;
    __syncthreads();
    if (F.tid < 256) { const int b = F.tid >> 6, k = F.tid & 63; const float cv = F.kp->in[I_C][b * DM + ks * 64 + k]; sl[F.tid] = cv / (1.0f + __expf(-cv)); }
    __syncthreads();
    const int j0 = jt * 2048 + F.tid * 4;
    const float* w = F.kp->in[I_WADA] + (size_t)(ks * 64) * 12288 + j0;
    f32x4 a0 = {0, 0, 0, 0}, a1 = a0, a2 = a0, a3 = a0;
#pragma unroll 8
    for (int k = 0; k < 64; ++k) { const f32x4 v = *(const f32x4*)(w + (size_t)k * 12288);
        a0 += v * sl[k]; a1 += v * sl[64 + k]; a2 += v * sl[128 + k]; a3 += v * sl[192 + k]; }
    float* o = F.at<float>(WS_MODP) + (size_t)ks * 4 * 12288 + j0;
    *(f32x4*)(o) = a0; *(f32x4*)(o + 12288) = a1; *(f32x4*)(o + 2 * 12288) = a2; *(f32x4*)(o + 3 * 12288) = a3;
}
DI void p0_cvt_tile(const Frame& F, const float* __restrict__ src, bf16_t* __restrict__ dst, int K, int Nsrc, int kt, int ntile) {
    LAS float* tl = (LAS float*)F.lds;
    __syncthreads();
    const int k0 = kt * 64, n0 = ntile * 128;
    {
        const int c4 = (F.tid & 31) * 4, r0 = F.tid >> 5;
#pragma unroll
        for (int i = 0; i < 4; ++i) { const int r = r0 + 16 * i; f32x4 v = {0, 0, 0, 0};
            if (n0 + c4 < Nsrc) v = *(const f32x4*)(src + (size_t)(k0 + r) * Nsrc + n0 + c4);
            tl[r * 129 + c4] = v[0]; tl[r * 129 + c4 + 1] = v[1]; tl[r * 129 + c4 + 2] = v[2]; tl[r * 129 + c4 + 3] = v[3]; }
    }
    __syncthreads();
    {
        const int kc = F.tid & 7;
#pragma unroll
        for (int i = 0; i < 2; ++i) { const int n = (F.tid >> 3) + 64 * i;
            float v[8];
#pragma unroll
            for (int j = 0; j < 8; ++j) v[j] = tl[(kc * 8 + j) * 129 + n];
            u32x4 w = {cvt_pk_bf16(v[0], v[1]), cvt_pk_bf16(v[2], v[3]), cvt_pk_bf16(v[4], v[5]), cvt_pk_bf16(v[6], v[7])};
            *(u32x4*)(dst + (size_t)(n0 + n) * K + k0 + kc * 8) = w; }
    }
}
DI unsigned pk_fp8x4(float a, float b, float c, float d) { int w = 0; w = __builtin_amdgcn_cvt_pk_fp8_f32(a, b, w, false); w = __builtin_amdgcn_cvt_pk_fp8_f32(c, d, w, true); return (unsigned)w; }
DI float clamp448(float x) { return __builtin_amdgcn_fmed3f(x, -448.f, 448.f); }
DI void p0_cvt_tile_fp8(const Frame& F, const float* __restrict__ src, unsigned char* __restrict__ dst, int K, int N, int kt, int ntile) {
    LAS float* tl = (LAS float*)F.lds;
    __syncthreads();
    const int k0 = kt * 128, n0 = ntile * 128;
    {
        const int c4 = (F.tid & 31) * 4, r0 = F.tid >> 5;
#pragma unroll
        for (int i = 0; i < 8; ++i) { const int r = r0 + 16 * i; const f32x4 v = *(const f32x4*)(src + (size_t)(k0 + r) * N + n0 + c4);
            tl[r * 129 + c4] = v[0]; tl[r * 129 + c4 + 1] = v[1]; tl[r * 129 + c4 + 2] = v[2]; tl[r * 129 + c4 + 3] = v[3]; }
    }
    __syncthreads();
    {
        const int n = F.tid & 127, kc = F.tid >> 7;
        unsigned w[8];
#pragma unroll
        for (int j = 0; j < 8; ++j) { const LAS float* p = tl + (kc * 32 + j * 4) * 129 + n;
            w[j] = pk_fp8x4(clamp448(p[0] * 32.f), clamp448(p[129] * 32.f), clamp448(p[258] * 32.f), clamp448(p[387] * 32.f)); }
        unsigned char* o = dst + (size_t)(n0 + n) * K + k0 + kc * 32;
        *(u32x4*)o = (u32x4){w[0], w[1], w[2], w[3]}; *(u32x4*)(o + 16) = (u32x4){w[4], w[5], w[6], w[7]};
    }
}
constexpr int CV_NB = (INB - NF8) / 128, CV_NF = NF8 / 128, CV_N0 = 32 * CV_NB + 16 * CV_NF + 16 * 32, CV_N1 = 8 * 16, CV_N2 = 8 * 16, CV_N3 = 16 * 16, CV_N4 = 0, CV_N5 = 0;
constexpr int CV_S1 = CV_N0, CV_S2 = CV_S1 + CV_N1, CV_S3 = CV_S2 + CV_N2, CV_S4 = CV_S3 + CV_N3, CV_S5 = CV_S4 + CV_N4, CV_TOT = CV_S5 + CV_N5;
DI void p0_prologue(const Frame& F) {
    for (int it = F.wg; it < 192; it += F.G) p0_modpart(F, it);
    for (int i = F.wg * NTHR + F.tid; i < NE * DM; i += F.G * NTHR) { const int e = i / DM, k = i % DM; const float v = F.kp->in[I_WR][(size_t)k * NE + e];
        const unsigned hi = cvt_pk_bf16(v, 0.f) & 0xffffu; const float r = v - __uint_as_float(hi << 16);
        F.at<bf16_t>(WS_WRT)[i] = (bf16_t)hi; F.at<bf16_t>(WS_WRT)[NE * DM + i] = (bf16_t)(cvt_pk_bf16(r, 0.f) & 0xffffu); }
    for (int it = F.wg; it < CV_TOT; it += F.G) {
        int j = it;
        Frame F2 = F; { KParams kq_ = F.kp; asm volatile("" : "+s"(kq_)); F2.kp = kq_; }
        if (j < 32 * CV_NB) { p0_cvt_tile(F, F2.kp->in[I_WIN] + NF8, F.at<bf16_t>(WS_WINT), 2048, INW, j / CV_NB, j % CV_NB); continue; }
        if (j < 32 * CV_NB + 16 * CV_NF) { const int r = j - 32 * CV_NB; p0_cvt_tile_fp8(F, F2.kp->in[I_WIN], F.at<unsigned char>(WS_WING8), 2048, INW, r / CV_NF, r % CV_NF); continue; }
        if (j < CV_N0) { const int r = j - 32 * CV_NB - 16 * CV_NF; p0_cvt_tile_fp8(F, F2.kp->in[I_WIN] + C_GA, F.at<unsigned char>(WS_WING8) + (size_t)NF8 * DM, 2048, INW, r / 32, r % 32); continue; }
        j -= CV_N0;
        if (j < CV_N1) { p0_cvt_tile_fp8(F, F2.kp->in[I_WA], F.at<unsigned char>(WS_WAT), 1024, 2048, j / 16, j % 16); continue; }
        j -= CV_N1;
        if (j < CV_N2) { p0_cvt_tile_fp8(F, F2.kp->in[I_WB], F.at<unsigned char>(WS_WBT), 1024, 2048, j / 16, j % 16); continue; }
        j -= CV_N2;
        p0_cvt_tile_fp8(F, F2.kp->in[I_WOUT], F.at<unsigned char>(WS_WOT), 2048, 2048, j / 16, j % 16);
    }
}

DI float mod_sum(const Frame& F, int b, int j) {
    const float* mp = F.at<float>(WS_MODP) + (size_t)b * 12288 + j; float s = F.kp->in[I_BADA][j]; float v[32];
#pragma unroll
    for (int ks = 0; ks < 32; ++ks) v[ks] = mp[(size_t)ks * 4 * 12288];
#pragma unroll
    for (int ks = 0; ks < 32; ++ks) s += v[ks];
    return s;
}
DI void p1_norm(const Frame& F) {
    LAS float* sA = (LAS float*)F.lds; LAS float* sB = sA + DM;
    for (int o = F.wg * NTHR + F.tid; o < 4 * 12288; o += F.G * NTHR) F.at<float>(WS_MOD)[o] = mod_sum(F, o / 12288, o % 12288);
    for (int blk = F.wg; blk < T / 128; blk += F.G) {
        const int b = blk / 64;
        __syncthreads();
        {
            const int col = F.tid * 4; const float* mp = F.at<float>(WS_MODP) + (size_t)b * 12288 + col;
            f32x4 a1 = *(const f32x4*)(F.kp->in[I_BADA] + 2048 + col), a0 = *(const f32x4*)(F.kp->in[I_BADA] + col);
#pragma unroll 8
            for (int ks = 0; ks < 32; ++ks) { a1 += *(const f32x4*)(mp + (size_t)ks * 4 * 12288 + 2048); a0 += *(const f32x4*)(mp + (size_t)ks * 4 * 12288); }
            const f32x4 g = *(const f32x4*)(F.kp->in[I_GPREMIX] + col);
#pragma unroll
            for (int i = 0; i < 4; ++i) { sA[col + i] = g[i] * (1.0f + a1[i]); sB[col + i] = a0[i]; }
        }
        __syncthreads();
        const size_t rowb = (size_t)blk * 128 + F.wave * 16;
        f32x4 v[8], vn[8];
        { const float* xr = F.kp->in[I_X] + rowb * DM + F.lane * 4;
#pragma unroll
          for (int q = 0; q < 8; ++q) v[q] = *(const f32x4*)(xr + q * 256); }
        for (int i = 0; i < 16; ++i) {
            const size_t row = rowb + i;
            if (i + 1 < 16) { const float* xr = F.kp->in[I_X] + (row + 1) * DM + F.lane * 4;
#pragma unroll
                for (int q = 0; q < 8; ++q) vn[q] = *(const f32x4*)(xr + q * 256); }
            float ss = 0.f;
#pragma unroll
            for (int q = 0; q < 8; ++q) ss += v[q][0] * v[q][0] + v[q][1] * v[q][1] + v[q][2] * v[q][2] + v[q][3] * v[q][3];
            ss = wave_sum(ss);
            const float rstd = rsqrtf(ss * (1.0f / DM) + RMS_EPS);
            bf16_t* hr = F.at<bf16_t>(WS_H) + row * DM + F.lane * 4;
#pragma unroll
            for (int q = 0; q < 8; ++q) { const int col = q * 256 + F.lane * 4;
                const float o0 = v[q][0] * rstd * sA[col] + sB[col], o1 = v[q][1] * rstd * sA[col + 1] + sB[col + 1], o2 = v[q][2] * rstd * sA[col + 2] + sB[col + 2], o3 = v[q][3] * rstd * sA[col + 3] + sB[col + 3];
                u32x2 w = {cvt_pk_bf16(o0, o1), cvt_pk_bf16(o2, o3)}; *(u32x2*)(hr + q * 256) = w;
                *(unsigned*)(F.at<unsigned char>(WS_H8) + row * DM + col) = pk_fp8x4(clamp448(o0), clamp448(o1), clamp448(o2), clamp448(o3)); }
#pragma unroll
            for (int q = 0; q < 8; ++q) v[q] = vn[q];
        }
    }
}

struct EpiStoreBf16 {
    static constexpr bool PERM = true;
    bf16_t* O; int ldc; int colmax;
    DI bool operator()(const f32x4 (&acc)[2][2][4][2], const pg8::Unit& u, int wr, int wc, int fr, int fq) const {
        const int row0 = u.pm * 256 + wr * 64 + fr, col0 = u.pn * 256 + wc * 32 + 8 * fq;
#pragma unroll
        for (int ai = 0; ai < 2; ++ai)
#pragma unroll
            for (int m = 0; m < 4; ++m) { bf16_t* rowp = O + (size_t)(row0 + ai * 128 + m * 16) * ldc + col0;
#pragma unroll
                for (int bj = 0; bj < 2; ++bj) { const f32x4 v0 = acc[ai][bj][m][0], v1 = acc[ai][bj][m][1];
                    u32x4 w; w.x = cvt_pk_bf16(v0[0], v0[1]); w.y = cvt_pk_bf16(v0[2], v0[3]); w.z = cvt_pk_bf16(v1[0], v1[1]); w.w = cvt_pk_bf16(v1[2], v1[3]);
                    if (col0 + bj * 128 < colmax) *(u32x4*)(rowp + bj * 128) = w; } }
        return false;
    }
};
template <int SCALE> struct EpiStoreFp8 {
    static constexpr bool PERM = true;
    unsigned char* O; int ldc;
    DI bool operator()(const f32x4 (&acc)[2][2][4][2], const pg8::Unit& u, int wr, int wc, int fr, int fq) const {
        const int row0 = u.pm * 256 + wr * 64 + fr, col0 = u.pn * 256 + wc * 32 + 8 * fq;
#pragma unroll
        for (int ai = 0; ai < 2; ++ai)
#pragma unroll
            for (int m = 0; m < 4; ++m) { unsigned char* rowp = O + (size_t)(row0 + ai * 128 + m * 16) * ldc + col0;
#pragma unroll
                for (int bj = 0; bj < 2; ++bj) { const f32x4 v0 = acc[ai][bj][m][0] * (float)SCALE, v1 = acc[ai][bj][m][1] * (float)SCALE;
                    u32x2 w; w.x = pk_fp8x4(clamp448(v0[0]), clamp448(v0[1]), clamp448(v0[2]), clamp448(v0[3])); w.y = pk_fp8x4(clamp448(v1[0]), clamp448(v1[1]), clamp448(v1[2]), clamp448(v1[3]));
                    *(u32x2*)(rowp + bj * 128) = w; } }
        return false;
    }
};
struct EpiInFp8 {
    static constexpr bool PERM = true;
    bf16_t* Z; unsigned char* GZ;
    DI bool operator()(const f32x4 (&acc)[2][2][4][2], const pg8::Unit& u, int wr, int wc, int fr, int fq) const {
        const int row0 = u.pm * 256 + wr * 64 + fr, colt = wc * 32 + 8 * fq;
        if (u.pn < NF8 / 256) {
#pragma unroll
            for (int ai = 0; ai < 2; ++ai)
#pragma unroll
                for (int m = 0; m < 4; ++m) { bf16_t* rowp = Z + (size_t)(row0 + ai * 128 + m * 16) * INWP + u.pn * 256 + colt;
#pragma unroll
                    for (int bj = 0; bj < 2; ++bj) { const f32x4 v0 = acc[ai][bj][m][0], v1 = acc[ai][bj][m][1];
                        u32x4 w; w.x = cvt_pk_bf16(v0[0], v0[1]); w.y = cvt_pk_bf16(v0[2], v0[3]); w.z = cvt_pk_bf16(v1[0], v1[1]); w.w = cvt_pk_bf16(v1[2], v1[3]);
                        *(u32x4*)(rowp + bj * 128) = w; } }
        } else {
#pragma unroll
            for (int ai = 0; ai < 2; ++ai)
#pragma unroll
                for (int m = 0; m < 4; ++m) { unsigned char* rowp = GZ + (size_t)(row0 + ai * 128 + m * 16) * 4096 + (u.pn - NF8 / 256) * 256 + colt;
#pragma unroll
                    for (int bj = 0; bj < 2; ++bj) { const f32x4 v0 = acc[ai][bj][m][0] * 16.f, v1 = acc[ai][bj][m][1] * 16.f;
                        u32x2 w; w.x = pk_fp8x4(clamp448(v0[0]), clamp448(v0[1]), clamp448(v0[2]), clamp448(v0[3])); w.y = pk_fp8x4(clamp448(v1[0]), clamp448(v1[1]), clamp448(v1[2]), clamp448(v1[3]));
                        *(u32x2*)(rowp + bj * 128) = w; } }
        }
        return false;
    }
};
template <int K> struct DenseSched {
    pg8::TileOrder ord; unsigned A, Bt;
    DI bool next(int i, pg8::Unit& u) const { int pm, pn; if (!ord.tile(i, pm, pn)) return false;
        u.pm = pm; u.pn = pn; u.e = 0; u.aux = 0; u.A = A + (unsigned)pm * 256u * K * 2u; u.B = Bt + (unsigned)pn * 256u * K * 2u; return true; }
};

DI void p3_rope(const Frame& F) {
    LAS float* cs = (LAS float*)F.lds;
    bf16_t* z = F.at<bf16_t>(WS_Z); bf16_t* kidx = F.at<bf16_t>(WS_KIDX); float* wif = F.at<float>(WS_WIF);
    bf16_t* kbF = F.at<bf16_t>(WS_KBF); bf16_t* vbF = F.at<bf16_t>(WS_VBF);
    const int* pos = (const int*)F.kp->in[I_POS];
    for (int item = F.wg; item < T / 32; item += F.G) {
        const int b = item >> 8, blk = item & 255, s0 = blk * 32; const size_t row0 = (size_t)b * SEQ + s0;
        __syncthreads();
        for (int e = F.tid; e < 32 * 24; e += NTHR) { const int tok = e / 24, a = e % 24;
            const float ex = a < 16 ? -(float)a * (1.0f / 16.0f) : -(float)(a - 16) * (1.0f / 8.0f);
            const float inv = __builtin_powf(500000.0f, ex);
            const float ang = (float)pos[row0 + tok] * inv;
            const double ad = (double)ang; const double kq = __builtin_rint(ad * 0.15915494309189535); const float r = (float)(ad - kq * 6.283185307179586);
            cs[e * 2] = __cosf(r); cs[e * 2 + 1] = __sinf(r); }
        __syncthreads();
        {
            const int tok = F.tid >> 4, u = F.tid & 15, u7 = u & 7; bf16_t* zr = z + (row0 + tok) * INWP;
            const float c16 = cs[(tok * 24 + u) * 2], s16 = cs[(tok * 24 + u) * 2 + 1], c8 = cs[(tok * 24 + 16 + u7) * 2], s8 = cs[(tok * 24 + 16 + u7) * 2 + 1];
            float x1[19], x2[19];
#pragma unroll
            for (int it = 0; it < 19; ++it) { const int c1 = it < 8 ? C_QA + it * 128 + u : it < 10 ? C_KA + (it - 8) * 128 + u : it < 18 ? C_QI + (2 * (it - 10) + (u >> 3)) * 64 + u7 : C_KI + u7;
                const int dist = it < 10 ? 16 : 8; x1[it] = bf2f(zr[c1]); x2[it] = bf2f(zr[c1 + dist]); }
#pragma unroll
            for (int it = 0; it < 18; ++it) { const int c1 = it < 8 ? C_QA + it * 128 + u : it < 10 ? C_KA + (it - 8) * 128 + u : C_QI + (2 * (it - 10) + (u >> 3)) * 64 + u7;
                const int dist = it < 10 ? 16 : 8; const float cc = it < 10 ? c16 : c8, sn = it < 10 ? s16 : s8;
                zr[c1] = (bf16_t)(cvt_pk_bf16(x1[it] * cc - x2[it] * sn, 0.f) & 0xffffu); zr[c1 + dist] = (bf16_t)(cvt_pk_bf16(x2[it] * cc + x1[it] * sn, 0.f) & 0xffffu); }
            if (u < 8) { bf16_t* kd = kidx + (row0 + tok) * 64; kd[u7] = (bf16_t)(cvt_pk_bf16(x1[18] * c8 - x2[18] * s8, 0.f) & 0xffffu); kd[u7 + 8] = (bf16_t)(cvt_pk_bf16(x2[18] * c8 + x1[18] * s8, 0.f) & 0xffffu); }
        }
        {
            unsigned short v[4];
#pragma unroll
            for (int it = 0; it < 4; ++it) { const int j = F.tid + it * NTHR, tok = j >> 6, q = j & 63; const bf16_t* zr = z + (row0 + tok) * INWP; v[it] = q < 48 ? zr[C_KI + 16 + q] : zr[C_WI + q - 48]; }
#pragma unroll
            for (int it = 0; it < 4; ++it) { const int j = F.tid + it * NTHR, tok = j >> 6, q = j & 63;
                if (q < 48) kidx[(row0 + tok) * 64 + 16 + q] = v[it]; else wif[(row0 + tok) * 16 + (q - 48)] = bf2f(v[it]); }
        }
        {
            u32x4 v[8];
#pragma unroll
            for (int i = 0; i < 8; ++i) { const int id = F.tid + NTHR * i, l = id & 63, kk = (id >> 6) & 7, h = id >> 9; v[i] = *(const u32x4*)(z + (row0 + (l & 31)) * INWP + C_KB + h * 128 + kk * 16 + (l >> 5) * 8); }
#pragma unroll
            for (int i = 0; i < 8; ++i) { const int id = F.tid + NTHR * i, l = id & 63, kk = (id >> 6) & 7, h = id >> 9; *(u32x4*)(kbF + ((((size_t)(b * 8 + h) * 256 + blk) * 8 + kk) * 64 + l) * 8) = v[i]; }
        }
#pragma unroll
        for (int i0 = 0; i0 < 8; i0 += 4) {
            unsigned short e[4][8];
#pragma unroll
            for (int i = 0; i < 4; ++i) { const int id = F.tid + NTHR * (i0 + i), l = id & 63, sb = (id >> 6) & 1, db = (id >> 7) & 3, h = id >> 9;
                const bf16_t* vp = z + (row0 + 16 * sb + 4 * (l >> 5)) * INWP + C_VB + h * 128 + 32 * db + (l & 31);
#pragma unroll
                for (int j = 0; j < 8; ++j) e[i][j] = vp[(size_t)(8 * (j >> 2) + (j & 3)) * INWP]; }
#pragma unroll
            for (int i = 0; i < 4; ++i) { const int id = F.tid + NTHR * (i0 + i), l = id & 63, sb = (id >> 6) & 1, db = (id >> 7) & 3, h = id >> 9;
                u32x4 w = {(unsigned)e[i][0] | ((unsigned)e[i][1] << 16), (unsigned)e[i][2] | ((unsigned)e[i][3] << 16), (unsigned)e[i][4] | ((unsigned)e[i][5] << 16), (unsigned)e[i][6] | ((unsigned)e[i][7] << 16)};
                *(u32x4*)(vbF + (((((size_t)(b * 8 + h) * 256 + blk) * 4 + db) * 2 + sb) * 64 + l) * 8) = w; }
        }
    }
}

#define MFMA32(a, b, c) __builtin_amdgcn_mfma_f32_32x32x16_bf16((a), (b), (c), 0, 0, 0)
DI void idx_chunk(const Frame& F, int b, int c) {
    const int l = F.lane, m = l & 31, hi = l >> 5, q = (m >> 2) & 1, head = ((m >> 3) << 2) | (m & 3);
    const int t0 = 64 * c + 8 * F.wave;
    const bf16_t* z = F.at<bf16_t>(WS_Z); const float* wif = F.at<float>(WS_WIF);
    LAS char* kl = (LAS char*)F.lds;
    bf16x8 Aq[4][4]; f32x4 wv[4][4];
#pragma unroll
    for (int p = 0; p < 4; ++p) { const bf16_t* qp = z + ((size_t)b * SEQ + t0 + 2 * p + q) * INWP + C_QI + head * 64 + hi * 8;
#pragma unroll
        for (int kk = 0; kk < 4; ++kk) Aq[p][kk] = *(const bf16x8*)(qp + kk * 16);
        const float* wp = wif + ((size_t)b * SEQ + t0 + 2 * p + hi) * 16;
#pragma unroll
        for (int r4 = 0; r4 < 4; ++r4) wv[p][r4] = *(const f32x4*)(wp + 4 * r4); }
    const int ntile = c + 1, L = 64 * (c + 1);
    const int skey = F.tid >> 3, sch = F.tid & 7;
    const bf16_t* kg = F.at<bf16_t>(WS_KIDX) + ((size_t)b * SEQ + skey) * 64 + sch * 8;
    const int swr = skey * 128 + ((sch ^ (skey & 7)) << 4);
    bf16_t* scb = F.at<bf16_t>(WS_SC) + (size_t)b * SC_PER_B + (size_t)2048 * c * (c + 1) + (size_t)(8 * F.wave + hi) * L + m;
    __syncthreads();
    u32x4 st = *(const u32x4*)kg;
    *(LAS u32x4*)(kl + swr) = st;
    if (ntile > 1) st = *(const u32x4*)(kg + (size_t)64 * 64);
    __syncthreads();
    for (int tl = 0; tl < ntile; ++tl) {
        LAS const char* kb = kl + (tl & 1) * 8192;
#pragma unroll
        for (int hb = 0; hb < 2; ++hb) {
            bf16x8 Bk[4];
            const int key = hb * 32 + m;
#pragma unroll
            for (int kk = 0; kk < 4; ++kk) Bk[kk] = *(LAS const bf16x8*)(kb + key * 128 + (((kk * 2 + hi) ^ (key & 7)) << 4));
#pragma unroll
            for (int p = 0; p < 4; ++p) {
                f32x16 acc = {};
#pragma unroll
                for (int kk = 0; kk < 4; ++kk) acc = MFMA32(Aq[p][kk], Bk[kk], acc);
                float sc_ = 0.f;
#pragma unroll
                for (int r = 0; r < 16; ++r) sc_ = fmaf(__int_as_float(max(__float_as_int(acc[r]), 0)), wv[p][r >> 2][r & 3], sc_);
                scb[(size_t)(2 * p) * L + tl * 64 + hb * 32] = (bf16_t)(cvt_pk_bf16(sc_, 0.f) & 0xffffu);
                if (p & 1) __builtin_amdgcn_sched_barrier(0);
            }
        }
        if (tl + 1 < ntile) {
            *(LAS u32x4*)(kl + ((tl + 1) & 1) * 8192 + swr) = st;
            if (tl + 2 < ntile) st = *(const u32x4*)(kg + (size_t)(tl + 2) * 64 * 64);
        }
        __syncthreads();
    }
}
DI void p4_indexer(const Frame& F) {
    for (int item = F.wg; item < 256; item += F.G) { const int b = item >> 6, pi = item & 63; idx_chunk(F, b, pi); idx_chunk(F, b, 127 - pi); }
}

DI unsigned f2key(float f) { const unsigned u = __float_as_uint(f); return u ^ ((unsigned)((int)u >> 31) | 0x80000000u); }
DI unsigned umed3(unsigned a, unsigned b, unsigned c) { const unsigned mx = a > b ? a : b, mn = a > b ? b : a; const unsigned t = mx < c ? mx : c; return mn > t ? mn : t; }
DI int wave_allsum(int v) {
    v += __builtin_amdgcn_update_dpp(0, v, 0xB1, 0xF, 0xF, false);
    v += __builtin_amdgcn_update_dpp(0, v, 0x4E, 0xF, 0xF, false);
    v += __builtin_amdgcn_update_dpp(0, v, 0x141, 0xF, 0xF, false);
    v += __builtin_amdgcn_update_dpp(0, v, 0x140, 0xF, 0xF, false);
    { auto r = __builtin_amdgcn_permlane16_swap((unsigned)v, (unsigned)v, false, false); v = (int)(r[0] + r[1]); }
    { auto r = __builtin_amdgcn_permlane32_swap((unsigned)v, (unsigned)v, false, false); v = (int)(r[0] + r[1]); }
    return v;
}
template <int NBITS> DI int wave_total(int pl) { int tot = 0;
#pragma unroll
    for (int b = 0; b < NBITS; ++b) tot += __popcll(__ballot((pl >> b) & 1)) << b;
    return tot; }
constexpr int NCVW = 2, NPW = NWAVES - NCVW;
constexpr int CVJ1 = NE * 32 * 64, CVJ2 = NE * 32 * 32, CVJ = CVJ1 + CVJ2;
struct CvJob { const float* src; unsigned char* dst; int N; };
DI CvJob cv_job(const Frame& F, int job) {
    CvJob J;
    if (job < CVJ1) { const int e = job >> 11, r = job & 2047, kt = r >> 6, nt = r & 63; J.N = 4096;
        J.src = F.kp->in[I_W1] + (size_t)e * 2048 * 4096 + (size_t)(kt * 64) * 4096 + nt * 64; J.dst = F.at<unsigned char>(WS_W1T) + (size_t)e * 4096 * 2048 + (size_t)(nt * 64) * 2048 + kt * 64; }
    else { const int j2 = job - CVJ1, e = j2 >> 10, r = j2 & 1023, kt = r >> 5, nt = r & 31; J.N = 2048;
        J.src = F.kp->in[I_W2] + (size_t)e * 2048 * 2048 + (size_t)(kt * 64) * 2048 + nt * 64; J.dst = F.at<unsigned char>(WS_W2T) + (size_t)e * 2048 * 2048 + (size_t)(nt * 64) * 2048 + kt * 64; }
    return J;
}
DI void cv_load(const CvJob& J, int l, f32x4 (&v)[16]) {
    const float* p = J.src + (size_t)((l >> 4) * 8) * J.N + (l & 15) * 4;
#pragma unroll
    for (int h = 0; h < 2; ++h)
#pragma unroll
        for (int i = 0; i < 8; ++i) v[h * 8 + i] = *(const f32x4*)(p + (size_t)(h * 32 + i) * J.N);
}
DI void cv_finish(const CvJob& J, int l, const f32x4 (&v)[16], LAS unsigned char* Tl) {
    const int c4 = (l & 15) * 4, g = l >> 4;
#pragma unroll
    for (int h = 0; h < 2; ++h)
#pragma unroll
        for (int q = 0; q < 2; ++q)
#pragma unroll
            for (int j = 0; j < 4; ++j)
                *(LAS unsigned*)(Tl + (c4 + j) * 80 + h * 32 + g * 8 + q * 4) = pk_fp8x4(clamp448(v[h * 8 + q * 4][j] * 32.f), clamp448(v[h * 8 + q * 4 + 1][j] * 32.f), clamp448(v[h * 8 + q * 4 + 2][j] * 32.f), clamp448(v[h * 8 + q * 4 + 3][j] * 32.f));
    u32x4 o[4];
#pragma unroll
    for (int p = 0; p < 4; ++p) o[p] = *(LAS const u32x4*)(Tl + ((l >> 2) + 16 * p) * 80 + (l & 3) * 16);
#pragma unroll
    for (int p = 0; p < 4; ++p) *(u32x4*)(J.dst + (size_t)((l >> 2) + 16 * p) * 2048 + (l & 3) * 16) = o[p];
}
DI void cv_stream(const Frame& F) {
    const int cw = F.wg * NCVW + (F.wave - NPW), ncw = F.G * NCVW, l = F.lane;
    LAS unsigned char* Tl = F.lds + 8192 + F.wave * 16640;
#pragma unroll 1
    for (int job = cw; job < CVJ; job += 6 * ncw) {
        f32x4 va[16], vb[16], vc[16];
        const int j1 = job + ncw, j2 = job + 2 * ncw, j3 = job + 3 * ncw, j4 = job + 4 * ncw, j5 = job + 5 * ncw;
        const CvJob J0 = cv_job(F, job), J1 = cv_job(F, j1 < CVJ ? j1 : job), J2 = cv_job(F, j2 < CVJ ? j2 : job);
#define CV_SB __builtin_amdgcn_sched_barrier(0)
        cv_load(J0, l, va); CV_SB; cv_load(J1, l, vb); CV_SB; cv_load(J2, l, vc); CV_SB;
        cv_finish(J0, l, va, Tl); CV_SB;
        const CvJob J3 = cv_job(F, j3 < CVJ ? j3 : job); cv_load(J3, l, va); CV_SB;
        if (j1 < CVJ) cv_finish(J1, l, vb, Tl);
        CV_SB;
        const CvJob J4 = cv_job(F, j4 < CVJ ? j4 : job); cv_load(J4, l, vb); CV_SB;
        if (j2 < CVJ) cv_finish(J2, l, vc, Tl);
        CV_SB;
        const CvJob J5 = cv_job(F, j5 < CVJ ? j5 : job); cv_load(J5, l, vc); CV_SB;
        if (j3 < CVJ) cv_finish(J3, l, va, Tl);
        CV_SB;
        if (j4 < CVJ) cv_finish(J4, l, vb, Tl);
        CV_SB;
        if (j5 < CVJ) cv_finish(J5, l, vc, Tl);
#undef CV_SB
    }
}
DI int p56_grab(LAS int* ctr, int lane) { int j = 0; if (lane == 0) j = __hip_atomic_fetch_add(ctr, 1, __ATOMIC_RELAXED, __HIP_MEMORY_SCOPE_WORKGROUP); return __builtin_amdgcn_readfirstlane(j); }
constexpr int P56_CTR = LDS_BYTES - 64;
DI void p5_select(const Frame& F) {
    { LAS int* ctr0 = (LAS int*)(F.lds + P56_CTR); if (F.tid < 2) ctr0[F.tid] = 0; __syncthreads(); }
    if (F.wave >= NPW) cv_stream(F);
    unsigned long long* sel = F.at<unsigned long long>(WS_SEL); const bf16_t* sc = F.at<bf16_t>(WS_SC);
    const int lane = F.lane;
    LAS int* ctr = (LAS int*)(F.lds + P56_CTR);
    LAS unsigned long long* wsl = (LAS unsigned long long*)(F.lds + F.wave * 1024);
    LAS unsigned* cl = (LAS unsigned*)(F.lds + 8192 + F.wave * 16640);
    for (;;) {
        const int row = p56_grab(ctr, lane) * F.G + F.wg; if (row >= T) break;
        const int b = row >> 13, t = row & 8191, c = t >> 6;
        if (c < 4) { if (lane <= c) sel[(size_t)row * 128 + lane] = ~0ull; continue; }
        const bf16_t* rowp = sc + (size_t)b * SC_PER_B + (size_t)2048 * c * (c + 1) + (size_t)(t & 63) * 64 * (c + 1);
        unsigned k[128];
        {
            float kf[128];
#pragma unroll
            for (int g = 0; g < 8; ++g) { const bf16_t* rg_ = rowp + ((g * 16 <= c) ? g * 1024 : 0);
#pragma unroll
                for (int i = 0; i < 16; ++i) kf[g * 16 + i] = bf2f(rg_[(unsigned)(i * 64 + lane)]); }
#pragma unroll
            for (int i = 0; i < 128; ++i) k[i] = (i <= c) ? f2key(kf[i]) : 0u;
        }
        unsigned ta = 0u, tb = 0u, tc = 0u, td = 0u;
#pragma unroll
        for (int g = 0; g < 4; ++g) { if (g * 32 <= c) {
#pragma unroll
            for (int i = g * 32; i < g * 32 + 32; ++i) { const unsigned x = k[i]; const unsigned nd = umed3(tc, td, x), nc = umed3(tb, tc, x), nb = umed3(ta, tb, x); ta = ta > x ? ta : x; tb = nb; tc = nc; td = nd; } } }
        unsigned L = td;
#pragma unroll
        for (int o = 32; o >= 1; o >>= 1) { const unsigned y = (unsigned)__shfl_xor((int)L, o); L = L < y ? L : y; }
        unsigned wa = (unsigned)lane * 4u;
#pragma unroll
        for (int g = 0; g < 4; ++g) { if (g * 32 <= c) {
#pragma unroll
            for (int i = g * 32; i < g * 32 + 32; ++i) { *(LAS unsigned*)((LAS char*)cl + wa) = k[i]; wa += (k[i] >= L && wa < 64u * 256u) ? 256u : 0u; } } }
        const int npl = (int)(wa >> 8);
        int mx = npl;
#pragma unroll
        for (int o = 32; o >= 1; o >>= 1) { const int y = __shfl_xor(mx, o); mx = mx > y ? mx : y; }
        asm volatile("s_waitcnt lgkmcnt(0)" ::: "memory");
        unsigned U = ta;
#pragma unroll
        for (int o = 32; o >= 1; o >>= 1) { const unsigned y = (unsigned)__shfl_xor((int)U, o); U = U > y ? U : y; }
        const unsigned dif = (unsigned)__builtin_amdgcn_readfirstlane((int)(L ^ U));
        const int hb = dif ? 31 - __builtin_clz(dif) : -1;
        unsigned pfx = (hb >= 31) ? 0u : (hb < 0 ? L : (L & ~((2u << hb) - 1u)));
        int cge, cgt;
        if (mx <= 24) {
            unsigned cc[24];
#pragma unroll
            for (int j = 0; j < 24; ++j) { const unsigned v = cl[j * 64 + lane]; cc[j] = (j < npl) ? v : 0u; asm volatile("" : "+v"(cc[j])); }
            for (int bit = hb; bit >= 0; --bit) { const unsigned cand = pfx | (1u << bit); int pl = 0;
#pragma unroll
                for (int j = 0; j < 24; ++j) pl += (cc[j] >= cand) ? 1 : 0;
                pfx = (wave_allsum(pl) >= 256) ? cand : pfx; }
            int p1 = 0, p2 = 0;
#pragma unroll
            for (int j = 0; j < 24; ++j) { p1 += (cc[j] >= pfx) ? 1 : 0; p2 += (cc[j] > pfx) ? 1 : 0; }
            cge = __builtin_amdgcn_readfirstlane(wave_allsum(p1)); cgt = __builtin_amdgcn_readfirstlane(wave_allsum(p2));
        } else {
            for (int bit = hb; bit >= 0; --bit) { const unsigned cand = pfx | (1u << bit); int pl = 0;
#pragma unroll
                for (int i = 0; i < 128; ++i) pl += (k[i] >= cand) ? 1 : 0;
                pfx = (wave_allsum(pl) >= 256) ? cand : pfx; }
            unsigned thrc = pfx; asm volatile("" : "+v"(thrc));
            int p1 = 0, p2 = 0;
#pragma unroll
            for (int i = 0; i < 128; ++i) { p1 += (k[i] >= thrc) ? 1 : 0; p2 += (k[i] > thrc) ? 1 : 0; }
            cge = __builtin_amdgcn_readfirstlane(wave_allsum(p1)); cgt = __builtin_amdgcn_readfirstlane(wave_allsum(p2));
        }
        const unsigned prefix = (unsigned)__builtin_amdgcn_readfirstlane((int)pfx);
        const unsigned thr = prefix;
        if (cge == 256) {
#pragma unroll
            for (int g = 0; g < 32; ++g) { if ((g >> 3) * 32 <= c) { unsigned long long w4[4];
#pragma unroll
                for (int j = 0; j < 4; ++j) w4[j] = __ballot(k[g * 4 + j] >= thr);
                if (lane == 0) {
#pragma unroll
                    for (int j = 0; j < 4; ++j) wsl[g * 4 + j] = w4[j]; }
                __builtin_amdgcn_sched_barrier(0); } }
        } else {
            const int allowed = 256 - cgt; int R = 0;
#pragma unroll
            for (int i = 0; i < 128; ++i) {
                unsigned long long gtm = __ballot(k[i] > thr), tm = __ballot(k[i] == thr);
                const int nt = __popcll(tm);
                if (R + nt > allowed) { int keepn = allowed - R; if (keepn < 0) keepn = 0; while (__popcll(tm) > keepn) tm &= ~(1ull << (63 - __clzll(tm))); }
                R += nt;
                const unsigned long long word = gtm | tm;
                if (lane == 0) wsl[i] = word;
                if ((i & 3) == 3) __builtin_amdgcn_sched_barrier(0);
            }
        }
        asm volatile("s_waitcnt lgkmcnt(0)" ::: "memory");
        if (lane <= c) sel[(size_t)row * 128 + lane] = wsl[lane];
        if (lane + 64 <= c) sel[(size_t)row * 128 + 64 + lane] = wsl[64 + lane];
    }
}

DI bf16x8 pack8(const f32x16& x, int s) {
    const u32x4 p = {cvt_pk_bf16(x[8 * s], x[8 * s + 1]), cvt_pk_bf16(x[8 * s + 2], x[8 * s + 3]), cvt_pk_bf16(x[8 * s + 4], x[8 * s + 5]), cvt_pk_bf16(x[8 * s + 6], x[8 * s + 7])};
    return __builtin_bit_cast(bf16x8, p);
}
DI void p6_stick(const Frame& F) {
    const int l = F.lane, n = l & 31, hi = l >> 5;
    const bf16_t* z = F.at<bf16_t>(WS_Z); const bf16x8* kbF = F.at<bf16x8>(WS_KBF); const bf16x8* vbF = F.at<bf16x8>(WS_VBF); bf16_t* ob = F.at<bf16_t>(WS_OB);
    constexpr float C2 = 0.088388347648318440f * 1.4426950408889634f;
    LAS int* ctr = (LAS int*)(F.lds + P56_CTR) + 1;
    for (;;) {
        const int u = p56_grab(ctr, l) * F.G + F.wg; if (u >= NB * 8 * 256) break;
        const int qt = 255 - (u >> 5), bh = u & 31, b = bh >> 3, h = bh & 7, t0 = qt * 32;
        bf16x8 Bq[8];
        { const bf16_t* qp = z + ((size_t)b * SEQ + t0 + n) * INWP + C_QB + h * 128 + hi * 8;
#pragma unroll
          for (int kk = 0; kk < 8; ++kk) Bq[kk] = *(const bf16x8*)(qp + kk * 16); }
        f32x16 oT[4] = {};
        float carry = 0.f;
        bf16x8 Kn[8];
        { const bf16x8* kc0 = kbF + (((size_t)(b * 8 + h) * 256 + qt) * 8) * 64 + l;
#pragma unroll
          for (int kk = 0; kk < 8; ++kk) Kn[kk] = kc0[kk * 64]; }
        bf16x8 Vn[8];
        { const bf16x8* vc0 = vbF + (((size_t)(b * 8 + h) * 256 + qt) * 8) * 64 + l;
#pragma unroll
          for (int kk = 0; kk < 8; ++kk) Vn[kk] = vc0[kk * 64]; }
        for (int kb = qt; kb >= 0; --kb) {
            const bf16x8* kc = kbF + (((size_t)(b * 8 + h) * 256 + (kb > 0 ? kb - 1 : 0)) * 8) * 64 + l;
            const bf16x8* vc = vbF + (((size_t)(b * 8 + h) * 256 + (kb > 0 ? kb - 1 : 0)) * 8) * 64 + l;
            bf16x8 Ka[8], Va[8];
#pragma unroll
            for (int kk = 0; kk < 8; ++kk) { Ka[kk] = Kn[kk]; Va[kk] = Vn[kk]; }
#pragma unroll
            for (int kk = 0; kk < 8; ++kk) Kn[kk] = kc[kk * 64];
#pragma unroll
            for (int kk = 0; kk < 8; ++kk) Vn[kk] = vc[kk * 64];
            f32x16 S = {};
#pragma unroll
            for (int kk = 0; kk < 8; ++kk) S = MFMA32(Ka[kk], Bq[kk], S);
            const bool diag = (kb == qt);
            float lk[16], lb[16];
#pragma unroll
            for (int r = 0; r < 16; ++r) {
                const float z2 = S[r] * C2;
                const float e = __builtin_amdgcn_exp2f(-__builtin_fabsf(z2));
                const float sp = fmaxf(z2, 0.f) + __builtin_amdgcn_logf(1.0f + e);
                const int srel = (r & 3) + 8 * (r >> 2) + 4 * hi;
                const bool causal = !diag || (srel < n);
                lk[r] = causal ? -sp : 0.f; lb[r] = z2 - sp;
                S[r] = causal ? 0.f : -1e30f;
            }
            float G[4];
#pragma unroll
            for (int q = 0; q < 4; ++q) G[q] = (lk[4 * q] + lk[4 * q + 1]) + (lk[4 * q + 2] + lk[4 * q + 3]);
            float Ev[4], Ov[4];
#pragma unroll
            for (int q = 0; q < 4; ++q) { auto rr = __builtin_amdgcn_permlane32_swap(__float_as_uint(G[q]), __float_as_uint(G[q]), false, false); Ev[q] = __uint_as_float(rr[0]); Ov[q] = __uint_as_float(rr[1]); }
            float Rq[4]; Rq[3] = 0.f; Rq[2] = Ev[3] + Ov[3]; Rq[1] = Rq[2] + (Ev[2] + Ov[2]); Rq[0] = Rq[1] + (Ev[1] + Ov[1]);
            const float tot = Rq[0] + (Ev[0] + Ov[0]);
#pragma unroll
            for (int q = 0; q < 4; ++q) {
                const float base = carry + Rq[q] + (hi ? 0.f : Ov[q]);
                const float g3 = base, g2 = g3 + lk[4 * q + 3], g1 = g2 + lk[4 * q + 2], g0 = g1 + lk[4 * q + 1];
                S[4 * q + 3] = __builtin_amdgcn_exp2f(lb[4 * q + 3] + g3 + S[4 * q + 3]);
                S[4 * q + 2] = __builtin_amdgcn_exp2f(lb[4 * q + 2] + g2 + S[4 * q + 2]);
                S[4 * q + 1] = __builtin_amdgcn_exp2f(lb[4 * q + 1] + g1 + S[4 * q + 1]);
                S[4 * q + 0] = __builtin_amdgcn_exp2f(lb[4 * q + 0] + g0 + S[4 * q + 0]);
            }
            carry += tot;
            const bf16x8 P0 = pack8(S, 0), P1 = pack8(S, 1);
#pragma unroll
            for (int db = 0; db < 4; ++db) { oT[db] = MFMA32(Va[db * 2], P0, oT[db]); oT[db] = MFMA32(Va[db * 2 + 1], P1, oT[db]); }
            if (__all(carry < -150.5f)) break;
        }
        unsigned char* op = (unsigned char*)ob + ((size_t)b * SEQ + t0 + n) * 1024 + h * 128 + 4 * hi;
#pragma unroll
        for (int db = 0; db < 4; ++db)
#pragma unroll
            for (int q = 0; q < 4; ++q) *(unsigned*)(op + 32 * db + 8 * q) = pk_fp8x4(clamp448(oT[db][4 * q] * 32.f), clamp448(oT[db][4 * q + 1] * 32.f), clamp448(oT[db][4 * q + 2] * 32.f), clamp448(oT[db][4 * q + 3] * 32.f));
    }
}

namespace dsa {
constexpr float SCALE = 0.088388347648318440f, THR = 8.f;
constexpr int SHM_V = 64 * 128 * 2, SHM_K = 64 * 128 * 2, SHM_ATTN = 2 * SHM_V + 2 * SHM_K + 8 * 64 * 4;
#define KSWZ(row, colB) ((row) * 256 + ((colB) ^ (((row) & 7) << 4)))
#define SBAR() __builtin_amdgcn_sched_barrier(0)
DI int crow(int r, int hi) { return (r & 3) + 8 * (r >> 2) + 4 * hi; }
DI void apply_mask(f32x16& p0, f32x16& p1, unsigned long long w, int hi) {
    const unsigned lo = (unsigned)w >> (4 * hi), up = (unsigned)(w >> 32) >> (4 * hi);
#pragma unroll
    for (int r = 0; r < 16; ++r) { const int bp = (r & 3) + 8 * (r >> 2);
        const unsigned t0 = (unsigned)(((int)(lo << (31 - bp))) >> 31), t1 = (unsigned)(((int)(up << (31 - bp))) >> 31);
        p0[r] = __uint_as_float((__float_as_uint(p0[r]) & t0) | (~t0 & 0xff800000u));
        p1[r] = __uint_as_float((__float_as_uint(p1[r]) & t1) | (~t1 & 0xff800000u)); }
}
DI void partialSM(f32x16& p0, f32x16& p1, float& m_reg, float& mn, float& alpha) {
    constexpr float C = SCALE * 1.4426950408889634f;
    float pmax = p0[0];
#pragma unroll
    for (int r = 1; r < 16; ++r) pmax = fmaxf(pmax, p0[r]);
#pragma unroll
    for (int r = 0; r < 16; ++r) pmax = fmaxf(pmax, p1[r]);
    { auto rr = __builtin_amdgcn_permlane32_swap(__float_as_uint(pmax), __float_as_uint(pmax), false, false);
      pmax = fmaxf(__uint_as_float(rr[0]), __uint_as_float(rr[1])); }
    if (__builtin_expect(__all(pmax - m_reg <= THR / SCALE), 1)) { mn = m_reg; alpha = 1.f; }
    else { mn = fmaxf(m_reg, pmax); alpha = __builtin_amdgcn_exp2f((m_reg - mn) * C); m_reg = mn; }
    const float mnC = -mn * C;
#pragma unroll
    for (int r = 0; r < 16; ++r) p0[r] = fmaf(p0[r], C, mnC);
#pragma unroll
    for (int r = 0; r < 16; ++r) p1[r] = fmaf(p1[r], C, mnC);
#pragma unroll
    for (int r = 0; r < 16; ++r) p0[r] = __builtin_amdgcn_exp2f(p0[r]);
}
DI void finishSM(f32x16& p0, f32x16& p1, float alpha, float& l_reg, bf16x8& pa0, bf16x8& pa1, bf16x8& pa2, bf16x8& pa3) {
#pragma unroll
    for (int r = 0; r < 16; ++r) p1[r] = __builtin_amdgcn_exp2f(p1[r]);
    float ps = 0;
#pragma unroll
    for (int r = 0; r < 16; ++r) ps += p0[r];
#pragma unroll
    for (int r = 0; r < 16; ++r) ps += p1[r];
    { auto rr = __builtin_amdgcn_permlane32_swap(__float_as_uint(ps), __float_as_uint(ps), false, false);
      ps = __uint_as_float(rr[0]) + __uint_as_float(rr[1]); }
    l_reg = l_reg * alpha + ps;
#define PK4(P, BASE, OUT) do { unsigned a0 = cvt_pk_bf16(P[BASE + 0], P[BASE + 1]), a1 = cvt_pk_bf16(P[BASE + 2], P[BASE + 3]);   \
    unsigned b0 = cvt_pk_bf16(P[BASE + 4], P[BASE + 5]), b1 = cvt_pk_bf16(P[BASE + 6], P[BASE + 7]);                              \
    auto r0 = __builtin_amdgcn_permlane32_swap(a0, b0, false, false); auto r1 = __builtin_amdgcn_permlane32_swap(a1, b1, false, false); \
    u32x4 w = {r0[0], r1[0], r0[1], r1[1]}; OUT = __builtin_bit_cast(bf16x8, w); } while (0)
    PK4(p0, 0, pa0); PK4(p0, 8, pa1); PK4(p1, 0, pa2); PK4(p1, 8, pa3);
#undef PK4
}
DI void qkt(f32x16& p0, f32x16& p1, LAS const char* Ks, const bf16x8* qr, int r32, int hi) {
    p0 = f32x16{}; p1 = f32x16{};
#pragma unroll
    for (int d0 = 0; d0 < 8; ++d0) { const int cb = (d0 * 16 + hi * 8) * 2;
        const bf16x8 b0 = *(LAS const bf16x8*)(Ks + KSWZ(r32, cb));
        const bf16x8 b1 = *(LAS const bf16x8*)(Ks + KSWZ(32 + r32, cb));
        p0 = MFMA32(b0, qr[d0], p0);
        p1 = MFMA32(b1, qr[d0], p1); }
}
DI int v_st(int k, int c) { const int kk = (k & ~0xC) | ((k & 4) << 1) | ((k & 8) >> 1); return ((kk >> 3) * 4 + (c >> 5)) * 512 + ((kk & 7) * 32 + (c & 31)) * 2; }
DI int v_rd_base(int lane) { return ((lane & 3) << 3) | (((lane >> 2) & 3) << 6) | (((lane >> 4) & 1) << 5) | (((lane >> 5) & 1) << 8); }
constexpr int v_rd_off(int d0, int ks, int half) { return d0 * 512 + ks * 4096 + half * 2048; }
template <int OFF> DI s16x4 tr_read(int vb) { s16x4 r; asm volatile("ds_read_b64_tr_b16 %0, %1 offset:%2" : "=&v"(r) : "v"(vb), "i"(OFF) : "memory"); return r; }
template <int D0> DI void pv_one(f32x16& od, int vb, bf16x8 pa0, bf16x8 pa1, bf16x8 pa2, bf16x8 pa3) {
    const s16x4 l0 = tr_read<v_rd_off(D0, 0, 0)>(vb), h0 = tr_read<v_rd_off(D0, 0, 1)>(vb), l1 = tr_read<v_rd_off(D0, 1, 0)>(vb), h1 = tr_read<v_rd_off(D0, 1, 1)>(vb);
    const s16x4 l2 = tr_read<v_rd_off(D0, 2, 0)>(vb), h2 = tr_read<v_rd_off(D0, 2, 1)>(vb), l3 = tr_read<v_rd_off(D0, 3, 0)>(vb), h3 = tr_read<v_rd_off(D0, 3, 1)>(vb);
    asm volatile("s_waitcnt lgkmcnt(0)" ::: "memory"); SBAR();
#define PKV(L, H) (bf16x8){L[0], L[1], L[2], L[3], H[0], H[1], H[2], H[3]}
    od = MFMA32(pa0, PKV(l0, h0), od);
    od = MFMA32(pa1, PKV(l1, h1), od);
    od = MFMA32(pa2, PKV(l2, h2), od);
    od = MFMA32(pa3, PKV(l3, h3), od);
#undef PKV
}
DI void pv_d0(f32x16* o, int vb, bf16x8 pa0, bf16x8 pa1, bf16x8 pa2, bf16x8 pa3) {
    pv_one<0>(o[0], vb, pa0, pa1, pa2, pa3); pv_one<1>(o[1], vb, pa0, pa1, pa2, pa3); pv_one<2>(o[2], vb, pa0, pa1, pa2, pa3); pv_one<3>(o[3], vb, pa0, pa1, pa2, pa3);
}
DI void unit(const bf16_t* __restrict__ Qw, const bf16_t* __restrict__ Kh, const bf16_t* __restrict__ Vh, const unsigned long long* __restrict__ selw, int NT,
             bf16_t* __restrict__ Ob, LAS char* lds) {
    const int tid = threadIdx.x, wid = tid >> 6, lane = tid & 63, r32 = lane & 31, hi = lane >> 5;
    constexpr long LDK = INWP;
    LAS char* V_lds = lds; LAS char* K_lds = lds + 2 * SHM_V;
    LAS float* wsl = (LAS float*)(lds + 2 * SHM_V + 2 * SHM_K) + wid * 64; LAS float* li_l = wsl; LAS float* al_l = wsl + 32;
    float m_reg = -1e30f, l_reg = 0; f32x16 o[4] = {}; bf16x8 qr[8];
#pragma unroll
    for (int d0 = 0; d0 < 8; ++d0) qr[d0] = *(const bf16x8*)(Qw + d0 * 16);
    const int sr = tid >> 4, sc = (tid & 15) * 8, vst0 = v_st(sr, sc), vst1 = v_st(32 + sr, sc);
    const int vb0 = (int)(uintptr_t)V_lds + v_rd_base(lane);
    struct { bf16x8 vs0, vs1, ks0, ks1; } sr_[1];
    const int NTe = (NT + 1) & ~1;
    const unsigned soff0 = (unsigned)(sr * (int)LDK + sc) * 2u, soff1 = soff0 + 32u * (unsigned)LDK * 2u;
#define SLOAD(i, k0) do { const char* vb_ = (const char*)Vh + (size_t)(k0) * LDK * 2; const char* kb_ = (const char*)Kh + (size_t)(k0) * LDK * 2; \
    sr_[i].vs0 = *(const bf16x8*)(vb_ + soff0); sr_[i].vs1 = *(const bf16x8*)(vb_ + soff1); sr_[i].ks0 = *(const bf16x8*)(kb_ + soff0); sr_[i].ks1 = *(const bf16x8*)(kb_ + soff1); } while (0)
#define SWRITE(b, i) do { *(LAS bf16x8*)(V_lds + (b) * SHM_V + vst0) = sr_[i].vs0;          \
    *(LAS bf16x8*)(V_lds + (b) * SHM_V + vst1) = sr_[i].vs1; const int kc = sc * 2;               \
    *(LAS bf16x8*)(K_lds + (b) * SHM_K + KSWZ(sr, kc)) = sr_[i].ks0;                       \
    *(LAS bf16x8*)(K_lds + (b) * SHM_K + KSWZ(32 + sr, kc)) = sr_[i].ks1; } while (0)
#define SWAIT() asm volatile("s_waitcnt vmcnt(0)" ::: "memory")
#define RESC(a) do { if (__any((a) < 1.f)) { if (hi == 0) al_l[r32] = (a); asm volatile("s_waitcnt lgkmcnt(0)" ::: "memory"); \
    _Pragma("unroll") for (int d = 0; d < 4; ++d) _Pragma("unroll") for (int r = 0; r < 16; ++r) o[d][r] *= al_l[crow(r, hi)]; } } while (0)
    const unsigned seloff = (unsigned)r32 * 1024u;
#define MASKW(jt) (((jt) < NT) ? *(const unsigned long long*)((const char*)(selw + (jt)) + seloff) : 0ull)
    f32x16 pA0, pA1, pB0, pB1; float mnA, mnB, alA, alB; bf16x8 pa0, pa1, pa2, pa3;
    unsigned long long mA, mB;
    constexpr int SE = 0, SO = 0;
    mA = MASKW(0);
    SLOAD(SE, 0); asm volatile("s_waitcnt vmcnt(0)" ::: "memory"); SWRITE(0, SE); __syncthreads();
    qkt(pA0, pA1, K_lds, qr, r32, hi); apply_mask(pA0, pA1, mA, hi); partialSM(pA0, pA1, m_reg, mnA, alA);
    SLOAD(SO, 64);
    SWAIT(); SWRITE(1, SO); __syncthreads();
    for (int j = 1; j + 1 < NTe; j += 2) {
        mB = MASKW(j);
        SBAR(); qkt(pB0, pB1, K_lds + SHM_K, qr, r32, hi);
        finishSM(pA0, pA1, alA, l_reg, pa0, pa1, pa2, pa3); SBAR();
        SLOAD(SO, (j + 1) * 64); SBAR();
        pv_d0(o, vb0, pa0, pa1, pa2, pa3); apply_mask(pB0, pB1, mB, hi); partialSM(pB0, pB1, m_reg, mnB, alB);
        __syncthreads(); SWAIT(); SWRITE(0, SE);
        RESC(alB); __syncthreads();
        mA = MASKW(j + 1);
        SBAR(); qkt(pA0, pA1, K_lds, qr, r32, hi);
        finishSM(pB0, pB1, alB, l_reg, pa0, pa1, pa2, pa3); SBAR();
        SLOAD(SE, (j + 2) * 64); SBAR();
        pv_d0(o, vb0 + SHM_V, pa0, pa1, pa2, pa3); apply_mask(pA0, pA1, mA, hi); partialSM(pA0, pA1, m_reg, mnA, alA);
        __syncthreads(); SWAIT(); SWRITE(1, SO);
        RESC(alA); __syncthreads();
    }
    mB = MASKW(NTe - 1);
    SBAR(); qkt(pB0, pB1, K_lds + SHM_K, qr, r32, hi);
    finishSM(pA0, pA1, alA, l_reg, pa0, pa1, pa2, pa3); SBAR();
    pv_d0(o, vb0, pa0, pa1, pa2, pa3); apply_mask(pB0, pB1, mB, hi); partialSM(pB0, pB1, m_reg, mnB, alB);
    __syncthreads(); RESC(alB);
    finishSM(pB0, pB1, alB, l_reg, pa0, pa1, pa2, pa3); SBAR();
    pv_d0(o, vb0 + SHM_V, pa0, pa1, pa2, pa3);
    if (hi == 0) li_l[r32] = l_reg; asm volatile("s_waitcnt lgkmcnt(0)" ::: "memory");
    float rli[16];
#pragma unroll
    for (int r = 0; r < 16; ++r) rli[r] = __builtin_amdgcn_rcpf(li_l[crow(r, hi)]);
#pragma unroll
    for (int r = 0; r < 16; ++r) { const int orow = crow(r, hi);
#pragma unroll
        for (int d0 = 0; d0 < 4; ++d0) ((unsigned char*)Ob)[(long)orow * 1024 + d0 * 32 + r32] = (unsigned char)(pk_fp8x4(clamp448(o[d0][r] * rli[r] * 32.f), 0.f, 0.f, 0.f) & 0xffu); }
#undef SLOAD
#undef SWRITE
#undef SWAIT
#undef RESC
#undef MASKW
}
}
DI void p7_dsa(const Frame& F) {
    const bf16_t* z = F.at<bf16_t>(WS_Z); const unsigned long long* sel = F.at<unsigned long long>(WS_SEL); bf16_t* oa = F.at<bf16_t>(WS_OA);
    const int r32 = F.lane & 31, hi = F.lane >> 5;
    for (int item = F.wg; item < NB * 2 * 64; item += F.G) {
        const int pi = item & 63, j = (item >> 6) & 1, b = item >> 7;
#pragma unroll 1
        for (int half = 0; half < 2; ++half) {
            const int c = half ? pi : 127 - pi;
            const size_t q0 = (size_t)b * SEQ + 64 * c + (F.wave & 1) * 32;
            const int head = j * 4 + (F.wave >> 1);
            __syncthreads();
            dsa::unit(z + (q0 + r32) * INWP + C_QA + head * 128 + hi * 8, z + (size_t)b * SEQ * INWP + C_KA + j * 128, z + (size_t)b * SEQ * INWP + C_VA + j * 128,
                      sel + q0 * 128, c + 1, (bf16_t*)((unsigned char*)oa + q0 * 1024 + head * 128), (LAS char*)F.lds);
        }
    }
}

struct MergedSched {
    pg8::TileOrder ord; unsigned OA, OB, WA, WB;
    DI bool next(int i, pg8::Unit& u) const { int pm, pn; if (!ord.tile(i >> 1, pm, pn)) return false; const int br = i & 1;
        u.pm = pm; u.pn = pn; u.e = 0; u.aux = br; u.A = (br ? OB : OA) + (unsigned)pm * 256u * 1024u; u.B = (br ? WB : WA) + (unsigned)pn * 256u * 1024u; return true; }
};
struct EpiMerged {
    static constexpr bool PERM = true;
    const unsigned char* GZ; unsigned char* O;
    static DI float g4(unsigned w, int j) { const f32x2 p = (j < 2) ? __builtin_amdgcn_cvt_pk_f32_fp8((int)w, false) : __builtin_amdgcn_cvt_pk_f32_fp8((int)w, true); return ((j & 1) ? p.y : p.x) * 0.0625f; }
    DI bool operator()(f32x4 (&acc)[2][2][4][2], const pg8::Unit& u, int wr, int wc, int fr, int fq) const {
        const int row0 = u.pm * 256 + wr * 64 + fr, col0 = u.pn * 256 + wc * 32 + 8 * fq;
        u32x2 gav[2][4][2], gbv[2][4][2];
#pragma unroll
        for (int ai = 0; ai < 2; ++ai)
#pragma unroll
            for (int m = 0; m < 4; ++m)
#pragma unroll
                for (int bj = 0; bj < 2; ++bj) { const size_t row = (size_t)(row0 + ai * 128 + m * 16); const int col = col0 + bj * 128;
                    gbv[ai][m][bj] = *(const u32x2*)(GZ + row * 4096 + 2048 + col); if (u.aux == 0) gav[ai][m][bj] = *(const u32x2*)(GZ + row * 4096 + col); else gav[ai][m][bj] = (u32x2){0u, 0u}; }
        if (u.aux != 0) {
#pragma unroll
            for (int ai = 0; ai < 2; ++ai)
#pragma unroll
                for (int m = 0; m < 4; ++m)
#pragma unroll
                    for (int bj = 0; bj < 2; ++bj) asm volatile("" : "+v"(gbv[ai][m][bj]));
        }
#pragma unroll
        for (int ai = 0; ai < 2; ++ai) {
#pragma unroll
            for (int m = 0; m < 4; ++m) { const size_t row = (size_t)(row0 + ai * 128 + m * 16);
#pragma unroll
                for (int bj = 0; bj < 2; ++bj) { const int col = col0 + bj * 128;
                    float f[8];
                    if (u.aux == 0) {
#pragma unroll
                        for (int j = 0; j < 8; ++j) { const float ga = g4(j < 4 ? gav[ai][m][bj].x : gav[ai][m][bj].y, j & 3), gb = g4(j < 4 ? gbv[ai][m][bj].x : gbv[ai][m][bj].y, j & 3);
                            f[j] = (1.f + __expf(-gb)) * __builtin_amdgcn_rcpf(1.f + __expf(-ga)); }
                    } else {
#pragma unroll
                        for (int j = 0; j < 8; ++j) { const float gb = g4(j < 4 ? gbv[ai][m][bj].x : gbv[ai][m][bj].y, j & 3); f[j] = __builtin_amdgcn_rcpf(1.f + __expf(-gb)); }
                    }
                    f32x4 v0 = acc[ai][bj][m][0], v1 = acc[ai][bj][m][1];
                    v0[0] *= f[0]; v0[1] *= f[1]; v0[2] *= f[2]; v0[3] *= f[3]; v1[0] *= f[4]; v1[1] *= f[5]; v1[2] *= f[6]; v1[3] *= f[7];
                    if (u.aux == 0) { acc[ai][bj][m][0] = v0; acc[ai][bj][m][1] = v1; }
                    else { u32x2 w; w.x = pk_fp8x4(clamp448(v0[0] * 16.f), clamp448(v0[1] * 16.f), clamp448(v0[2] * 16.f), clamp448(v0[3] * 16.f));
                        w.y = pk_fp8x4(clamp448(v1[0] * 16.f), clamp448(v1[1] * 16.f), clamp448(v1[2] * 16.f), clamp448(v1[3] * 16.f));
                        *(u32x2*)(O + row * DM + col) = w; } } }
        }
        return u.aux == 0;
    }
};

typedef int v4i32q __attribute__((ext_vector_type(4)));
constexpr int LDS_TAB = 131072;
DI void p10_rows(const Frame& F) {
    LAS float* cG1 = (LAS float*)F.lds; LAS float* cA1 = cG1 + DM; LAS float* cA2 = cA1 + DM; LAS float* cB2 = cA2 + DM;
    LAS float* lg = cB2 + DM;
    LAS int* se = (LAS int*)(lg + 128 * 33);
    const float* mod = F.at<float>(WS_MOD); const bf16_t* mix = F.at<bf16_t>(WS_MIX);
    bf16_t* h2h = F.at<bf16_t>(WS_H); bf16_t* h2l = F.at<bf16_t>(WS_H2LO); unsigned char* h2q = F.at<unsigned char>(WS_H2Q);
    for (int blk = F.wg; blk < T / 128; blk += F.G) {
        const int b = blk / 64;
        __syncthreads();
#pragma unroll
        for (int i = 0; i < 4; ++i) { const int col = F.tid * 4 + i; const float* mb = mod + (size_t)b * 12288;
            cG1[col] = F.kp->in[I_GPOSTMIX][col] * mb[4096 + col]; cA2[col] = F.kp->in[I_GPREFFN][col] * (1.0f + mb[8192 + col]); cB2[col] = mb[6144 + col]; }
        __syncthreads();
        const size_t rowb = (size_t)blk * 128 + F.wave * 16;
        f32x4 xv[8], xn[8]; u32x2 mw[8], mn[8];
        { const float* xr = F.kp->in[I_X] + rowb * DM + F.lane * 4; const bf16_t* mr = mix + rowb * DM + F.lane * 4;
#pragma unroll
          for (int q = 0; q < 8; ++q) { xv[q] = *(const f32x4*)(xr + q * 256); mw[q] = *(const u32x2*)(mr + q * 256); } }
        for (int i = 0; i < 16; ++i) {
            const size_t row = rowb + i;
            if (i + 1 < 16) { const float* xr = F.kp->in[I_X] + (row + 1) * DM + F.lane * 4; const bf16_t* mr = mix + (row + 1) * DM + F.lane * 4;
#pragma unroll
                for (int q = 0; q < 8; ++q) { xn[q] = *(const f32x4*)(xr + q * 256); mn[q] = *(const u32x2*)(mr + q * 256); } }
            float ss = 0.f;
#pragma unroll
            for (int q = 0; q < 8; ++q) { const float m0 = bflo(mw[q].x), m1 = bfhi(mw[q].x), m2 = bflo(mw[q].y), m3 = bfhi(mw[q].y); ss += m0 * m0 + m1 * m1 + m2 * m2 + m3 * m3; }
            ss = wave_sum(ss);
            const float rs1 = rsqrtf(ss * (1.0f / DM) + RMS_EPS);
            float s2 = 0.f; bf16_t* orow = F.at<bf16_t>(WS_X1B) + row * DM + F.lane * 4;
#pragma unroll
            for (int q = 0; q < 8; ++q) { const int col = q * 256 + F.lane * 4; const float mq[4] = {bflo(mw[q].x), bfhi(mw[q].x), bflo(mw[q].y), bfhi(mw[q].y)};
#pragma unroll
                for (int e = 0; e < 4; ++e) { xv[q][e] += mq[e] * rs1 * cG1[col + e]; s2 += xv[q][e] * xv[q][e]; }
                *(u32x2*)(orow + q * 256) = (u32x2){cvt_pk_bf16(xv[q][0], xv[q][1]), cvt_pk_bf16(xv[q][2], xv[q][3])}; }
            s2 = wave_sum(s2);
            const float rs2 = rsqrtf(s2 * (1.0f / DM) + RMS_EPS);
            int lz = F.lane * 4; asm volatile("" : "+v"(lz));
#pragma unroll
            for (int q = 0; q < 8; ++q) { const int col = q * 256 + lz; float h[4], lo[4]; unsigned hb[4];
#pragma unroll
                for (int e = 0; e < 4; ++e) { h[e] = xv[q][e] * rs2 * cA2[col + e] + cB2[col + e]; hb[e] = cvt_pk_bf16(h[e], 0.f) & 0xffffu; lo[e] = h[e] - __uint_as_float(hb[e] << 16); }
                u32x2 wh = {hb[0] | (hb[1] << 16), hb[2] | (hb[3] << 16)}; u32x2 wl = {cvt_pk_bf16(lo[0], lo[1]), cvt_pk_bf16(lo[2], lo[3])};
                *(u32x2*)(h2h + row * DM + col) = wh; *(u32x2*)(h2l + row * DM + col) = wl;
                *(unsigned*)(h2q + row * DM + col) = pk_fp8x4(clamp448(h[0]), clamp448(h[1]), clamp448(h[2]), clamp448(h[3])); }
#pragma unroll
            for (int q = 0; q < 8; ++q) { xv[q] = xn[q]; mw[q] = mn[q]; }
        }
        asm volatile("s_waitcnt vmcnt(0)" ::: "memory");
        if (F.tid >= 256 && F.tid < 288) se[512 + F.tid - 256] = 0;
        __syncthreads();
        if (F.wave < 4) {
            const int l = F.lane, m = l & 31, hi = l >> 5; const size_t r0 = (size_t)blk * 128 + F.wave * 32;
            const bf16_t* ah = h2h + (r0 + m) * DM + hi * 8; const bf16_t* al = h2l + (r0 + m) * DM + hi * 8;
            const bf16_t* wh = F.at<bf16_t>(WS_WRT) + (size_t)m * DM + hi * 8; const bf16_t* wl = wh + NE * DM;
            f32x16 acc = {};
#pragma unroll 4
            for (int kk = 0; kk < DM / 16; ++kk) { const bf16x8 a0 = *(const bf16x8*)(ah + kk * 16), a1 = *(const bf16x8*)(al + kk * 16), b0 = *(const bf16x8*)(wh + kk * 16), b1 = *(const bf16x8*)(wl + kk * 16);
                acc = MFMA32(a0, b0, acc); acc = MFMA32(a1, b0, acc); acc = MFMA32(a0, b1, acc); }
            const float br = F.kp->in[I_BR][m];
#pragma unroll
            for (int r = 0; r < 16; ++r) lg[(F.wave * 32 + (r & 3) + 8 * (r >> 2) + 4 * hi) * 33 + m] = acc[r] + br;
        }
        __syncthreads();
        if (F.tid < 128) {
            float v[32];
#pragma unroll
            for (int e = 0; e < 32; ++e) v[e] = lg[F.tid * 33 + e];
            int te[4]; float tv[4];
#pragma unroll
            for (int k = 0; k < 4; ++k) { float best = -INFINITY; int bi = 0;
#pragma unroll
                for (int e = 0; e < 32; ++e) { if (v[e] > best) { best = v[e]; bi = e; } }
                te[k] = bi; tv[k] = best;
#pragma unroll
                for (int e = 0; e < 32; ++e) if (e == bi) v[e] = -INFINITY; }
            const float e1 = __expf(tv[1] - tv[0]), e2 = __expf(tv[2] - tv[0]), e3 = __expf(tv[3] - tv[0]); const float inv = 1.0f / (1.0f + e1 + e2 + e3);
            const size_t tok = (size_t)blk * 128 + F.tid;
            int* tep = F.at<int>(WS_TOPE) + tok * 4; float* twp = F.at<float>(WS_TOPW) + tok * 4;
            tep[0] = te[0]; tep[1] = te[1]; tep[2] = te[2]; tep[3] = te[3]; twp[0] = inv; twp[1] = e1 * inv; twp[2] = e2 * inv; twp[3] = e3 * inv;
#pragma unroll
            for (int k = 0; k < 4; ++k) __hip_atomic_fetch_add(se + 512 + te[k], 1, __ATOMIC_RELAXED, __HIP_MEMORY_SCOPE_WORKGROUP);
        }
        __syncthreads();
        if (F.tid < 32) F.at<int>(WS_CNT)[blk * 32 + F.tid] = se[512 + F.tid];
    }
}

DI void moe_tables(const Frame& F, int blk) {
    LAS int* tb = (LAS int*)(F.lds + LDS_TAB); LAS int* part = tb + 1024;
    __syncthreads();
    { const int e = F.tid & 31, g = F.tid >> 5; const int* cnt = F.at<int>(WS_CNT) + (g * 16) * 32 + e; int v[16];
#pragma unroll
      for (int j = 0; j < 16; ++j) v[j] = cnt[j * 32];
      int all = 0, bef = 0;
#pragma unroll
      for (int j = 0; j < 16; ++j) { all += v[j]; bef += (g * 16 + j < blk) ? v[j] : 0; }
      part[g * 32 + e] = all; part[512 + g * 32 + e] = bef; }
    __syncthreads();
    if (F.tid < 32) { int tot = 0, pre = 0;
#pragma unroll
        for (int g = 0; g < 16; ++g) { tot += part[g * 32 + F.tid]; pre += part[512 + g * 32 + F.tid]; }
        tb[F.tid] = tot; tb[160 + F.tid] = pre; tb[64 + F.tid] = (tot + 255) >> 8; }
    __syncthreads();
    if (F.tid == 0) { int rs = 0, us = 0; for (int e = 0; e < 32; ++e) { tb[32 + e] = rs; tb[96 + e] = us; rs += tb[64 + e] * 256; us += tb[64 + e]; } tb[96 + 32] = us; }
    __syncthreads();
}
DI void p11_sort(const Frame& F) {
    LAS int* tb = (LAS int*)(F.lds + LDS_TAB); LAS int* se = (LAS int*)F.lds; LAS int* pos = se + 512;
    int* rslot = F.at<int>(WS_RSLOT); float* rw = F.at<float>(WS_RW); const unsigned char* h2q = F.at<unsigned char>(WS_H2Q); unsigned char* hs = F.at<unsigned char>(WS_HS);
    for (int blk = F.wg; blk < T / 128; blk += F.G) {
        moe_tables(F, blk);
        se[F.tid] = F.at<int>(WS_TOPE)[(size_t)blk * 512 + F.tid];
        __syncthreads();
        {
            LAS int* wc = pos + 512;
            const int e = se[F.tid]; int rank = 0, mine = 0;
#pragma unroll 1
            for (int ee = 0; ee < 32; ++ee) { const unsigned long long mk = __ballot(e == ee);
                if (e == ee) { rank = __builtin_popcountll(mk & ((1ull << F.lane) - 1ull)); mine = __builtin_popcountll(mk); }
                if (F.lane == 0) wc[F.wave * 32 + ee] = __builtin_popcountll(mk); }
            (void)mine;
            __syncthreads();
            int before = 0;
            for (int w = 0; w < F.wave; ++w) before += wc[w * 32 + e];
            pos[F.tid] = tb[32 + e] + tb[160 + e] + before + rank;
        }
        __syncthreads();
        { const int p = pos[F.tid]; rslot[p] = blk * 512 + F.tid; rw[p] = F.at<float>(WS_TOPW)[(size_t)blk * 512 + F.tid]; }
        for (int t0 = F.wave * 8; t0 < 128; t0 += NWAVES * 8) {
            u32x4 v[8][2];
#pragma unroll
            for (int e = 0; e < 8; ++e) { const u32x4* src = (const u32x4*)(h2q + ((size_t)blk * 128 + t0 + e) * DM); v[e][0] = src[F.lane]; v[e][1] = src[64 + F.lane]; }
#pragma unroll
            for (int e = 0; e < 8; ++e)
#pragma unroll
                for (int k = 0; k < 4; ++k) { u32x4* dst = (u32x4*)(hs + (size_t)pos[(t0 + e) * 4 + k] * DM); dst[F.lane] = v[e][0]; dst[64 + F.lane] = v[e][1]; } }
        if (blk < 32) { const int e = blk, lo = tb[32 + e] + tb[e], hi_ = tb[32 + e] + tb[64 + e] * 256;
            for (int p = lo + F.tid; p < hi_; p += NTHR) { rslot[p] = -1; rw[p] = 0.f; }
            for (int p = lo + F.wave; p < hi_; p += NWAVES) { u32x4* dst = (u32x4*)(hs + (size_t)p * DM);
#pragma unroll
                for (int q = 0; q < 2; ++q) dst[q * 64 + F.lane] = (u32x4){0u, 0u, 0u, 0u}; } }
        __syncthreads();
    }
}

template <int NT_, int NROWS_B> DI void moe_units(const Frame& F, unsigned Abase, unsigned Bbase) {
    LAS int* tb = (LAS int*)(F.lds + LDS_TAB);
    const int total = tb[96 + 32] * NT_;
    int n = 0;
    for (int i = F.tid; ; i += NTHR) { const int L = i * F.G + F.wg; if (L >= total) break;
        int e = 0;
#pragma unroll 1
        for (int q = 1; q < 32; ++q) if (L >= tb[96 + q] * NT_) e = q;
        const int l = L - tb[96 + e] * NT_, mt = tb[64 + e], mi = l % mt, ni = l / mt, r0 = tb[32 + e] + mi * 256;
        tb[256 + 4 * i] = (int)(Abase + (unsigned)r0 * 2048u); tb[256 + 4 * i + 1] = (int)(Bbase + ((unsigned)e * NROWS_B + (unsigned)ni * 256u) * 2048u); tb[256 + 4 * i + 2] = r0 >> 8; tb[256 + 4 * i + 3] = (e << 8) | ni; }
    if (F.tid == 0) { const int mine = total > F.wg ? (total - F.wg + F.G - 1) / F.G : 0; tb[255] = mine; }
    (void)n;
    __syncthreads();
}
struct MoeSched {
    LAS const int* tb;
    DI bool next(int i, pg8::Unit& u) const {
        if (i >= __builtin_amdgcn_readfirstlane(tb[255])) return false;
        const v4i32q v = *(LAS const v4i32q*)(tb + 256 + 4 * i);
        u.A = (unsigned)__builtin_amdgcn_readfirstlane(v[0]); u.B = (unsigned)__builtin_amdgcn_readfirstlane(v[1]); u.pm = __builtin_amdgcn_readfirstlane(v[2]);
        const int w = __builtin_amdgcn_readfirstlane(v[3]); u.pn = w & 255; u.e = w >> 8; u.aux = 0; return true; }
};
DI void dense_units(const Frame& F, int nM, int nN, unsigned Abase, unsigned Bbase, unsigned RB) {
    LAS int* tb = (LAS int*)(F.lds + LDS_TAB);
    pg8::TileOrder ord; ord.init(nM, nN, F.G, F.wg);
    __syncthreads();
    int n = 0;
    for (int i = F.tid; ; i += NTHR) { int pm, pn; if (!ord.tile(i, pm, pn)) break;
        tb[256 + 4 * i] = (int)(Abase + (unsigned)pm * 256u * RB); tb[256 + 4 * i + 1] = (int)(Bbase + (unsigned)pn * 256u * RB); tb[256 + 4 * i + 2] = pm; tb[256 + 4 * i + 3] = pn; }
    if (F.tid == 0) { const int total = nM * nN; tb[255] = total > F.wg ? (total - F.wg + F.G - 1) / F.G : 0; }
    (void)n;
    __syncthreads();
}
DI u32x4 xpose4(unsigned d0, unsigned d1, unsigned d2, unsigned d3) {
    typedef unsigned u32x2v_ __attribute__((ext_vector_type(2)));
    const u32x2v_ a = __builtin_amdgcn_permlane16_swap(d0, d1, false, false), b = __builtin_amdgcn_permlane16_swap(d2, d3, false, false);
    const u32x2v_ x = __builtin_amdgcn_permlane32_swap(a.x, b.x, false, false), y = __builtin_amdgcn_permlane32_swap(a.y, b.y, false, false);
    u32x4 r; r.x = x.x; r.y = y.x; r.z = x.y; r.w = y.y; return r;
}
struct EpiMoe1 {
    static constexpr bool PERM = true;
    const float* b1; unsigned char* act;
    DI bool operator()(const f32x4 (&acc)[2][2][4][2], const pg8::Unit& u, int wr, int wc, int fr, int fq) const {
        const int row0 = u.pm * 256 + wr * 64 + fr, col0 = u.pn * 256 + wc * 32 + 8 * fq;
        f32x4 bva[2][2];
#pragma unroll
        for (int bj = 0; bj < 2; ++bj) { bva[bj][0] = *(const f32x4*)(b1 + (size_t)u.e * 4096 + col0 + bj * 128); bva[bj][1] = *(const f32x4*)(b1 + (size_t)u.e * 4096 + col0 + bj * 128 + 4); }
#pragma unroll
        for (int bj = 0; bj < 2; ++bj) {
            const f32x4 bv0 = bva[bj][0], bv1 = bva[bj][1];
#pragma unroll
            for (int ai = 0; ai < 2; ++ai) {
                unsigned d[4];
#pragma unroll
                for (int m = 0; m < 4; ++m) {
                    const f32x4 v0 = acc[ai][bj][m][0] + bv0, v1 = acc[ai][bj][m][1] + bv1;
                    float o[4];
#pragma unroll
                    for (int j = 0; j < 4; ++j) { const float g = fminf(j < 2 ? v0[2 * j] : v1[2 * j - 4], 7.0f), li = fminf(fmaxf(j < 2 ? v0[2 * j + 1] : v1[2 * j - 3], -7.0f), 7.0f);
                        o[j] = g * __builtin_amdgcn_rcpf(1.0f + __builtin_amdgcn_exp2f(g * (-1.702f * 1.44269504f))) * fmaf(li, 4.0f, 4.0f); }
                    d[m] = pk_fp8x4(o[0], o[1], o[2], o[3]); }
                *(u32x4*)(act + (size_t)(row0 + ai * 128 + fq * 16) * DFF + ((col0 - 8 * fq) >> 1) + bj * 64) = xpose4(d[0], d[1], d[2], d[3]); }
            asm volatile("" ::: "memory");
        }
        return false;
    }
};
struct EpiMoe2 {
    static constexpr bool PERM = true;
    const float* b2; const int* rslot; const float* rw; unsigned char* ys;
    DI bool operator()(const f32x4 (&acc)[2][2][4][2], const pg8::Unit& u, int wr, int wc, int fr, int fq) const {
        const int row0 = u.pm * 256 + wr * 64 + fr, col0 = u.pn * 256 + wc * 32 + 8 * fq;
        int slot[2][4]; float w[2][4]; f32x4 bv[2][2];
#pragma unroll
        for (int ai = 0; ai < 2; ++ai)
#pragma unroll
            for (int m = 0; m < 4; ++m) { const int row = row0 + ai * 128 + m * 16; slot[ai][m] = rslot[row]; w[ai][m] = rw[row]; }
#pragma unroll
        for (int bj = 0; bj < 2; ++bj) { bv[bj][0] = *(const f32x4*)(b2 + (size_t)u.e * 2048 + col0 + bj * 128); bv[bj][1] = *(const f32x4*)(b2 + (size_t)u.e * 2048 + col0 + bj * 128 + 4); }
#pragma unroll
        for (int ai = 0; ai < 2; ++ai)
#pragma unroll
            for (int m = 0; m < 4; ++m) asm volatile("" : "+v"(slot[ai][m]), "+v"(w[ai][m]));
#pragma unroll
        for (int bj = 0; bj < 2; ++bj) asm volatile("" : "+v"(bv[bj][0]), "+v"(bv[bj][1]));
        asm volatile("" ::: "memory");
#pragma unroll
        for (int ai = 0; ai < 2; ++ai) {
#pragma unroll
            for (int bj = 0; bj < 2; ++bj) {
                const f32x4 bv0 = bv[bj][0], bv1 = bv[bj][1];
#pragma unroll
                for (int m = 0; m < 4; ++m) {
                    if (slot[ai][m] >= 0) { const float ws_ = w[ai][m] * 16.f; const f32x4 v0 = (acc[ai][bj][m][0] + bv0) * ws_, v1 = (acc[ai][bj][m][1] + bv1) * ws_;
                        u32x2 q; q.x = pk_fp8x4(clamp448(v0[0]), clamp448(v0[1]), clamp448(v0[2]), clamp448(v0[3])); q.y = pk_fp8x4(clamp448(v1[0]), clamp448(v1[1]), clamp448(v1[2]), clamp448(v1[3]));
                        *(u32x2*)(ys + (size_t)slot[ai][m] * DM + col0 + bj * 128) = q; } }
            }
        }
        return false;
    }
};

DI void p14_final(const Frame& F) {
    LAS float* cG = (LAS float*)F.lds; const float* mod = F.at<float>(WS_MOD); const unsigned char* ys = F.at<unsigned char>(WS_YS);
    for (int blk = F.wg; blk < T / 128; blk += F.G) {
        const int b = blk / 64;
        __syncthreads();
#pragma unroll
        for (int i = 0; i < 4; ++i) { const int col = F.tid * 4 + i; cG[col] = F.kp->in[I_GPOSTFFN][col] * mod[(size_t)b * 12288 + 10240 + col]; }
        __syncthreads();
        const size_t rowb = (size_t)blk * 128 + F.wave * 16;
        unsigned yw[4][8], yn[4][8];
#pragma unroll
        for (int k = 0; k < 4; ++k)
#pragma unroll
            for (int q = 0; q < 8; ++q) yw[k][q] = *(const unsigned*)(ys + (rowb * 4 + k) * DM + q * 256 + F.lane * 4);
        u32x2 x1w[8], x1n[8];
#pragma unroll
        for (int q = 0; q < 8; ++q) x1w[q] = *(const u32x2*)(F.at<bf16_t>(WS_X1B) + rowb * DM + F.lane * 4 + q * 256);
        for (int i = 0; i < 16; ++i) {
            const size_t row = rowb + i;
            if (i + 1 < 16) {
#pragma unroll
                for (int k = 0; k < 4; ++k)
#pragma unroll
                    for (int q = 0; q < 8; ++q) yn[k][q] = *(const unsigned*)(ys + ((row + 1) * 4 + k) * DM + q * 256 + F.lane * 4);
#pragma unroll
                for (int q = 0; q < 8; ++q) x1n[q] = *(const u32x2*)(F.at<bf16_t>(WS_X1B) + (row + 1) * DM + F.lane * 4 + q * 256); }
            float* orow = F.kp->out + row * DM + F.lane * 4;
            f32x4 x1[8];
#pragma unroll
            for (int q = 0; q < 8; ++q) x1[q] = (f32x4){bflo(x1w[q].x), bfhi(x1w[q].x), bflo(x1w[q].y), bfhi(x1w[q].y)};
            f32x4 f[8]; float ss = 0.f;
#pragma unroll
            for (int q = 0; q < 8; ++q) { f[q] = (f32x4){0.f, 0.f, 0.f, 0.f};
#pragma unroll
                for (int k = 0; k < 4; ++k) { const unsigned w = yw[k][q]; const f32x2 lo = __builtin_amdgcn_cvt_pk_f32_fp8((int)w, false), hi = __builtin_amdgcn_cvt_pk_f32_fp8((int)w, true);
                    f[q] += (f32x4){lo.x, lo.y, hi.x, hi.y}; }
                f[q] *= 0.0625f;
                ss += f[q][0] * f[q][0] + f[q][1] * f[q][1] + f[q][2] * f[q][2] + f[q][3] * f[q][3]; }
            ss = wave_sum(ss);
            const float rs = rsqrtf(ss * (1.0f / DM) + RMS_EPS);
#pragma unroll
            for (int q = 0; q < 8; ++q) { const int col = q * 256 + F.lane * 4;
#pragma unroll
                for (int e = 0; e < 4; ++e) x1[q][e] += f[q][e] * rs * cG[col + e];
                *(f32x4*)(orow + q * 256) = x1[q]; }
#pragma unroll
            for (int k = 0; k < 4; ++k)
#pragma unroll
                for (int q = 0; q < 8; ++q) yw[k][q] = yn[k][q];
#pragma unroll
            for (int q = 0; q < 8; ++q) x1w[q] = x1n[q];
        }
    }
}

constexpr int N_PHASES = 15;
__global__ void __launch_bounds__(NTHR, 2) mega(Params p) {
    extern __shared__ __attribute__((aligned(16))) unsigned char lds_raw[];
    Frame F; F.kp = (KParams)__builtin_amdgcn_kernarg_segment_ptr(); F.ws = p.ws; F.lds = (LAS unsigned char*)lds_raw; F.tid = threadIdx.x; F.wave = __builtin_amdgcn_readfirstlane(threadIdx.x >> 6); F.lane = threadIdx.x & 63; F.G = gridDim.x; F.wg = blockIdx.x;
    volatile LAS unsigned* bst = (volatile LAS unsigned*)(F.lds + LDS_BYTES - 16);
    if (F.tid < 4) bst[F.tid] = 0u;
    __syncthreads();
    const int lo = p.ph_lo, hi = p.ph_hi;
    XcdBarrier bar; bar.bar = (unsigned*)(p.ws + WS_CTL); bar.x = 0; bar.st = bst;
    if (hi - lo > 1) bar = xcd_barrier_post((unsigned*)(p.ws + WS_CTL), bst);
#ifdef ONLY_PHASE
#define IN(k) ((k) == ONLY_PHASE)
#else
#ifdef SKIP_PHASE
#define IN(k) ((k) != SKIP_PHASE && lo <= (k) && (k) < hi)
#else
#define IN(k) (lo <= (k) && (k) < hi)
#endif
#endif
#define PH(k) if (IN(k)) { KParams kq_ = (KParams)__builtin_amdgcn_kernarg_segment_ptr(); asm volatile("" : "+s"(kq_)); F.kp = kq_; int t_ = threadIdx.x; asm volatile("" : "+v"(t_)); F.tid = t_; F.lane = t_ & 63; }
#define SEAM(k) do { if (IN(k) && IN((k) + 1)) xcd_barrier(bar); } while (0)
#ifndef DBG_DOUBLE
#define DBG_DOUBLE 0
#endif
#define PHASE(k, ...) PH(k) if (IN(k)) { { __VA_ARGS__ } if constexpr ((DBG_DOUBLE >> (k)) & 1) { xcd_barrier(bar); { __VA_ARGS__ } } }
    PHASE(0, p0_prologue(F);) SEAM(0);
    PHASE(1, p1_norm(F);) SEAM(1);
    PHASE(2, { dense_units(F, T / 256, (INB - NF8) / 256, (unsigned)WS_H, (unsigned)WS_WINT, 4096u); MoeSched S{(LAS const int*)(F.lds + LDS_TAB)};
          EpiStoreBf16 E{F.at<bf16_t>(WS_Z) + NF8, INWP, C_GA - NF8}; pg8::gemm_phase<2048, EpiStoreBf16, MoeSched>(F.lds, F.ws, S, E); }
        { dense_units(F, T / 256, (NF8 + 4096) / 256, (unsigned)WS_H8, (unsigned)WS_WING8, 2048u); MoeSched S{(LAS const int*)(F.lds + LDS_TAB)};
          EpiInFp8 E{F.at<bf16_t>(WS_Z), F.at<unsigned char>(WS_GZ)}; pg8::gemm_phase<1024, EpiInFp8, MoeSched, true, 122, 127>(F.lds, F.ws, S, E); }) SEAM(2);
    PHASE(3, p3_rope(F);) SEAM(3);
    PHASE(4, p4_indexer(F);) SEAM(4);
    PHASE(5, p5_select(F);)
    PHASE(6, p6_stick(F);) SEAM(6);
    PHASE(7, p7_dsa(F);) SEAM(7);
    PHASE(8, MergedSched S; S.ord.init(T / 256, DM / 256, F.G, F.wg); S.OA = (unsigned)WS_OA; S.OB = (unsigned)WS_OB; S.WA = (unsigned)WS_WAT; S.WB = (unsigned)WS_WBT;
        EpiMerged E{F.at<unsigned char>(WS_GZ), F.at<unsigned char>(WS_MERGED)}; pg8::gemm_phase<512, EpiMerged, MergedSched, true, 122, 122>(F.lds, F.ws, S, E);) SEAM(8);
    PHASE(9, dense_units(F, T / 256, DM / 256, (unsigned)WS_MERGED, (unsigned)WS_WOT, 2048u); MoeSched S{(LAS const int*)(F.lds + LDS_TAB)};
        EpiStoreBf16 E{F.at<bf16_t>(WS_MIX), DM, DM}; pg8::gemm_phase<1024, EpiStoreBf16, MoeSched, true, 122, 123>(F.lds, F.ws, S, E);) SEAM(9);
    PHASE(10, p10_rows(F);) SEAM(10);
    PHASE(11, p11_sort(F);) SEAM(11);
    PHASE(12, moe_tables(F, 0); moe_units<16, 4096>(F, (unsigned)WS_HS, (unsigned)WS_W1T); MoeSched S{(LAS const int*)(F.lds + LDS_TAB)};
        EpiMoe1 E{F.kp->in[I_B1], F.at<unsigned char>(WS_ACT)}; pg8::gemm_phase<1024, EpiMoe1, MoeSched, true, 122, 127>(F.lds, F.ws, S, E);) SEAM(12);
    PHASE(13, moe_tables(F, 0); moe_units<8, 2048>(F, (unsigned)WS_ACT, (unsigned)WS_W2T); MoeSched S{(LAS const int*)(F.lds + LDS_TAB)};
        EpiMoe2 E{F.kp->in[I_B2], F.at<int>(WS_RSLOT), F.at<float>(WS_RW), F.at<unsigned char>(WS_YS)}; pg8::gemm_phase<1024, EpiMoe2, MoeSched, true, 122, 125>(F.lds, F.ws, S, E);) SEAM(13);
    PHASE(14, p14_final(F);)
#undef IN
#undef SEAM
}


extern "C" void kernel_launch(void* const* d_in, const int* in_sizes, int n_in, void* d_out, int out_size, void* d_ws, size_t ws_size, hipStream_t stream) {
    static int grid = 0;
    if (grid == 0) {
        if (n_in != 19 || out_size != T * DM || ws_size < WS_END) { fprintf(stderr, "kernel_launch: unexpected shapes: n_in %d out %d ws %zu (need %zu)\n", n_in, out_size, ws_size, (size_t)WS_END); grid = -1; return; }
        int dev = 0, cus = 0, per_cu = 0;
        if (hipGetDevice(&dev) != hipSuccess || hipDeviceGetAttribute(&cus, hipDeviceAttributeMultiprocessorCount, dev) != hipSuccess) { grid = -1; return; }
        if (hipFuncSetAttribute((const void*)mega, hipFuncAttributeMaxDynamicSharedMemorySize, LDS_BYTES) != hipSuccess) { fprintf(stderr, "kernel_launch: hipFuncSetAttribute failed\n"); grid = -1; return; }
        if (hipOccupancyMaxActiveBlocksPerMultiprocessor(&per_cu, (const void*)mega, NTHR, LDS_BYTES) != hipSuccess || per_cu < 1) { fprintf(stderr, "kernel_launch: occupancy query says %d blocks per CU\n", per_cu); per_cu = 1; }
        (void)hipGetLastError();
        grid = cus;
    }
    if (grid < 0) return;
    (void)hipMemsetAsync((char*)d_ws + WS_CTL, 0, CTL_BYTES, stream);
    Params p{};
    for (int i = 0; i < 19; ++i) p.in[i] = (const float*)d_in[i];
    p.out = (float*)d_out; p.ws = (unsigned char*)d_ws;
#if MK_N_LAUNCHES == 1
    p.ph_lo = 0; p.ph_hi = N_PHASES;
    hipLaunchKernelGGL(mega, dim3(grid), dim3(NTHR), LDS_BYTES, stream, p);
#else
#ifndef DBG_LAST_PHASE
#define DBG_LAST_PHASE (N_PHASES - 1)
#endif
    for (int k = 0; k <= DBG_LAST_PHASE; ++k) { p.ph_lo = k; p.ph_hi = k + 1; hipLaunchKernelGGL(mega, dim3(grid), dim3(NTHR), LDS_BYTES, stream, p); }
#endif
    const hipError_t le = hipPeekAtLastError();
    if (le != hipSuccess) fprintf(stderr, "kernel_launch: launch failed: %s\n", hipGetErrorName(le));
}
```

```cpp
#include <hip/hip_runtime.h>
#include <cstdio>
#include <cstdint>

#ifndef DBG_DOUBLE
#define DBG_DOUBLE 0
#endif
#ifndef MK_N_LAUNCHES
#define MK_N_LAUNCHES 1
#endif

#define LAS __attribute__((address_space(3)))
typedef unsigned short bf16_t;
typedef short bf16x8 __attribute__((ext_vector_type(8)));
typedef short s16x4 __attribute__((ext_vector_type(4)));
typedef float f32x2 __attribute__((ext_vector_type(2)));
typedef float f32x4 __attribute__((ext_vector_type(4)));
typedef float f32x16 __attribute__((ext_vector_type(16)));
typedef unsigned u32x2 __attribute__((ext_vector_type(2)));
typedef unsigned u32x4 __attribute__((ext_vector_type(4)));
#define DI __device__ __forceinline__

constexpr int NB = 4, SEQ = 8192, T = NB * SEQ, DM = 2048;
constexpr int INW = 9808, INWP = 9984;
constexpr int INB = 5888;
constexpr int C_QA = 0, C_KA = 1024, C_VA = 1280, C_QB = 1536, C_KB = 2560, C_VB = 3584, C_QI = 4608, C_KI = 5632, C_WI = 5696, C_GA = 5712, C_GB = 7760;
constexpr int NE = 32, TOPK = 4, DFF = 2048, NSLOT = T * TOPK;
constexpr int MAXROWS = NSLOT + NE * 256;
constexpr float RMS_EPS = 1e-6f;
constexpr int NWAVES = 8, NTHR = 512;
constexpr int LDS_BYTES = 147456;

constexpr size_t al256(size_t x) { return (x + 255) / 256 * 256; }
constexpr size_t WS_CTL = 0;
constexpr size_t CTL_BYTES = 65536;
constexpr size_t WS_MODP = WS_CTL + CTL_BYTES;
constexpr size_t WS_MOD = WS_MODP + al256((size_t)32 * 4 * 12288 * 4);
constexpr size_t WS_WINT = WS_MOD + al256((size_t)4 * 12288 * 4);
constexpr size_t WS_WAT = WS_WINT + al256((size_t)INWP * DM * 2);
constexpr size_t WS_WBT = WS_WAT + al256((size_t)2048 * 1024 * 2);
constexpr size_t WS_WOT = WS_WBT + al256((size_t)2048 * 1024 * 2);
constexpr size_t WS_W1T = WS_WOT + al256((size_t)2048 * 2048 * 2);
constexpr size_t WS_W2T = WS_W1T + al256((size_t)NE * 4096 * 2048 * 2);
constexpr size_t WS_WRT = WS_W2T + al256((size_t)NE * 2048 * 2048 * 2);
constexpr int NF8 = 4608;
constexpr size_t WS_WING8 = WS_WRT + al256((size_t)2 * NE * DM * 2);
constexpr size_t WS_H8 = WS_WING8 + al256((size_t)(NF8 + 4096) * DM);
constexpr size_t WS_GZ = WS_H8 + al256((size_t)T * DM);
constexpr size_t WS_TOPE = WS_GZ + al256((size_t)T * 4096);
constexpr size_t WS_TOPW = WS_TOPE + al256((size_t)T * 4 * 4);
constexpr size_t WS_CNT = WS_TOPW + al256((size_t)T * 4 * 4);
constexpr size_t WS_RSLOT = WS_CNT + al256((size_t)256 * NE * 4);
constexpr size_t WS_RW = WS_RSLOT + al256((size_t)MAXROWS * 4);
constexpr size_t WS_H = WS_RW + al256((size_t)MAXROWS * 4);
constexpr size_t WS_Z = WS_H + al256((size_t)T * DM * 2);
constexpr size_t SC_PER_B = (size_t)4096 * 128 * 129 / 2;
constexpr size_t WS_SC = WS_Z + al256((size_t)T * INWP * 2);
constexpr size_t WS_KBF = WS_SC + al256(SC_PER_B * 4 * NB);
constexpr size_t WS_VBF = WS_KBF + al256((size_t)T * 1024 * 2);
constexpr size_t WS_KIDX = WS_VBF + al256((size_t)T * 1024 * 2);
constexpr size_t WS_WIF = WS_KIDX + al256((size_t)T * 64 * 2);
constexpr size_t WS_SEL = WS_WIF + al256((size_t)T * 16 * 4);
constexpr size_t WS_OA = WS_SEL + al256((size_t)T * 128 * 8);
constexpr size_t WS_OB = WS_OA + al256((size_t)T * 1024 * 2);
constexpr size_t WS_MERGED = WS_OB + al256((size_t)T * 1024 * 2);
constexpr size_t WS_MIX = WS_MERGED + al256((size_t)T * DM * 2);
constexpr size_t WS_ENDX = WS_MIX + al256((size_t)T * DM * 2);
constexpr size_t WS_X1B = WS_GZ;
constexpr size_t WS_H2LO = WS_Z;
constexpr size_t WS_H2Q = WS_H2LO + al256((size_t)T * DM * 2);
constexpr size_t WS_HS = WS_H2Q + al256((size_t)T * DM);
constexpr size_t WS_ACT = WS_HS + al256((size_t)MAXROWS * DM * 2);
constexpr size_t WS_YS = WS_ACT + al256((size_t)MAXROWS * DFF * 2);
constexpr size_t WS_ENDY = WS_YS + al256((size_t)NSLOT * DM * 2);
constexpr size_t WS_END = WS_ENDX > WS_ENDY ? WS_ENDX : WS_ENDY;
static_assert(WS_END < 0xffffffffull, "32-bit workspace offsets");
static_assert(WS_HS >= WS_Z + (size_t)T * DM * 2 && WS_HS + (size_t)MAXROWS * DM <= WS_SC, "map: h2lo, h2q, hs must stay inside the dead z buffer while merged/mix (further up) are live");

struct Params { const float* in[19]; float* out; unsigned char* ws; int ph_lo, ph_hi; };
enum { I_X = 0, I_C, I_POS, I_WADA, I_BADA, I_GPREMIX, I_GPOSTMIX, I_WIN, I_WA, I_WB, I_WOUT, I_GPREFFN, I_GPOSTFFN, I_WR, I_BR, I_W1, I_B1, I_W2, I_B2 };

#define XB_TMO      128
#define XB_XCNT(j)  (256  + 64 * (j))
#define XB_XSUB(j)  (1280 + 64 * (j))
#define XB_XGEN(j)  (2304 + 64 * (j))
#define XB_TOP      3328
#define XB_TOPGEN   3392
#define XCD_BAR_WORDS 3456
#define XB_SPIN_CAP (1u << 18)
__device__ __forceinline__ unsigned xb_ld(unsigned* p)              { return __hip_atomic_load(p, __ATOMIC_RELAXED, __HIP_MEMORY_SCOPE_AGENT); }
__device__ __forceinline__ unsigned xb_add(unsigned* p, unsigned v) { return __hip_atomic_fetch_add(p, v, __ATOMIC_RELAXED, __HIP_MEMORY_SCOPE_AGENT); }
__device__ __forceinline__ unsigned xb_xcc_id() { return (unsigned)__builtin_amdgcn_s_getreg((3 << 11) | 20) & 0xFu; }
#define XB_SPIN(cond, bar) do { unsigned _sp = 0; while (cond) { __builtin_amdgcn_s_sleep(1); \
    if ((++_sp & 255u) == 0u) { if (xb_ld(&(bar)[XB_TMO])) break; if (_sp > XB_SPIN_CAP) { atomicAdd(&(bar)[XB_TMO], 1u); break; } } } } while (0)
struct XcdBarrier { unsigned* bar; unsigned x; volatile LAS unsigned* st; };
__device__ __forceinline__ XcdBarrier xcd_barrier_post(unsigned* bar, volatile LAS unsigned* st) {
    XcdBarrier b; b.bar = bar; b.x = xb_xcc_id(); b.st = st;
    if (threadIdx.x == 0) (void)xb_add(&bar[XB_XCNT(b.x)], 1u);
    return b;
}
__device__ __forceinline__ void xcd_barrier_complete(unsigned* bar, unsigned x, unsigned& nloc, unsigned& nx) {
    const unsigned G = gridDim.x * gridDim.y * gridDim.z;
    unsigned sum, cnt, mine, sp = 0u;
    for (;;) {
        sum = 0u; cnt = 0u; mine = 0u;
#pragma unroll
        for (unsigned j = 0; j < 16; ++j) { const unsigned c = xb_ld(&bar[XB_XCNT(j)]); sum += c; cnt += (c > 0u) ? 1u : 0u; mine = (j == x) ? c : mine; }
        if (sum == G) break;
        __builtin_amdgcn_s_sleep(1);
        if ((++sp & 255u) == 0u) { if (xb_ld(&bar[XB_TMO])) break; if (sp > XB_SPIN_CAP) { atomicAdd(&bar[XB_TMO], 1u); break; } }
    }
    nloc = mine > 0u ? mine : 1u; nx = cnt > 0u ? cnt : 1u;
}
__device__ __forceinline__ void xcd_barrier(const XcdBarrier& b) {
    asm volatile("s_waitcnt vmcnt(0)" ::: "memory");
    __syncthreads();
    if (threadIdx.x == 0) {
        unsigned* bar = b.bar;
        __builtin_amdgcn_s_waitcnt(0);
        unsigned nloc = b.st[0], nx = b.st[1];
        if (nloc == 0u) { xcd_barrier_complete(bar, b.x, nloc, nx); b.st[0] = nloc; b.st[1] = nx; }
        const unsigned old = xb_add(&bar[XB_XSUB(b.x)], 1u);
        const unsigned gen = old / nloc;
        if (old + 1u == (gen + 1u) * nloc) {
            __builtin_amdgcn_fence(__ATOMIC_RELEASE, "agent");
            asm volatile("s_waitcnt vmcnt(0)" ::: "memory");
            const unsigned og = xb_add(&bar[XB_TOP], 1u);
            const unsigned tg = og / nx;
            if (og + 1u == (tg + 1u) * nx) xb_add(&bar[XB_TOPGEN], 1u);
            else XB_SPIN(xb_ld(&bar[XB_TOPGEN]) == tg, bar);
            __builtin_amdgcn_fence(__ATOMIC_ACQUIRE, "agent");
            xb_add(&bar[XB_XGEN(b.x)], 1u);
            asm volatile("s_waitcnt vmcnt(0)" ::: "memory");
        } else {
            XB_SPIN(xb_ld(&bar[XB_XGEN(b.x)]) == gen, bar);
            __builtin_amdgcn_fence(__ATOMIC_ACQUIRE, "agent");
            asm volatile("s_waitcnt vmcnt(0)" ::: "memory");
        }
    }
    __syncthreads();
}

typedef __bf16 bf16x2v __attribute__((ext_vector_type(2)));
DI unsigned cvt_pk_bf16(float lo, float hi) { const f32x2 v = {lo, hi}; const bf16x2v b = __builtin_convertvector(v, bf16x2v); return __builtin_bit_cast(unsigned, b); }
DI float bf2f(unsigned short b) { return __uint_as_float((unsigned)b << 16); }
DI float bflo(unsigned w) { return __uint_as_float(w << 16); }
DI float bfhi(unsigned w) { return __uint_as_float(w & 0xffff0000u); }
DI float wave_sum(float v) {
    v += __builtin_bit_cast(float, __builtin_amdgcn_update_dpp(0, __builtin_bit_cast(int, v), 0xB1, 0xF, 0xF, false));
    v += __builtin_bit_cast(float, __builtin_amdgcn_update_dpp(0, __builtin_bit_cast(int, v), 0x4E, 0xF, 0xF, false));
    v += __builtin_bit_cast(float, __builtin_amdgcn_update_dpp(0, __builtin_bit_cast(int, v), 0x141, 0xF, 0xF, false));
    v += __builtin_bit_cast(float, __builtin_amdgcn_update_dpp(0, __builtin_bit_cast(int, v), 0x140, 0xF, 0xF, false));
    { auto r = __builtin_amdgcn_permlane16_swap(__float_as_uint(v), __float_as_uint(v), false, false); v = __uint_as_float(r[0]) + __uint_as_float(r[1]); }
    { auto r = __builtin_amdgcn_permlane32_swap(__float_as_uint(v), __float_as_uint(v), false, false); v = __uint_as_float(r[0]) + __uint_as_float(r[1]); }
    return v;
}
DI float sigmoidf_(float x) { return 1.0f / (1.0f + __expf(-x)); }

namespace pg8 {
constexpr int BM = 256, BK = 64, HALF = 128, HTB = HALF * BK * 2, STAGE_BYTES = 8 * HTB;
__host__ __device__ __forceinline__ int lds_byte(int r, int c) { const int st = (r >> 4) * 2 + (c >> 5), rr = r & 15, cc = c & 31, ob = rr * 64 + cc * 2; return st * 1024 + (ob ^ (((ob >> 9) & 1) << 5)); }
__host__ __device__ __forceinline__ void stage_rc(int b, int& R, int& C) { const int st = b / 1024, sb = b % 1024, swz = sb ^ (((sb >> 9) & 1) << 5); R = (st >> 1) * 16 + swz / 64; C = (st & 1) * 32 + (swz % 64) / 2; }
__host__ __device__ __forceinline__ int perm32(int rho) { const int n = rho >> 4, i = rho & 15; return 8 * (i >> 2) + 4 * n + (i & 3); }

struct Unit { unsigned A, B; int pm, pn, e, aux; };

typedef int v8i32 __attribute__((ext_vector_type(8)));
typedef int v4i32 __attribute__((ext_vector_type(4)));
template <int K, class Epi, class Sched, bool FP8 = false, int SC_W = 127, int SC_A = 127>
__device__ __forceinline__ void gemm_phase(LAS unsigned char* lds, const unsigned char* wsbase, const Sched& S, const Epi& E) {
    const __amdgpu_buffer_rsrc_t rsrc = __builtin_amdgcn_make_buffer_rsrc((void*)wsbase, 0, 0xffffffff, 0x00020000);
    const int tid = threadIdx.x, wid = __builtin_amdgcn_readfirstlane(tid >> 6), lane = tid & 63, wr = wid >> 2, wc = wid & 3, fr = lane & 15, fq = lane >> 4;
    constexpr int nt = K / BK;
    unsigned voffA[2], voffB[2];
#pragma unroll
    for (int i = 0; i < 2; ++i) { int R, C; stage_rc(tid * 16 + i * 8192, R, C); const int Rb = Epi::PERM ? ((R & ~31) + perm32(R & 31)) : R;
        voffA[i] = (unsigned)(R * K + C) * 2u; voffB[i] = (unsigned)(Rb * K + C) * 2u; }
    constexpr unsigned kstep = (unsigned)(BK * 2);
    constexpr unsigned hstep = (unsigned)HALF * K * 2;
    const unsigned ldsw = (unsigned)wid * 1024u;
    const int aoff = lds_byte(wr * 64 + fr, fq * 8), boff = lds_byte(wc * 32 + fr, fq * 8);
#define PG8_SA(b, h) (((b) * 2 + (h)) * HTB)
#define PG8_SB(b, h) ((4 + (b) * 2 + (h)) * HTB)
#define PG8_STAGE(bufoff, gbase, voff) do { _Pragma("unroll") for (int _i = 0; _i < 2; ++_i) \
        __builtin_amdgcn_raw_ptr_buffer_load_lds(rsrc, (LAS void*)(lds + (bufoff) + ldsw + _i * 8192), 16, (int)(voff)[0], (int)((gbase) + (unsigned)_i * (64u * K * 2u)), 0, 0); } while (0)
#define PG8_CAT2(p0, p1) __builtin_shufflevector(*(const LAS v4i32*)(p0), *(const LAS v4i32*)(p1), 0, 1, 2, 3, 4, 5, 6, 7)
#define PG8_LDA(dst, b, h) do { _Pragma("unroll") for (int m = 0; m < 4; ++m) { if constexpr (FP8) dst##8[m] = PG8_CAT2(lds + PG8_SA(b, h) + aoff + m * 2048, lds + PG8_SA(b, h) + aoff + m * 2048 + 1024); \
        else { _Pragma("unroll") for (int k = 0; k < 2; ++k) dst[m][k] = *(const LAS bf16x8*)(lds + PG8_SA(b, h) + aoff + m * 2048 + k * 1024); } } } while (0)
#define PG8_LDB(dst, b, h) do { _Pragma("unroll") for (int n = 0; n < 2; ++n) { if constexpr (FP8) dst##8[n] = PG8_CAT2(lds + PG8_SB(b, h) + boff + n * 2048, lds + PG8_SB(b, h) + boff + n * 2048 + 1024); \
        else { _Pragma("unroll") for (int k = 0; k < 2; ++k) dst[n][k] = *(const LAS bf16x8*)(lds + PG8_SB(b, h) + boff + n * 2048 + k * 1024); } } } while (0)
#define PG8_CAT(x) __builtin_shufflevector(__builtin_bit_cast(v4i32, (x)[0]), __builtin_bit_cast(v4i32, (x)[1]), 0, 1, 2, 3, 4, 5, 6, 7)
#define PG8_MMA(ai, bj, At, Bt) do { __builtin_amdgcn_s_setprio(1); _Pragma("unroll") for (int m = 0; m < 4; ++m) _Pragma("unroll") for (int n = 0; n < 2; ++n) { \
        if constexpr (FP8) acc[ai][bj][m][n] = __builtin_amdgcn_mfma_scale_f32_16x16x128_f8f6f4(Bt##8[n], At##8[m], acc[ai][bj][m][n], 0, 0, 0, SC_W, 0, SC_A); \
        else { _Pragma("unroll") for (int k = 0; k < 2; ++k) acc[ai][bj][m][n] = __builtin_amdgcn_mfma_f32_16x16x32_bf16(Bt[n][k], At[m][k], acc[ai][bj][m][n], 0, 0, 0); } } \
        __builtin_amdgcn_s_setprio(0); } while (0)
#define PG8_WAIT_V(n) asm volatile("s_waitcnt vmcnt(" #n ")" ::: "memory")
#define PG8_WAIT_L(n) asm volatile("s_waitcnt lgkmcnt(" #n ")" ::: "memory")
#define PG8_BAR __builtin_amdgcn_s_barrier()
#define PG8_SCHED __builtin_amdgcn_sched_barrier(0)
    Unit cur, nxt; int ui = 0;
    if (!S.next(0, cur)) return;
    f32x4 acc[2][2][4][2];
#pragma unroll
    for (int a = 0; a < 2; ++a)
#pragma unroll
        for (int b = 0; b < 2; ++b)
#pragma unroll
            for (int m = 0; m < 4; ++m)
#pragma unroll
                for (int n = 0; n < 2; ++n) acc[a][b][m][n] = (f32x4){0.f, 0.f, 0.f, 0.f};
    bf16x8 At[4][2], B0[2][2], B1[2][2]; v8i32 At8[4], B08[2], B18[2];
    unsigned cA = (unsigned)__builtin_amdgcn_readfirstlane((int)cur.A), cB = (unsigned)__builtin_amdgcn_readfirstlane((int)cur.B);
    PG8_STAGE(PG8_SB(0, 0), cB, voffB); PG8_STAGE(PG8_SB(0, 1), cB + hstep, voffB); PG8_STAGE(PG8_SA(0, 0), cA, voffA); PG8_STAGE(PG8_SA(0, 1), cA + hstep, voffA);
    if (wr == 1) PG8_BAR;
    PG8_WAIT_V(2); PG8_BAR;
    PG8_STAGE(PG8_SB(1, 0), cB + kstep, voffB); PG8_STAGE(PG8_SA(1, 0), cA + kstep, voffA); PG8_STAGE(PG8_SB(1, 1), cB + hstep + kstep, voffB);
    PG8_WAIT_V(6); PG8_BAR;
    for (;;) {
        const bool has_next = S.next(ui + 1, nxt);
        const unsigned nA = has_next ? (unsigned)__builtin_amdgcn_readfirstlane((int)nxt.A) : cA, nB = has_next ? (unsigned)__builtin_amdgcn_readfirstlane((int)nxt.B) : cB;
#pragma unroll 1
        for (int t = 0; t < nt; t += 2) {
            const bool last = (t == nt - 2);
            const unsigned a1 = cA + (unsigned)(t + 1) * kstep;
            const unsigned a2 = last ? nA : cA + (unsigned)(t + 2) * kstep, b2 = last ? nB : cB + (unsigned)(t + 2) * kstep;
            const unsigned a3 = a2 + kstep, b3 = b2 + kstep;
            PG8_LDB(B0, 0, 0); PG8_LDB(B1, 0, 1); PG8_SCHED; PG8_LDA(At, 0, 0); PG8_STAGE(PG8_SA(1, 1), a1 + hstep, voffA);
            PG8_WAIT_V(8); PG8_WAIT_L(0); PG8_BAR; PG8_MMA(0, 0, At, B0); PG8_MMA(0, 1, At, B1); PG8_BAR; PG8_SCHED;
            PG8_LDA(At, 0, 1); PG8_STAGE(PG8_SB(0, 0), b2, voffB); PG8_STAGE(PG8_SB(0, 1), b2 + hstep, voffB); PG8_STAGE(PG8_SA(0, 0), a2, voffA);
            PG8_WAIT_V(8); PG8_WAIT_L(0); PG8_BAR; PG8_MMA(1, 0, At, B0); PG8_MMA(1, 1, At, B1); PG8_BAR; PG8_SCHED;
            PG8_LDB(B0, 1, 0); PG8_LDB(B1, 1, 1); PG8_SCHED; PG8_LDA(At, 1, 0); PG8_STAGE(PG8_SA(0, 1), a2 + hstep, voffA);
            PG8_WAIT_V(8); PG8_WAIT_L(0); PG8_BAR; PG8_MMA(0, 0, At, B0); PG8_MMA(0, 1, At, B1); PG8_BAR; PG8_SCHED;
            PG8_LDA(At, 1, 1); PG8_STAGE(PG8_SB(1, 0), b3, voffB); PG8_STAGE(PG8_SB(1, 1), b3 + hstep, voffB); PG8_STAGE(PG8_SA(1, 0), a3, voffA);
            PG8_WAIT_V(8); PG8_WAIT_L(0); PG8_BAR; PG8_MMA(1, 0, At, B0); PG8_MMA(1, 1, At, B1); PG8_BAR; PG8_SCHED;
        }
        if (wr == 0) PG8_BAR;
        int tl_ = threadIdx.x; asm volatile("" : "+v"(tl_));
        const bool keep = E(acc, cur, wr, wc, tl_ & 15, (tl_ & 63) >> 4);
        if (!has_next) break;
        if (!keep) {
#pragma unroll
        for (int a = 0; a < 2; ++a)
#pragma unroll
            for (int b = 0; b < 2; ++b)
#pragma unroll
                for (int m = 0; m < 4; ++m)
#pragma unroll
                    for (int n = 0; n < 2; ++n) acc[a][b][m][n] = (f32x4){0.f, 0.f, 0.f, 0.f};
        }
        cur = nxt; cA = nA; cB = nB; ++ui;
        if (wr == 1) PG8_BAR;
    }
    PG8_WAIT_V(0);
    PG8_BAR;
#undef PG8_SA
#undef PG8_SB
#undef PG8_STAGE
#undef PG8_LDA
#undef PG8_LDB
#undef PG8_MMA
#undef PG8_CAT
#undef PG8_CAT2
#undef PG8_WAIT_V
#undef PG8_WAIT_L
#undef PG8_BAR
#undef PG8_SCHED
}

struct TileOrder {
    int nM, nN, nwg, G, c;
    DI void init(int nM_, int nN_, int G_, int c_) { nM = nM_; nN = nN_; nwg = nM * nN; G = G_; c = c_; }
    DI bool tile(int i, int& pm, int& pn) const {
        const long L = (long)i * G + c; if (L >= nwg) return false;
        int wgid = (int)L; { const int q = nwg / 8, r = nwg % 8, xcd = wgid % 8, off = wgid / 8; wgid = (xcd < r ? xcd * (q + 1) : r * (q + 1) + (xcd - r) * q) + off; }
        const int nig = 8 * nN, gid = wgid / nig, fm = gid * 8, gsz = (nM - fm) < 8 ? (nM - fm) : 8;
        pm = fm + ((wgid % nig) % gsz); pn = (wgid % nig) / gsz; return true;
    }
};
}

typedef const __attribute__((address_space(4))) Params* KParams;
struct Frame {
    KParams kp; unsigned char* ws; LAS unsigned char* lds; int tid, wave, lane, G, wg;
    template <class Tp> DI Tp* at(size_t off) const { return (Tp*)(ws + off); }
};

DI void p0_modpart(const Frame& F, int item) {
    const int ks = item / 6, jt = item % 6;
    LAS float* sl = (LAS float*)F.lds;
    __syncthreads();
    if (F.tid < 256) { const int b = F.tid >> 6, k = F.tid & 63; const float cv = F.kp->in[I_C][b * DM + ks * 64 + k]; sl[F.tid] = cv / (1.0f + __expf(-cv)); }
    __syncthreads();
    const int j0 = jt * 2048 + F.tid * 4;
    const float* w = F.kp->in[I_WADA] + (size_t)(ks * 64) * 12288 + j0;
    f32x4 a0 = {0, 0, 0, 0}, a1 = a0, a2 = a0, a3 = a0;
#pragma unroll 8
    for (int k = 0; k < 64; ++k) { const f32x4 v = *(const f32x4*)(w + (size_t)k * 12288);
        a0 += v * sl[k]; a1 += v * sl[64 + k]; a2 += v * sl[128 + k]; a3 += v * sl[192 + k]; }
    float* o = F.at<float>(WS_MODP) + (size_t)ks * 4 * 12288 + j0;
    *(f32x4*)(o) = a0; *(f32x4*)(o + 12288) = a1; *(f32x4*)(o + 2 * 12288) = a2; *(f32x4*)(o + 3 * 12288) = a3;
}
DI void p0_cvt_tile(const Frame& F, const float* __restrict__ src, bf16_t* __restrict__ dst, int K, int Nsrc, int kt, int ntile) {
    LAS float* tl = (LAS float*)F.lds;
    __syncthreads();
    const int k0 = kt * 64, n0 = ntile * 128;
    {
        const int c4 = (F.tid & 31) * 4, r0 = F.tid >> 5;
#pragma unroll
        for (int i = 0; i < 4; ++i) { const int r = r0 + 16 * i; f32x4 v = {0, 0, 0, 0};
            if (n0 + c4 < Nsrc) v = *(const f32x4*)(src + (size_t)(k0 + r) * Nsrc + n0 + c4);
            tl[r * 129 + c4] = v[0]; tl[r * 129 + c4 + 1] = v[1]; tl[r * 129 + c4 + 2] = v[2]; tl[r * 129 + c4 + 3] = v[3]; }
    }
    __syncthreads();
    {
        const int kc = F.tid & 7;
#pragma unroll
        for (int i = 0; i < 2; ++i) { const int n = (F.tid >> 3) + 64 * i;
            float v[8];
#pragma unroll
            for (int j = 0; j < 8; ++j) v[j] = tl[(kc * 8 + j) * 129 + n];
            u32x4 w = {cvt_pk_bf16(v[0], v[1]), cvt_pk_bf16(v[2], v[3]), cvt_pk_bf16(v[4], v[5]), cvt_pk_bf16(v[6], v[7])};
            *(u32x4*)(dst + (size_t)(n0 + n) * K + k0 + kc * 8) = w; }
    }
}
DI unsigned pk_fp8x4(float a, float b, float c, float d) { int w = 0; w = __builtin_amdgcn_cvt_pk_fp8_f32(a, b, w, false); w = __builtin_amdgcn_cvt_pk_fp8_f32(c, d, w, true); return (unsigned)w; }
DI float clamp448(float x) { return __builtin_amdgcn_fmed3f(x, -448.f, 448.f); }
DI void p0_cvt_tile_fp8(const Frame& F, const float* __restrict__ src, unsigned char* __restrict__ dst, int K, int N, int kt, int ntile) {
    LAS float* tl = (LAS float*)F.lds;
    __syncthreads();
    const int k0 = kt * 128, n0 = ntile * 128;
    {
        const int c4 = (F.tid & 31) * 4, r0 = F.tid >> 5;
#pragma unroll
        for (int i = 0; i < 8; ++i) { const int r = r0 + 16 * i; const f32x4 v = *(const f32x4*)(src + (size_t)(k0 + r) * N + n0 + c4);
            tl[r * 129 + c4] = v[0]; tl[r * 129 + c4 + 1] = v[1]; tl[r * 129 + c4 + 2] = v[2]; tl[r * 129 + c4 + 3] = v[3]; }
    }
    __syncthreads();
    {
        const int n = F.tid & 127, kc = F.tid >> 7;
        unsigned w[8];
#pragma unroll
        for (int j = 0; j < 8; ++j) { const LAS float* p = tl + (kc * 32 + j * 4) * 129 + n;
            w[j] = pk_fp8x4(clamp448(p[0] * 32.f), clamp448(p[129] * 32.f), clamp448(p[258] * 32.f), clamp448(p[387] * 32.f)); }
        unsigned char* o = dst + (size_t)(n0 + n) * K + k0 + kc * 32;
        *(u32x4*)o = (u32x4){w[0], w[1], w[2], w[3]}; *(u32x4*)(o + 16) = (u32x4){w[4], w[5], w[6], w[7]};
    }
}
constexpr int CV_NB = (INB - NF8) / 128, CV_NF = NF8 / 128, CV_N0 = 32 * CV_NB + 16 * CV_NF + 16 * 32, CV_N1 = 8 * 16, CV_N2 = 8 * 16, CV_N3 = 16 * 16, CV_N4 = 0, CV_N5 = 0;
constexpr int CV_S1 = CV_N0, CV_S2 = CV_S1 + CV_N1, CV_S3 = CV_S2 + CV_N2, CV_S4 = CV_S3 + CV_N3, CV_S5 = CV_S4 + CV_N4, CV_TOT = CV_S5 + CV_N5;
DI void p0_prologue(const Frame& F) {
    for (int it = F.wg; it < 192; it += F.G) p0_modpart(F, it);
    for (int i = F.wg * NTHR + F.tid; i < NE * DM; i += F.G * NTHR) { const int e = i / DM, k = i % DM; const float v = F.kp->in[I_WR][(size_t)k * NE + e];
        const unsigned hi = cvt_pk_bf16(v, 0.f) & 0xffffu; const float r = v - __uint_as_float(hi << 16);
        F.at<bf16_t>(WS_WRT)[i] = (bf16_t)hi; F.at<bf16_t>(WS_WRT)[NE * DM + i] = (bf16_t)(cvt_pk_bf16(r, 0.f) & 0xffffu); }
    for (int it = F.wg; it < CV_TOT; it += F.G) {
        int j = it;
        Frame F2 = F; { KParams kq_ = F.kp; asm volatile("" : "+s"(kq_)); F2.kp = kq_; }
        if (j < 32 * CV_NB) { p0_cvt_tile(F, F2.kp->in[I_WIN] + NF8, F.at<bf16_t>(WS_WINT), 2048, INW, j / CV_NB, j % CV_NB); continue; }
        if (j < 32 * CV_NB + 16 * CV_NF) { const int r = j - 32 * CV_NB; p0_cvt_tile_fp8(F, F2.kp->in[I_WIN], F.at<unsigned char>(WS_WING8), 2048, INW, r / CV_NF, r % CV_NF); continue; }
        if (j < CV_N0) { const int r = j - 32 * CV_NB - 16 * CV_NF; p0_cvt_tile_fp8(F, F2.kp->in[I_WIN] + C_GA, F.at<unsigned char>(WS_WING8) + (size_t)NF8 * DM, 2048, INW, r / 32, r % 32); continue; }
        j -= CV_N0;
        if (j < CV_N1) { p0_cvt_tile_fp8(F, F2.kp->in[I_WA], F.at<unsigned char>(WS_WAT), 1024, 2048, j / 16, j % 16); continue; }
        j -= CV_N1;
        if (j < CV_N2) { p0_cvt_tile_fp8(F, F2.kp->in[I_WB], F.at<unsigned char>(WS_WBT), 1024, 2048, j / 16, j % 16); continue; }
        j -= CV_N2;
        p0_cvt_tile_fp8(F, F2.kp->in[I_WOUT], F.at<unsigned char>(WS_WOT), 2048, 2048, j / 16, j % 16);
    }
}

DI float mod_sum(const Frame& F, int b, int j) {
    const float* mp = F.at<float>(WS_MODP) + (size_t)b * 12288 + j; float s = F.kp->in[I_BADA][j]; float v[32];
#pragma unroll
    for (int ks = 0; ks < 32; ++ks) v[ks] = mp[(size_t)ks * 4 * 12288];
#pragma unroll
    for (int ks = 0; ks < 32; ++ks) s += v[ks];
    return s;
}
DI void p1_norm(const Frame& F) {
    LAS float* sA = (LAS float*)F.lds; LAS float* sB = sA + DM;
    for (int o = F.wg * NTHR + F.tid; o < 4 * 12288; o += F.G * NTHR) F.at<float>(WS_MOD)[o] = mod_sum(F, o / 12288, o % 12288);
    for (int blk = F.wg; blk < T / 128; blk += F.G) {
        const int b = blk / 64;
        __syncthreads();
        {
            const int col = F.tid * 4; const float* mp = F.at<float>(WS_MODP) + (size_t)b * 12288 + col;
            f32x4 a1 = *(const f32x4*)(F.kp->in[I_BADA] + 2048 + col), a0 = *(const f32x4*)(F.kp->in[I_BADA] + col);
#pragma unroll 8
            for (int ks = 0; ks < 32; ++ks) { a1 += *(const f32x4*)(mp + (size_t)ks * 4 * 12288 + 2048); a0 += *(const f32x4*)(mp + (size_t)ks * 4 * 12288); }
            const f32x4 g = *(const f32x4*)(F.kp->in[I_GPREMIX] + col);
#pragma unroll
            for (int i = 0; i < 4; ++i) { sA[col + i] = g[i] * (1.0f + a1[i]); sB[col + i] = a0[i]; }
        }
        __syncthreads();
        const size_t rowb = (size_t)blk * 128 + F.wave * 16;
        f32x4 v[8], vn[8];
        { const float* xr = F.kp->in[I_X] + rowb * DM + F.lane * 4;
#pragma unroll
          for (int q = 0; q < 8; ++q) v[q] = __builtin_nontemporal_load((const f32x4*)(xr + q * 256)); }
        for (int i = 0; i < 16; ++i) {
            const size_t row = rowb + i;
            if (i + 1 < 16) { const float* xr = F.kp->in[I_X] + (row + 1) * DM + F.lane * 4;
#pragma unroll
                for (int q = 0; q < 8; ++q) vn[q] = __builtin_nontemporal_load((const f32x4*)(xr + q * 256)); }
            float ss = 0.f;
#pragma unroll
            for (int q = 0; q < 8; ++q) ss += v[q][0] * v[q][0] + v[q][1] * v[q][1] + v[q][2] * v[q][2] + v[q][3] * v[q][3];
            ss = wave_sum(ss);
            const float rstd = rsqrtf(ss * (1.0f / DM) + RMS_EPS);
            bf16_t* hr = F.at<bf16_t>(WS_H) + row * DM + F.lane * 4;
#pragma unroll
            for (int q = 0; q < 8; ++q) { const int col = q * 256 + F.lane * 4;
                const float o0 = v[q][0] * rstd * sA[col] + sB[col], o1 = v[q][1] * rstd * sA[col + 1] + sB[col + 1], o2 = v[q][2] * rstd * sA[col + 2] + sB[col + 2], o3 = v[q][3] * rstd * sA[col + 3] + sB[col + 3];
                u32x2 w = {cvt_pk_bf16(o0, o1), cvt_pk_bf16(o2, o3)}; *(u32x2*)(hr + q * 256) = w;
                *(unsigned*)(F.at<unsigned char>(WS_H8) + row * DM + col) = pk_fp8x4(clamp448(o0), clamp448(o1), clamp448(o2), clamp448(o3)); }
#pragma unroll
            for (int q = 0; q < 8; ++q) v[q] = vn[q];
        }
    }
}

struct EpiStoreBf16 {
    static constexpr bool PERM = true;
    bf16_t* O; int ldc; int colmax;
    DI bool operator()(const f32x4 (&acc)[2][2][4][2], const pg8::Unit& u, int wr, int wc, int fr, int fq) const {
        const int row0 = u.pm * 256 + wr * 64 + fr, col0 = u.pn * 256 + wc * 32 + 8 * fq;
#pragma unroll
        for (int ai = 0; ai < 2; ++ai)
#pragma unroll
            for (int m = 0; m < 4; ++m) { bf16_t* rowp = O + (size_t)(row0 + ai * 128 + m * 16) * ldc + col0;
#pragma unroll
                for (int bj = 0; bj < 2; ++bj) { const f32x4 v0 = acc[ai][bj][m][0], v1 = acc[ai][bj][m][1];
                    u32x4 w; w.x = cvt_pk_bf16(v0[0], v0[1]); w.y = cvt_pk_bf16(v0[2], v0[3]); w.z = cvt_pk_bf16(v1[0], v1[1]); w.w = cvt_pk_bf16(v1[2], v1[3]);
                    if (col0 + bj * 128 < colmax) *(u32x4*)(rowp + bj * 128) = w; } }
        return false;
    }
};
template <int SCALE> struct EpiStoreFp8 {
    static constexpr bool PERM = true;
    unsigned char* O; int ldc;
    DI bool operator()(const f32x4 (&acc)[2][2][4][2], const pg8::Unit& u, int wr, int wc, int fr, int fq) const {
        const int row0 = u.pm * 256 + wr * 64 + fr, col0 = u.pn * 256 + wc * 32 + 8 * fq;
#pragma unroll
        for (int ai = 0; ai < 2; ++ai)
#pragma unroll
            for (int m = 0; m < 4; ++m) { unsigned char* rowp = O + (size_t)(row0 + ai * 128 + m * 16) * ldc + col0;
#pragma unroll
                for (int bj = 0; bj < 2; ++bj) { const f32x4 v0 = acc[ai][bj][m][0] * (float)SCALE, v1 = acc[ai][bj][m][1] * (float)SCALE;
                    u32x2 w; w.x = pk_fp8x4(clamp448(v0[0]), clamp448(v0[1]), clamp448(v0[2]), clamp448(v0[3])); w.y = pk_fp8x4(clamp448(v1[0]), clamp448(v1[1]), clamp448(v1[2]), clamp448(v1[3]));
                    *(u32x2*)(rowp + bj * 128) = w; } }
        return false;
    }
};
struct EpiInFp8 {
    static constexpr bool PERM = true;
    bf16_t* Z; unsigned char* GZ;
    DI bool operator()(const f32x4 (&acc)[2][2][4][2], const pg8::Unit& u, int wr, int wc, int fr, int fq) const {
        const int row0 = u.pm * 256 + wr * 64 + fr, colt = wc * 32 + 8 * fq;
        if (u.pn < NF8 / 256) {
#pragma unroll
            for (int ai = 0; ai < 2; ++ai)
#pragma unroll
                for (int m = 0; m < 4; ++m) { bf16_t* rowp = Z + (size_t)(row0 + ai * 128 + m * 16) * INWP + u.pn * 256 + colt;
#pragma unroll
                    for (int bj = 0; bj < 2; ++bj) { const f32x4 v0 = acc[ai][bj][m][0], v1 = acc[ai][bj][m][1];
                        u32x4 w; w.x = cvt_pk_bf16(v0[0], v0[1]); w.y = cvt_pk_bf16(v0[2], v0[3]); w.z = cvt_pk_bf16(v1[0], v1[1]); w.w = cvt_pk_bf16(v1[2], v1[3]);
                        *(u32x4*)(rowp + bj * 128) = w; } }
        } else {
#pragma unroll
            for (int ai = 0; ai < 2; ++ai)
#pragma unroll
                for (int m = 0; m < 4; ++m) { unsigned char* rowp = GZ + (size_t)(row0 + ai * 128 + m * 16) * 4096 + (u.pn - NF8 / 256) * 256 + colt;
#pragma unroll
                    for (int bj = 0; bj < 2; ++bj) { const f32x4 v0 = acc[ai][bj][m][0] * 16.f, v1 = acc[ai][bj][m][1] * 16.f;
                        u32x2 w; w.x = pk_fp8x4(clamp448(v0[0]), clamp448(v0[1]), clamp448(v0[2]), clamp448(v0[3])); w.y = pk_fp8x4(clamp448(v1[0]), clamp448(v1[1]), clamp448(v1[2]), clamp448(v1[3]));
                        *(u32x2*)(rowp + bj * 128) = w; } }
        }
        return false;
    }
};
template <int K> struct DenseSched {
    pg8::TileOrder ord; unsigned A, Bt;
    DI bool next(int i, pg8::Unit& u) const { int pm, pn; if (!ord.tile(i, pm, pn)) return false;
        u.pm = pm; u.pn = pn; u.e = 0; u.aux = 0; u.A = A + (unsigned)pm * 256u * K * 2u; u.B = Bt + (unsigned)pn * 256u * K * 2u; return true; }
};

DI void p3_rope(const Frame& F) {
    LAS float* cs = (LAS float*)F.lds;
    bf16_t* z = F.at<bf16_t>(WS_Z); bf16_t* kidx = F.at<bf16_t>(WS_KIDX); float* wif = F.at<float>(WS_WIF);
    bf16_t* kbF = F.at<bf16_t>(WS_KBF); bf16_t* vbF = F.at<bf16_t>(WS_VBF);
    const int* pos = (const int*)F.kp->in[I_POS];
    for (int item = F.wg; item < T / 32; item += F.G) {
        const int b = item >> 8, blk = item & 255, s0 = blk * 32; const size_t row0 = (size_t)b * SEQ + s0;
        __syncthreads();
        for (int e = F.tid; e < 32 * 24; e += NTHR) { const int tok = e / 24, a = e % 24;
            const float ex = a < 16 ? -(float)a * (1.0f / 16.0f) : -(float)(a - 16) * (1.0f / 8.0f);
            const float inv = __builtin_powf(500000.0f, ex);
            const float ang = (float)pos[row0 + tok] * inv;
            const double ad = (double)ang; const double kq = __builtin_rint(ad * 0.15915494309189535); const float r = (float)(ad - kq * 6.283185307179586);
            cs[e * 2] = __cosf(r); cs[e * 2 + 1] = __sinf(r); }
        __syncthreads();
        {
            const int tok = F.tid >> 4, u = F.tid & 15, u7 = u & 7; bf16_t* zr = z + (row0 + tok) * INWP;
            const float c16 = cs[(tok * 24 + u) * 2], s16 = cs[(tok * 24 + u) * 2 + 1], c8 = cs[(tok * 24 + 16 + u7) * 2], s8 = cs[(tok * 24 + 16 + u7) * 2 + 1];
            float x1[19], x2[19];
#pragma unroll
            for (int it = 0; it < 19; ++it) { const int c1 = it < 8 ? C_QA + it * 128 + u : it < 10 ? C_KA + (it - 8) * 128 + u : it < 18 ? C_QI + (2 * (it - 10) + (u >> 3)) * 64 + u7 : C_KI + u7;
                const int dist = it < 10 ? 16 : 8; x1[it] = bf2f(zr[c1]); x2[it] = bf2f(zr[c1 + dist]); }
#pragma unroll
            for (int it = 0; it < 18; ++it) { const int c1 = it < 8 ? C_QA + it * 128 + u : it < 10 ? C_KA + (it - 8) * 128 + u : C_QI + (2 * (it - 10) + (u >> 3)) * 64 + u7;
                const int dist = it < 10 ? 16 : 8; const float cc = it < 10 ? c16 : c8, sn = it < 10 ? s16 : s8;
                zr[c1] = (bf16_t)(cvt_pk_bf16(x1[it] * cc - x2[it] * sn, 0.f) & 0xffffu); zr[c1 + dist] = (bf16_t)(cvt_pk_bf16(x2[it] * cc + x1[it] * sn, 0.f) & 0xffffu); }
            if (u < 8) { bf16_t* kd = kidx + (row0 + tok) * 64; kd[u7] = (bf16_t)(cvt_pk_bf16(x1[18] * c8 - x2[18] * s8, 0.f) & 0xffffu); kd[u7 + 8] = (bf16_t)(cvt_pk_bf16(x2[18] * c8 + x1[18] * s8, 0.f) & 0xffffu); }
        }
        {
            unsigned short v[4];
#pragma unroll
            for (int it = 0; it < 4; ++it) { const int j = F.tid + it * NTHR, tok = j >> 6, q = j & 63; const bf16_t* zr = z + (row0 + tok) * INWP; v[it] = q < 48 ? zr[C_KI + 16 + q] : zr[C_WI + q - 48]; }
#pragma unroll
            for (int it = 0; it < 4; ++it) { const int j = F.tid + it * NTHR, tok = j >> 6, q = j & 63;
                if (q < 48) kidx[(row0 + tok) * 64 + 16 + q] = v[it]; else wif[(row0 + tok) * 16 + (q - 48)] = bf2f(v[it]); }
        }
        {
            u32x4 v[8];
#pragma unroll
            for (int i = 0; i < 8; ++i) { const int id = F.tid + NTHR * i, l = id & 63, kk = (id >> 6) & 7, h = id >> 9; v[i] = *(const u32x4*)(z + (row0 + (l & 31)) * INWP + C_KB + h * 128 + kk * 16 + (l >> 5) * 8); }
#pragma unroll
            for (int i = 0; i < 8; ++i) { const int id = F.tid + NTHR * i, l = id & 63, kk = (id >> 6) & 7, h = id >> 9; *(u32x4*)(kbF + ((((size_t)(b * 8 + h) * 256 + blk) * 8 + kk) * 64 + l) * 8) = v[i]; }
        }
#pragma unroll
        for (int i0 = 0; i0 < 8; i0 += 4) {
            unsigned short e[4][8];
#pragma unroll
            for (int i = 0; i < 4; ++i) { const int id = F.tid + NTHR * (i0 + i), l = id & 63, sb = (id >> 6) & 1, db = (id >> 7) & 3, h = id >> 9;
                const bf16_t* vp = z + (row0 + 16 * sb + 4 * (l >> 5)) * INWP + C_VB + h * 128 + 32 * db + (l & 31);
#pragma unroll
                for (int j = 0; j < 8; ++j) e[i][j] = vp[(size_t)(8 * (j >> 2) + (j & 3)) * INWP]; }
#pragma unroll
            for (int i = 0; i < 4; ++i) { const int id = F.tid + NTHR * (i0 + i), l = id & 63, sb = (id >> 6) & 1, db = (id >> 7) & 3, h = id >> 9;
                u32x4 w = {(unsigned)e[i][0] | ((unsigned)e[i][1] << 16), (unsigned)e[i][2] | ((unsigned)e[i][3] << 16), (unsigned)e[i][4] | ((unsigned)e[i][5] << 16), (unsigned)e[i][6] | ((unsigned)e[i][7] << 16)};
                *(u32x4*)(vbF + (((((size_t)(b * 8 + h) * 256 + blk) * 4 + db) * 2 + sb) * 64 + l) * 8) = w; }
        }
    }
}

#define MFMA32(a, b, c) __builtin_amdgcn_mfma_f32_32x32x16_bf16((a), (b), (c), 0, 0, 0)
DI void idx_chunk(const Frame& F, int b, int c) {
    const int l = F.lane, m = l & 31, hi = l >> 5, q = (m >> 2) & 1, head = ((m >> 3) << 2) | (m & 3);
    const int t0 = 64 * c + 8 * F.wave;
    const bf16_t* z = F.at<bf16_t>(WS_Z); const float* wif = F.at<float>(WS_WIF);
    LAS char* kl = (LAS char*)F.lds;
    bf16x8 Aq[4][4]; f32x4 wv[4][4];
#pragma unroll
    for (int p = 0; p < 4; ++p) { const bf16_t* qp = z + ((size_t)b * SEQ + t0 + 2 * p + q) * INWP + C_QI + head * 64 + hi * 8;
#pragma unroll
        for (int kk = 0; kk < 4; ++kk) Aq[p][kk] = *(const bf16x8*)(qp + kk * 16);
        const float* wp = wif + ((size_t)b * SEQ + t0 + 2 * p + hi) * 16;
#pragma unroll
        for (int r4 = 0; r4 < 4; ++r4) wv[p][r4] = *(const f32x4*)(wp + 4 * r4); }
    const int ntile = c + 1, L = 64 * (c + 1);
    const int skey = F.tid >> 3, sch = F.tid & 7;
    const bf16_t* kg = F.at<bf16_t>(WS_KIDX) + ((size_t)b * SEQ + skey) * 64 + sch * 8;
    const int swr = skey * 128 + ((sch ^ (skey & 7)) << 4);
    bf16_t* scb = F.at<bf16_t>(WS_SC) + (size_t)b * SC_PER_B + (size_t)2048 * c * (c + 1) + (size_t)(8 * F.wave + hi) * L + m;
    __syncthreads();
    u32x4 st = *(const u32x4*)kg;
    *(LAS u32x4*)(kl + swr) = st;
    if (ntile > 1) st = *(const u32x4*)(kg + (size_t)64 * 64);
    __syncthreads();
    for (int tl = 0; tl < ntile; ++tl) {
        LAS const char* kb = kl + (tl & 1) * 8192;
#pragma unroll
        for (int hb = 0; hb < 2; ++hb) {
            bf16x8 Bk[4];
            const int key = hb * 32 + m;
#pragma unroll
            for (int kk = 0; kk < 4; ++kk) Bk[kk] = *(LAS const bf16x8*)(kb + key * 128 + (((kk * 2 + hi) ^ (key & 7)) << 4));
#pragma unroll
            for (int p = 0; p < 4; ++p) {
                f32x16 acc = {};
#pragma unroll
                for (int kk = 0; kk < 4; ++kk) acc = MFMA32(Aq[p][kk], Bk[kk], acc);
                float sc_ = 0.f;
#pragma unroll
                for (int r = 0; r < 16; ++r) sc_ = fmaf(__int_as_float(max(__float_as_int(acc[r]), 0)), wv[p][r >> 2][r & 3], sc_);
                scb[(size_t)(2 * p) * L + tl * 64 + hb * 32] = (bf16_t)(cvt_pk_bf16(sc_, 0.f) & 0xffffu);
                if (p & 1) __builtin_amdgcn_sched_barrier(0);
            }
        }
        if (tl + 1 < ntile) {
            *(LAS u32x4*)(kl + ((tl + 1) & 1) * 8192 + swr) = st;
            if (tl + 2 < ntile) st = *(const u32x4*)(kg + (size_t)(tl + 2) * 64 * 64);
        }
        __syncthreads();
    }
}
DI void p4_indexer(const Frame& F) {
    for (int item = F.wg; item < 256; item += F.G) { const int b = item >> 6, pi = item & 63; idx_chunk(F, b, pi); idx_chunk(F, b, 127 - pi); }
}

DI unsigned f2key(float f) { const unsigned u = __float_as_uint(f); return u ^ ((unsigned)((int)u >> 31) | 0x80000000u); }
DI unsigned umed3(unsigned a, unsigned b, unsigned c) { const unsigned mx = a > b ? a : b, mn = a > b ? b : a; const unsigned t = mx < c ? mx : c; return mn > t ? mn : t; }
DI int wave_allsum(int v) {
    v += __builtin_amdgcn_update_dpp(0, v, 0xB1, 0xF, 0xF, false);
    v += __builtin_amdgcn_update_dpp(0, v, 0x4E, 0xF, 0xF, false);
    v += __builtin_amdgcn_update_dpp(0, v, 0x141, 0xF, 0xF, false);
    v += __builtin_amdgcn_update_dpp(0, v, 0x140, 0xF, 0xF, false);
    { auto r = __builtin_amdgcn_permlane16_swap((unsigned)v, (unsigned)v, false, false); v = (int)(r[0] + r[1]); }
    { auto r = __builtin_amdgcn_permlane32_swap((unsigned)v, (unsigned)v, false, false); v = (int)(r[0] + r[1]); }
    return v;
}
template <int NBITS> DI int wave_total(int pl) { int tot = 0;
#pragma unroll
    for (int b = 0; b < NBITS; ++b) tot += __popcll(__ballot((pl >> b) & 1)) << b;
    return tot; }
constexpr int NCVW = 2, NPW = NWAVES - NCVW;
constexpr int CVJ1 = NE * 32 * 64, CVJ2 = NE * 32 * 32, CVJ = CVJ1 + CVJ2;
struct CvJob { const float* src; unsigned char* dst; int N; };
DI CvJob cv_job(const Frame& F, int job) {
    CvJob J;
    if (job < CVJ1) { const int e = job >> 11, r = job & 2047, kt = r >> 6, nt = r & 63; J.N = 4096;
        J.src = F.kp->in[I_W1] + (size_t)e * 2048 * 4096 + (size_t)(kt * 64) * 4096 + nt * 64; J.dst = F.at<unsigned char>(WS_W1T) + (size_t)e * 4096 * 2048 + (size_t)(nt * 64) * 2048 + kt * 64; }
    else { const int j2 = job - CVJ1, e = j2 >> 10, r = j2 & 1023, kt = r >> 5, nt = r & 31; J.N = 2048;
        J.src = F.kp->in[I_W2] + (size_t)e * 2048 * 2048 + (size_t)(kt * 64) * 2048 + nt * 64; J.dst = F.at<unsigned char>(WS_W2T) + (size_t)e * 2048 * 2048 + (size_t)(nt * 64) * 2048 + kt * 64; }
    return J;
}
DI void cv_load(const CvJob& J, int l, f32x4 (&v)[16]) {
    const float* p = J.src + (size_t)((l >> 4) * 8) * J.N + (l & 15) * 4;
#pragma unroll
    for (int h = 0; h < 2; ++h)
#pragma unroll
        for (int i = 0; i < 8; ++i) v[h * 8 + i] = __builtin_nontemporal_load((const f32x4*)(p + (size_t)(h * 32 + i) * J.N));
}
DI void cv_finish(const CvJob& J, int l, const f32x4 (&v)[16], LAS unsigned char* Tl) {
    const int c4 = (l & 15) * 4, g = l >> 4;
#pragma unroll
    for (int h = 0; h < 2; ++h)
#pragma unroll
        for (int q = 0; q < 2; ++q)
#pragma unroll
            for (int j = 0; j < 4; ++j)
                *(LAS unsigned*)(Tl + (c4 + j) * 80 + h * 32 + g * 8 + q * 4) = pk_fp8x4(clamp448(v[h * 8 + q * 4][j] * 32.f), clamp448(v[h * 8 + q * 4 + 1][j] * 32.f), clamp448(v[h * 8 + q * 4 + 2][j] * 32.f), clamp448(v[h * 8 + q * 4 + 3][j] * 32.f));
    u32x4 o[4];
#pragma unroll
    for (int p = 0; p < 4; ++p) o[p] = *(LAS const u32x4*)(Tl + ((l >> 2) + 16 * p) * 80 + (l & 3) * 16);
#pragma unroll
    for (int p = 0; p < 4; ++p) __builtin_nontemporal_store(o[p], (u32x4*)(J.dst + (size_t)((l >> 2) + 16 * p) * 2048 + (l & 3) * 16));
}
DI void cv_stream(const Frame& F) {
    const int cw = F.wg * NCVW + (F.wave - NPW), ncw = F.G * NCVW, l = F.lane;
    LAS unsigned char* Tl = F.lds + 8192 + F.wave * 16640;
#pragma unroll 1
    for (int job = cw; job < CVJ; job += 6 * ncw) {
        f32x4 va[16], vb[16], vc[16];
        const int j1 = job + ncw, j2 = job + 2 * ncw, j3 = job + 3 * ncw, j4 = job + 4 * ncw, j5 = job + 5 * ncw;
        const CvJob J0 = cv_job(F, job), J1 = cv_job(F, j1 < CVJ ? j1 : job), J2 = cv_job(F, j2 < CVJ ? j2 : job);
#define CV_SB __builtin_amdgcn_sched_barrier(0)
        cv_load(J0, l, va); CV_SB; cv_load(J1, l, vb); CV_SB; cv_load(J2, l, vc); CV_SB;
        cv_finish(J0, l, va, Tl); CV_SB;
        const CvJob J3 = cv_job(F, j3 < CVJ ? j3 : job); cv_load(J3, l, va); CV_SB;
        if (j1 < CVJ) cv_finish(J1, l, vb, Tl);
        CV_SB;
        const CvJob J4 = cv_job(F, j4 < CVJ ? j4 : job); cv_load(J4, l, vb); CV_SB;
        if (j2 < CVJ) cv_finish(J2, l, vc, Tl);
        CV_SB;
        const CvJob J5 = cv_job(F, j5 < CVJ ? j5 : job); cv_load(J5, l, vc); CV_SB;
        if (j3 < CVJ) cv_finish(J3, l, va, Tl);
        CV_SB;
        if (j4 < CVJ) cv_finish(J4, l, vb, Tl);
        CV_SB;
        if (j5 < CVJ) cv_finish(J5, l, vc, Tl);
#undef CV_SB
    }
}
DI int p56_grab(LAS int* ctr, int lane) { int j = 0; if (lane == 0) j = __hip_atomic_fetch_add(ctr, 1, __ATOMIC_RELAXED, __HIP_MEMORY_SCOPE_WORKGROUP); return __builtin_amdgcn_readfirstlane(j); }
constexpr int P56_CTR = LDS_BYTES - 64;
DI void p5_select(const Frame& F) {
    { LAS int* ctr0 = (LAS int*)(F.lds + P56_CTR); if (F.tid < 2) ctr0[F.tid] = 0; __syncthreads(); }
    if (F.wave >= NPW) cv_stream(F);
    unsigned long long* sel = F.at<unsigned long long>(WS_SEL); const bf16_t* sc = F.at<bf16_t>(WS_SC);
    const int lane = F.lane;
    LAS int* ctr = (LAS int*)(F.lds + P56_CTR);
    LAS unsigned long long* wsl = (LAS unsigned long long*)(F.lds + F.wave * 1024);
    LAS unsigned* cl = (LAS unsigned*)(F.lds + 8192 + F.wave * 16640);
    for (;;) {
        const int row = p56_grab(ctr, lane) * F.G + F.wg; if (row >= T) break;
        const int b = row >> 13, t = row & 8191, c = t >> 6;
        if (c < 4) { if (lane <= c) sel[(size_t)row * 128 + lane] = ~0ull; continue; }
        const bf16_t* rowp = sc + (size_t)b * SC_PER_B + (size_t)2048 * c * (c + 1) + (size_t)(t & 63) * 64 * (c + 1);
        unsigned k[128];
        {
            float kf[128];
#pragma unroll
            for (int g = 0; g < 8; ++g) { const bf16_t* rg_ = rowp + ((g * 16 <= c) ? g * 1024 : 0);
#pragma unroll
                for (int i = 0; i < 16; ++i) kf[g * 16 + i] = bf2f(__builtin_nontemporal_load(rg_ + (unsigned)(i * 64 + lane))); }
#pragma unroll
            for (int i = 0; i < 128; ++i) k[i] = (i <= c) ? f2key(kf[i]) : 0u;
        }
        unsigned ta = 0u, tb = 0u, tc = 0u, td = 0u;
#pragma unroll
        for (int g = 0; g < 4; ++g) { if (g * 32 <= c) {
#pragma unroll
            for (int i = g * 32; i < g * 32 + 32; ++i) { const unsigned x = k[i]; const unsigned nd = umed3(tc, td, x), nc = umed3(tb, tc, x), nb = umed3(ta, tb, x); ta = ta > x ? ta : x; tb = nb; tc = nc; td = nd; } } }
        unsigned L = td;
#pragma unroll
        for (int o = 32; o >= 1; o >>= 1) { const unsigned y = (unsigned)__shfl_xor((int)L, o); L = L < y ? L : y; }
        unsigned wa = (unsigned)lane * 4u;
#pragma unroll
        for (int g = 0; g < 4; ++g) { if (g * 32 <= c) {
#pragma unroll
            for (int i = g * 32; i < g * 32 + 32; ++i) { *(LAS unsigned*)((LAS char*)cl + wa) = k[i]; wa += (k[i] >= L && wa < 64u * 256u) ? 256u : 0u; } } }
        const int npl = (int)(wa >> 8);
        int mx = npl;
#pragma unroll
        for (int o = 32; o >= 1; o >>= 1) { const int y = __shfl_xor(mx, o); mx = mx > y ? mx : y; }
        asm volatile("s_waitcnt lgkmcnt(0)" ::: "memory");
        unsigned U = ta;
#pragma unroll
        for (int o = 32; o >= 1; o >>= 1) { const unsigned y = (unsigned)__shfl_xor((int)U, o); U = U > y ? U : y; }
        const unsigned dif = (unsigned)__builtin_amdgcn_readfirstlane((int)(L ^ U));
        const int hb = dif ? 31 - __builtin_clz(dif) : -1;
        unsigned pfx = (hb >= 31) ? 0u : (hb < 0 ? L : (L & ~((2u << hb) - 1u)));
        int cge, cgt;
        if (mx <= 24) {
            unsigned cc[24];
#pragma unroll
            for (int j = 0; j < 24; ++j) { const unsigned v = cl[j * 64 + lane]; cc[j] = (j < npl) ? v : 0u; asm volatile("" : "+v"(cc[j])); }
            for (int bit = hb; bit >= 0; --bit) { const unsigned cand = pfx | (1u << bit); int pl = 0;
#pragma unroll
                for (int j = 0; j < 24; ++j) pl += (cc[j] >= cand) ? 1 : 0;
                pfx = (wave_allsum(pl) >= 256) ? cand : pfx; }
            int p1 = 0, p2 = 0;
#pragma unroll
            for (int j = 0; j < 24; ++j) { p1 += (cc[j] >= pfx) ? 1 : 0; p2 += (cc[j] > pfx) ? 1 : 0; }
            cge = __builtin_amdgcn_readfirstlane(wave_allsum(p1)); cgt = __builtin_amdgcn_readfirstlane(wave_allsum(p2));
        } else {
            for (int bit = hb; bit >= 0; --bit) { const unsigned cand = pfx | (1u << bit); int pl = 0;
#pragma unroll
                for (int i = 0; i < 128; ++i) pl += (k[i] >= cand) ? 1 : 0;
                pfx = (wave_allsum(pl) >= 256) ? cand : pfx; }
            unsigned thrc = pfx; asm volatile("" : "+v"(thrc));
            int p1 = 0, p2 = 0;
#pragma unroll
            for (int i = 0; i < 128; ++i) { p1 += (k[i] >= thrc) ? 1 : 0; p2 += (k[i] > thrc) ? 1 : 0; }
            cge = __builtin_amdgcn_readfirstlane(wave_allsum(p1)); cgt = __builtin_amdgcn_readfirstlane(wave_allsum(p2));
        }
        const unsigned prefix = (unsigned)__builtin_amdgcn_readfirstlane((int)pfx);
        const unsigned thr = prefix;
        if (cge == 256) {
#pragma unroll
            for (int g = 0; g < 32; ++g) { if ((g >> 3) * 32 <= c) { unsigned long long w4[4];
#pragma unroll
                for (int j = 0; j < 4; ++j) w4[j] = __ballot(k[g * 4 + j] >= thr);
                if (lane == 0) {
#pragma unroll
                    for (int j = 0; j < 4; ++j) wsl[g * 4 + j] = w4[j]; }
                __builtin_amdgcn_sched_barrier(0); } }
        } else {
            const int allowed = 256 - cgt; int R = 0;
#pragma unroll
            for (int i = 0; i < 128; ++i) {
                unsigned long long gtm = __ballot(k[i] > thr), tm = __ballot(k[i] == thr);
                const int nt = __popcll(tm);
                if (R + nt > allowed) { int keepn = allowed - R; if (keepn < 0) keepn = 0; while (__popcll(tm) > keepn) tm &= ~(1ull << (63 - __clzll(tm))); }
                R += nt;
                const unsigned long long word = gtm | tm;
                if (lane == 0) wsl[i] = word;
                if ((i & 3) == 3) __builtin_amdgcn_sched_barrier(0);
            }
        }
        asm volatile("s_waitcnt lgkmcnt(0)" ::: "memory");
        if (lane <= c) sel[(size_t)row * 128 + lane] = wsl[lane];
        if (lane + 64 <= c) sel[(size_t)row * 128 + 64 + lane] = wsl[64 + lane];
    }
}

DI bf16x8 pack8(const f32x16& x, int s) {
    const u32x4 p = {cvt_pk_bf16(x[8 * s], x[8 * s + 1]), cvt_pk_bf16(x[8 * s + 2], x[8 * s + 3]), cvt_pk_bf16(x[8 * s + 4], x[8 * s + 5]), cvt_pk_bf16(x[8 * s + 6], x[8 * s + 7])};
    return __builtin_bit_cast(bf16x8, p);
}
DI void p6_stick(const Frame& F) {
    const int l = F.lane, n = l & 31, hi = l >> 5;
    const bf16_t* z = F.at<bf16_t>(WS_Z); const bf16x8* kbF = F.at<bf16x8>(WS_KBF); const bf16x8* vbF = F.at<bf16x8>(WS_VBF); bf16_t* ob = F.at<bf16_t>(WS_OB);
    constexpr float C2 = 0.088388347648318440f * 1.4426950408889634f;
    LAS int* ctr = (LAS int*)(F.lds + P56_CTR) + 1;
    for (;;) {
        const int u = p56_grab(ctr, l) * F.G + F.wg; if (u >= NB * 8 * 256) break;
        const int qt = 255 - (u >> 5), bh = u & 31, b = bh >> 3, h = bh & 7, t0 = qt * 32;
        bf16x8 Bq[8];
        { const bf16_t* qp = z + ((size_t)b * SEQ + t0 + n) * INWP + C_QB + h * 128 + hi * 8;
#pragma unroll
          for (int kk = 0; kk < 8; ++kk) Bq[kk] = *(const bf16x8*)(qp + kk * 16); }
        f32x16 oT[4] = {};
        float carry = 0.f;
        bf16x8 Kn[8];
        { const bf16x8* kc0 = kbF + (((size_t)(b * 8 + h) * 256 + qt) * 8) * 64 + l;
#pragma unroll
          for (int kk = 0; kk < 8; ++kk) Kn[kk] = kc0[kk * 64]; }
        bf16x8 Vn[8];
        { const bf16x8* vc0 = vbF + (((size_t)(b * 8 + h) * 256 + qt) * 8) * 64 + l;
#pragma unroll
          for (int kk = 0; kk < 8; ++kk) Vn[kk] = vc0[kk * 64]; }
        for (int kb = qt; kb >= 0; --kb) {
            const bf16x8* kc = kbF + (((size_t)(b * 8 + h) * 256 + (kb > 0 ? kb - 1 : 0)) * 8) * 64 + l;
            const bf16x8* vc = vbF + (((size_t)(b * 8 + h) * 256 + (kb > 0 ? kb - 1 : 0)) * 8) * 64 + l;
            bf16x8 Ka[8], Va[8];
#pragma unroll
            for (int kk = 0; kk < 8; ++kk) { Ka[kk] = Kn[kk]; Va[kk] = Vn[kk]; }
#pragma unroll
            for (int kk = 0; kk < 8; ++kk) Kn[kk] = kc[kk * 64];
#pragma unroll
            for (int kk = 0; kk < 8; ++kk) Vn[kk] = vc[kk * 64];
            f32x16 S = {};
#pragma unroll
            for (int kk = 0; kk < 8; ++kk) S = MFMA32(Ka[kk], Bq[kk], S);
            const bool diag = (kb == qt);
            float lk[16], lb[16];
#pragma unroll
            for (int r = 0; r < 16; ++r) {
                const float z2 = S[r] * C2;
                const float e = __builtin_amdgcn_exp2f(-__builtin_fabsf(z2));
                const float sp = fmaxf(z2, 0.f) + __builtin_amdgcn_logf(1.0f + e);
                const int srel = (r & 3) + 8 * (r >> 2) + 4 * hi;
                const bool causal = !diag || (srel < n);
                lk[r] = causal ? -sp : 0.f; lb[r] = z2 - sp;
                S[r] = causal ? 0.f : -1e30f;
            }
            float G[4];
#pragma unroll
            for (int q = 0; q < 4; ++q) G[q] = (lk[4 * q] + lk[4 * q + 1]) + (lk[4 * q + 2] + lk[4 * q + 3]);
            float Ev[4], Ov[4];
#pragma unroll
            for (int q = 0; q < 4; ++q) { auto rr = __builtin_amdgcn_permlane32_swap(__float_as_uint(G[q]), __float_as_uint(G[q]), false, false); Ev[q] = __uint_as_float(rr[0]); Ov[q] = __uint_as_float(rr[1]); }
            float Rq[4]; Rq[3] = 0.f; Rq[2] = Ev[3] + Ov[3]; Rq[1] = Rq[2] + (Ev[2] + Ov[2]); Rq[0] = Rq[1] + (Ev[1] + Ov[1]);
            const float tot = Rq[0] + (Ev[0] + Ov[0]);
#pragma unroll
            for (int q = 0; q < 4; ++q) {
                const float base = carry + Rq[q] + (hi ? 0.f : Ov[q]);
                const float g3 = base, g2 = g3 + lk[4 * q + 3], g1 = g2 + lk[4 * q + 2], g0 = g1 + lk[4 * q + 1];
                S[4 * q + 3] = __builtin_amdgcn_exp2f(lb[4 * q + 3] + g3 + S[4 * q + 3]);
                S[4 * q + 2] = __builtin_amdgcn_exp2f(lb[4 * q + 2] + g2 + S[4 * q + 2]);
                S[4 * q + 1] = __builtin_amdgcn_exp2f(lb[4 * q + 1] + g1 + S[4 * q + 1]);
                S[4 * q + 0] = __builtin_amdgcn_exp2f(lb[4 * q + 0] + g0 + S[4 * q + 0]);
            }
            carry += tot;
            const bf16x8 P0 = pack8(S, 0), P1 = pack8(S, 1);
#pragma unroll
            for (int db = 0; db < 4; ++db) { oT[db] = MFMA32(Va[db * 2], P0, oT[db]); oT[db] = MFMA32(Va[db * 2 + 1], P1, oT[db]); }
            if (__all(carry < -150.5f)) break;
        }
        unsigned char* op = (unsigned char*)ob + ((size_t)b * SEQ + t0 + n) * 1024 + h * 128 + 4 * hi;
#pragma unroll
        for (int db = 0; db < 4; ++db)
#pragma unroll
            for (int q = 0; q < 4; ++q) *(unsigned*)(op + 32 * db + 8 * q) = pk_fp8x4(clamp448(oT[db][4 * q] * 32.f), clamp448(oT[db][4 * q + 1] * 32.f), clamp448(oT[db][4 * q + 2] * 32.f), clamp448(oT[db][4 * q + 3] * 32.f));
    }
}

namespace dsa {
constexpr float SCALE = 0.088388347648318440f, THR = 8.f;
constexpr int SHM_V = 64 * 128 * 2, SHM_K = 64 * 128 * 2, SHM_ATTN = 2 * SHM_V + 2 * SHM_K + 8 * 64 * 4;
#define KSWZ(row, colB) ((row) * 256 + ((colB) ^ (((row) & 7) << 4)))
#define SBAR() __builtin_amdgcn_sched_barrier(0)
DI int crow(int r, int hi) { return (r & 3) + 8 * (r >> 2) + 4 * hi; }
DI void apply_mask(f32x16& p0, f32x16& p1, unsigned long long w, int hi) {
    const unsigned lo = (unsigned)w >> (4 * hi), up = (unsigned)(w >> 32) >> (4 * hi);
#pragma unroll
    for (int r = 0; r < 16; ++r) { const int bp = (r & 3) + 8 * (r >> 2);
        const unsigned t0 = (unsigned)(((int)(lo << (31 - bp))) >> 31), t1 = (unsigned)(((int)(up << (31 - bp))) >> 31);
        p0[r] = __uint_as_float((__float_as_uint(p0[r]) & t0) | (~t0 & 0xff800000u));
        p1[r] = __uint_as_float((__float_as_uint(p1[r]) & t1) | (~t1 & 0xff800000u)); }
}
DI void partialSM(f32x16& p0, f32x16& p1, float& m_reg, float& mn, float& alpha) {
    constexpr float C = SCALE * 1.4426950408889634f;
    float pmax = p0[0];
#pragma unroll
    for (int r = 1; r < 16; ++r) pmax = fmaxf(pmax, p0[r]);
#pragma unroll
    for (int r = 0; r < 16; ++r) pmax = fmaxf(pmax, p1[r]);
    { auto rr = __builtin_amdgcn_permlane32_swap(__float_as_uint(pmax), __float_as_uint(pmax), false, false);
      pmax = fmaxf(__uint_as_float(rr[0]), __uint_as_float(rr[1])); }
    if (__builtin_expect(__all(pmax - m_reg <= THR / SCALE), 1)) { mn = m_reg; alpha = 1.f; }
    else { mn = fmaxf(m_reg, pmax); alpha = __builtin_amdgcn_exp2f((m_reg - mn) * C); m_reg = mn; }
    const float mnC = -mn * C;
#pragma unroll
    for (int r = 0; r < 16; ++r) p0[r] = fmaf(p0[r], C, mnC);
#pragma unroll
    for (int r = 0; r < 16; ++r) p1[r] = fmaf(p1[r], C, mnC);
#pragma unroll
    for (int r = 0; r < 16; ++r) p0[r] = __builtin_amdgcn_exp2f(p0[r]);
}
DI void finishSM(f32x16& p0, f32x16& p1, float alpha, float& l_reg, bf16x8& pa0, bf16x8& pa1, bf16x8& pa2, bf16x8& pa3) {
#pragma unroll
    for (int r = 0; r < 16; ++r) p1[r] = __builtin_amdgcn_exp2f(p1[r]);
    float ps = 0;
#pragma unroll
    for (int r = 0; r < 16; ++r) ps += p0[r];
#pragma unroll
    for (int r = 0; r < 16; ++r) ps += p1[r];
    { auto rr = __builtin_amdgcn_permlane32_swap(__float_as_uint(ps), __float_as_uint(ps), false, false);
      ps = __uint_as_float(rr[0]) + __uint_as_float(rr[1]); }
    l_reg = l_reg * alpha + ps;
#define PK4(P, BASE, OUT) do { unsigned a0 = cvt_pk_bf16(P[BASE + 0], P[BASE + 1]), a1 = cvt_pk_bf16(P[BASE + 2], P[BASE + 3]);   \
    unsigned b0 = cvt_pk_bf16(P[BASE + 4], P[BASE + 5]), b1 = cvt_pk_bf16(P[BASE + 6], P[BASE + 7]);                              \
    auto r0 = __builtin_amdgcn_permlane32_swap(a0, b0, false, false); auto r1 = __builtin_amdgcn_permlane32_swap(a1, b1, false, false); \
    u32x4 w = {r0[0], r1[0], r0[1], r1[1]}; OUT = __builtin_bit_cast(bf16x8, w); } while (0)
    PK4(p0, 0, pa0); PK4(p0, 8, pa1); PK4(p1, 0, pa2); PK4(p1, 8, pa3);
#undef PK4
}
DI void qkt(f32x16& p0, f32x16& p1, LAS const char* Ks, const bf16x8* qr, int r32, int hi) {
    p0 = f32x16{}; p1 = f32x16{};
#pragma unroll
    for (int d0 = 0; d0 < 8; ++d0) { const int cb = (d0 * 16 + hi * 8) * 2;
        const bf16x8 b0 = *(LAS const bf16x8*)(Ks + KSWZ(r32, cb));
        const bf16x8 b1 = *(LAS const bf16x8*)(Ks + KSWZ(32 + r32, cb));
        p0 = MFMA32(b0, qr[d0], p0);
        p1 = MFMA32(b1, qr[d0], p1); }
}
DI int v_st(int k, int c) { const int kk = (k & ~0xC) | ((k & 4) << 1) | ((k & 8) >> 1); return ((kk >> 3) * 4 + (c >> 5)) * 512 + ((kk & 7) * 32 + (c & 31)) * 2; }
DI int v_rd_base(int lane) { return ((lane & 3) << 3) | (((lane >> 2) & 3) << 6) | (((lane >> 4) & 1) << 5) | (((lane >> 5) & 1) << 8); }
constexpr int v_rd_off(int d0, int ks, int half) { return d0 * 512 + ks * 4096 + half * 2048; }
template <int OFF> DI s16x4 tr_read(int vb) { s16x4 r; asm volatile("ds_read_b64_tr_b16 %0, %1 offset:%2" : "=&v"(r) : "v"(vb), "i"(OFF) : "memory"); return r; }
template <int D0> DI void pv_one(f32x16& od, int vb, bf16x8 pa0, bf16x8 pa1, bf16x8 pa2, bf16x8 pa3) {
    const s16x4 l0 = tr_read<v_rd_off(D0, 0, 0)>(vb), h0 = tr_read<v_rd_off(D0, 0, 1)>(vb), l1 = tr_read<v_rd_off(D0, 1, 0)>(vb), h1 = tr_read<v_rd_off(D0, 1, 1)>(vb);
    const s16x4 l2 = tr_read<v_rd_off(D0, 2, 0)>(vb), h2 = tr_read<v_rd_off(D0, 2, 1)>(vb), l3 = tr_read<v_rd_off(D0, 3, 0)>(vb), h3 = tr_read<v_rd_off(D0, 3, 1)>(vb);
    asm volatile("s_waitcnt lgkmcnt(0)" ::: "memory"); SBAR();
#define PKV(L, H) (bf16x8){L[0], L[1], L[2], L[3], H[0], H[1], H[2], H[3]}
    od = MFMA32(pa0, PKV(l0, h0), od);
    od = MFMA32(pa1, PKV(l1, h1), od);
    od = MFMA32(pa2, PKV(l2, h2), od);
    od = MFMA32(pa3, PKV(l3, h3), od);
#undef PKV
}
DI void pv_d0(f32x16* o, int vb, bf16x8 pa0, bf16x8 pa1, bf16x8 pa2, bf16x8 pa3) {
    pv_one<0>(o[0], vb, pa0, pa1, pa2, pa3); pv_one<1>(o[1], vb, pa0, pa1, pa2, pa3); pv_one<2>(o[2], vb, pa0, pa1, pa2, pa3); pv_one<3>(o[3], vb, pa0, pa1, pa2, pa3);
}
DI void unit(const bf16_t* __restrict__ Qw, const bf16_t* __restrict__ Kh, const bf16_t* __restrict__ Vh, const unsigned long long* __restrict__ selw, int NT,
             bf16_t* __restrict__ Ob, LAS char* lds) {
    const int tid = threadIdx.x, wid = tid >> 6, lane = tid & 63, r32 = lane & 31, hi = lane >> 5;
    constexpr long LDK = INWP;
    LAS char* V_lds = lds; LAS char* K_lds = lds + 2 * SHM_V;
    LAS float* wsl = (LAS float*)(lds + 2 * SHM_V + 2 * SHM_K) + wid * 64; LAS float* li_l = wsl; LAS float* al_l = wsl + 32;
    float m_reg = -1e30f, l_reg = 0; f32x16 o[4] = {}; bf16x8 qr[8];
#pragma unroll
    for (int d0 = 0; d0 < 8; ++d0) qr[d0] = *(const bf16x8*)(Qw + d0 * 16);
    const int sr = tid >> 4, sc = (tid & 15) * 8, vst0 = v_st(sr, sc), vst1 = v_st(32 + sr, sc);
    const int vb0 = (int)(uintptr_t)V_lds + v_rd_base(lane);
    struct { bf16x8 vs0, vs1, ks0, ks1; } sr_[1];
    const int NTe = (NT + 1) & ~1;
    const unsigned soff0 = (unsigned)(sr * (int)LDK + sc) * 2u, soff1 = soff0 + 32u * (unsigned)LDK * 2u;
#define SLOAD(i, k0) do { const char* vb_ = (const char*)Vh + (size_t)(k0) * LDK * 2; const char* kb_ = (const char*)Kh + (size_t)(k0) * LDK * 2; \
    sr_[i].vs0 = *(const bf16x8*)(vb_ + soff0); sr_[i].vs1 = *(const bf16x8*)(vb_ + soff1); sr_[i].ks0 = *(const bf16x8*)(kb_ + soff0); sr_[i].ks1 = *(const bf16x8*)(kb_ + soff1); } while (0)
#define SWRITE(b, i) do { *(LAS bf16x8*)(V_lds + (b) * SHM_V + vst0) = sr_[i].vs0;          \
    *(LAS bf16x8*)(V_lds + (b) * SHM_V + vst1) = sr_[i].vs1; const int kc = sc * 2;               \
    *(LAS bf16x8*)(K_lds + (b) * SHM_K + KSWZ(sr, kc)) = sr_[i].ks0;                       \
    *(LAS bf16x8*)(K_lds + (b) * SHM_K + KSWZ(32 + sr, kc)) = sr_[i].ks1; } while (0)
#define SWAIT() asm volatile("s_waitcnt vmcnt(0)" ::: "memory")
#define RESC(a) do { if (__any((a) < 1.f)) { if (hi == 0) al_l[r32] = (a); asm volatile("s_waitcnt lgkmcnt(0)" ::: "memory"); \
    _Pragma("unroll") for (int d = 0; d < 4; ++d) _Pragma("unroll") for (int r = 0; r < 16; ++r) o[d][r] *= al_l[crow(r, hi)]; } } while (0)
    const unsigned seloff = (unsigned)r32 * 1024u;
#define MASKW(jt) (((jt) < NT) ? *(const unsigned long long*)((const char*)(selw + (jt)) + seloff) : 0ull)
    f32x16 pA0, pA1, pB0, pB1; float mnA, mnB, alA, alB; bf16x8 pa0, pa1, pa2, pa3;
    unsigned long long mA, mB;
    constexpr int SE = 0, SO = 0;
    mA = MASKW(0);
    SLOAD(SE, 0); asm volatile("s_waitcnt vmcnt(0)" ::: "memory"); SWRITE(0, SE); __syncthreads();
    qkt(pA0, pA1, K_lds, qr, r32, hi); apply_mask(pA0, pA1, mA, hi); partialSM(pA0, pA1, m_reg, mnA, alA);
    SLOAD(SO, 64);
    mB = MASKW(1);
    SWAIT(); SWRITE(1, SO); __syncthreads();
    for (int j = 1; j + 1 < NTe; j += 2) {
        mA = MASKW(j + 1);
        SBAR(); qkt(pB0, pB1, K_lds + SHM_K, qr, r32, hi);
        finishSM(pA0, pA1, alA, l_reg, pa0, pa1, pa2, pa3); SBAR();
        SLOAD(SO, (j + 1) * 64); SBAR();
        pv_d0(o, vb0, pa0, pa1, pa2, pa3); apply_mask(pB0, pB1, mB, hi); partialSM(pB0, pB1, m_reg, mnB, alB);
        __syncthreads(); SWAIT(); SWRITE(0, SE);
        RESC(alB); __syncthreads();
        mB = MASKW(j + 2);
        SBAR(); qkt(pA0, pA1, K_lds, qr, r32, hi);
        finishSM(pB0, pB1, alB, l_reg, pa0, pa1, pa2, pa3); SBAR();
        SLOAD(SE, (j + 2) * 64); SBAR();
        pv_d0(o, vb0 + SHM_V, pa0, pa1, pa2, pa3); apply_mask(pA0, pA1, mA, hi); partialSM(pA0, pA1, m_reg, mnA, alA);
        __syncthreads(); SWAIT(); SWRITE(1, SO);
        RESC(alA); __syncthreads();
    }
    SBAR(); qkt(pB0, pB1, K_lds + SHM_K, qr, r32, hi);
    finishSM(pA0, pA1, alA, l_reg, pa0, pa1, pa2, pa3); SBAR();
    pv_d0(o, vb0, pa0, pa1, pa2, pa3); apply_mask(pB0, pB1, mB, hi); partialSM(pB0, pB1, m_reg, mnB, alB);
    __syncthreads(); RESC(alB);
    finishSM(pB0, pB1, alB, l_reg, pa0, pa1, pa2, pa3); SBAR();
    pv_d0(o, vb0 + SHM_V, pa0, pa1, pa2, pa3);
    if (hi == 0) li_l[r32] = l_reg; asm volatile("s_waitcnt lgkmcnt(0)" ::: "memory");
    float rli[16];
#pragma unroll
    for (int r = 0; r < 16; ++r) rli[r] = __builtin_amdgcn_rcpf(li_l[crow(r, hi)]);
#pragma unroll
    for (int r = 0; r < 16; ++r) { const int orow = crow(r, hi);
#pragma unroll
        for (int d0 = 0; d0 < 4; ++d0) ((unsigned char*)Ob)[(long)orow * 1024 + d0 * 32 + r32] = (unsigned char)(pk_fp8x4(clamp448(o[d0][r] * rli[r] * 32.f), 0.f, 0.f, 0.f) & 0xffu); }
#undef SLOAD
#undef SWRITE
#undef SWAIT
#undef RESC
#undef MASKW
}
}
DI void p7_dsa(const Frame& F) {
    const bf16_t* z = F.at<bf16_t>(WS_Z); const unsigned long long* sel = F.at<unsigned long long>(WS_SEL); bf16_t* oa = F.at<bf16_t>(WS_OA);
    const int r32 = F.lane & 31, hi = F.lane >> 5;
    for (int item = F.wg; item < NB * 2 * 64; item += F.G) {
        const int pi = item & 63, j = (item >> 6) & 1, b = item >> 7;
#pragma unroll 1
        for (int half = 0; half < 2; ++half) {
            const int c = half ? pi : 127 - pi;
            const size_t q0 = (size_t)b * SEQ + 64 * c + (F.wave & 1) * 32;
            const int head = j * 4 + (F.wave >> 1);
            __syncthreads();
            dsa::unit(z + (q0 + r32) * INWP + C_QA + head * 128 + hi * 8, z + (size_t)b * SEQ * INWP + C_KA + j * 128, z + (size_t)b * SEQ * INWP + C_VA + j * 128,
                      sel + q0 * 128, c + 1, (bf16_t*)((unsigned char*)oa + q0 * 1024 + head * 128), (LAS char*)F.lds);
        }
    }
}

struct MergedSched {
    pg8::TileOrder ord; unsigned OA, OB, WA, WB;
    DI bool next(int i, pg8::Unit& u) const { int pm, pn; if (!ord.tile(i >> 1, pm, pn)) return false; const int br = i & 1;
        u.pm = pm; u.pn = pn; u.e = 0; u.aux = br; u.A = (br ? OB : OA) + (unsigned)pm * 256u * 1024u; u.B = (br ? WB : WA) + (unsigned)pn * 256u * 1024u; return true; }
};
struct EpiMerged {
    static constexpr bool PERM = true;
    const unsigned char* GZ; unsigned char* O;
    static DI float g4(unsigned w, int j) { const f32x2 p = (j < 2) ? __builtin_amdgcn_cvt_pk_f32_fp8((int)w, false) : __builtin_amdgcn_cvt_pk_f32_fp8((int)w, true); return ((j & 1) ? p.y : p.x) * 0.0625f; }
    DI bool operator()(f32x4 (&acc)[2][2][4][2], const pg8::Unit& u, int wr, int wc, int fr, int fq) const {
        const int row0 = u.pm * 256 + wr * 64 + fr, col0 = u.pn * 256 + wc * 32 + 8 * fq;
        u32x2 gav[2][4][2], gbv[2][4][2];
#pragma unroll
        for (int ai = 0; ai < 2; ++ai)
#pragma unroll
            for (int m = 0; m < 4; ++m)
#pragma unroll
                for (int bj = 0; bj < 2; ++bj) { const size_t row = (size_t)(row0 + ai * 128 + m * 16); const int col = col0 + bj * 128;
                    gbv[ai][m][bj] = *(const u32x2*)(GZ + row * 4096 + 2048 + col); if (u.aux == 0) gav[ai][m][bj] = *(const u32x2*)(GZ + row * 4096 + col); else gav[ai][m][bj] = (u32x2){0u, 0u}; }
        if (u.aux != 0) {
#pragma unroll
            for (int ai = 0; ai < 2; ++ai)
#pragma unroll
                for (int m = 0; m < 4; ++m)
#pragma unroll
                    for (int bj = 0; bj < 2; ++bj) asm volatile("" : "+v"(gbv[ai][m][bj]));
        }
#pragma unroll
        for (int ai = 0; ai < 2; ++ai) {
#pragma unroll
            for (int m = 0; m < 4; ++m) { const size_t row = (size_t)(row0 + ai * 128 + m * 16);
#pragma unroll
                for (int bj = 0; bj < 2; ++bj) { const int col = col0 + bj * 128;
                    float f[8];
                    if (u.aux == 0) {
#pragma unroll
                        for (int j = 0; j < 8; ++j) { const float ga = g4(j < 4 ? gav[ai][m][bj].x : gav[ai][m][bj].y, j & 3), gb = g4(j < 4 ? gbv[ai][m][bj].x : gbv[ai][m][bj].y, j & 3);
                            f[j] = (1.f + __expf(-gb)) * __builtin_amdgcn_rcpf(1.f + __expf(-ga)); }
                    } else {
#pragma unroll
                        for (int j = 0; j < 8; ++j) { const float gb = g4(j < 4 ? gbv[ai][m][bj].x : gbv[ai][m][bj].y, j & 3); f[j] = __builtin_amdgcn_rcpf(1.f + __expf(-gb)); }
                    }
                    f32x4 v0 = acc[ai][bj][m][0], v1 = acc[ai][bj][m][1];
                    v0[0] *= f[0]; v0[1] *= f[1]; v0[2] *= f[2]; v0[3] *= f[3]; v1[0] *= f[4]; v1[1] *= f[5]; v1[2] *= f[6]; v1[3] *= f[7];
                    if (u.aux == 0) { acc[ai][bj][m][0] = v0; acc[ai][bj][m][1] = v1; }
                    else { u32x2 w; w.x = pk_fp8x4(clamp448(v0[0] * 16.f), clamp448(v0[1] * 16.f), clamp448(v0[2] * 16.f), clamp448(v0[3] * 16.f));
                        w.y = pk_fp8x4(clamp448(v1[0] * 16.f), clamp448(v1[1] * 16.f), clamp448(v1[2] * 16.f), clamp448(v1[3] * 16.f));
                        *(u32x2*)(O + row * DM + col) = w; } } }
        }
        return u.aux == 0;
    }
};

typedef int v4i32q __attribute__((ext_vector_type(4)));
constexpr int LDS_TAB = 131072;
DI void p10_rows(const Frame& F) {
    LAS float* cG1 = (LAS float*)F.lds; LAS float* cA1 = cG1 + DM; LAS float* cA2 = cA1 + DM; LAS float* cB2 = cA2 + DM;
    LAS float* lg = cB2 + DM;
    LAS int* se = (LAS int*)(lg + 128 * 33);
    const float* mod = F.at<float>(WS_MOD); const bf16_t* mix = F.at<bf16_t>(WS_MIX);
    bf16_t* h2h = F.at<bf16_t>(WS_H); bf16_t* h2l = F.at<bf16_t>(WS_H2LO); unsigned char* h2q = F.at<unsigned char>(WS_H2Q);
    for (int blk = F.wg; blk < T / 128; blk += F.G) {
        const int b = blk / 64;
        __syncthreads();
#pragma unroll
        for (int i = 0; i < 4; ++i) { const int col = F.tid * 4 + i; const float* mb = mod + (size_t)b * 12288;
            cG1[col] = F.kp->in[I_GPOSTMIX][col] * mb[4096 + col]; cA2[col] = F.kp->in[I_GPREFFN][col] * (1.0f + mb[8192 + col]); cB2[col] = mb[6144 + col]; }
        __syncthreads();
        const size_t rowb = (size_t)blk * 128 + F.wave * 16;
        f32x4 xv[8], xn[8]; u32x2 mw[8], mn[8];
        { const float* xr = F.kp->in[I_X] + rowb * DM + F.lane * 4; const bf16_t* mr = mix + rowb * DM + F.lane * 4;
#pragma unroll
          for (int q = 0; q < 8; ++q) { xv[q] = __builtin_nontemporal_load((const f32x4*)(xr + q * 256)); mw[q] = __builtin_nontemporal_load((const u32x2*)(mr + q * 256)); } }
        for (int i = 0; i < 16; ++i) {
            const size_t row = rowb + i;
            if (i + 1 < 16) { const float* xr = F.kp->in[I_X] + (row + 1) * DM + F.lane * 4; const bf16_t* mr = mix + (row + 1) * DM + F.lane * 4;
#pragma unroll
                for (int q = 0; q < 8; ++q) { xn[q] = __builtin_nontemporal_load((const f32x4*)(xr + q * 256)); mn[q] = __builtin_nontemporal_load((const u32x2*)(mr + q * 256)); } }
            float ss = 0.f;
#pragma unroll
            for (int q = 0; q < 8; ++q) { const float m0 = bflo(mw[q].x), m1 = bfhi(mw[q].x), m2 = bflo(mw[q].y), m3 = bfhi(mw[q].y); ss += m0 * m0 + m1 * m1 + m2 * m2 + m3 * m3; }
            ss = wave_sum(ss);
            const float rs1 = rsqrtf(ss * (1.0f / DM) + RMS_EPS);
            float s2 = 0.f; bf16_t* orow = F.at<bf16_t>(WS_X1B) + row * DM + F.lane * 4;
#pragma unroll
            for (int q = 0; q < 8; ++q) { const int col = q * 256 + F.lane * 4; const float mq[4] = {bflo(mw[q].x), bfhi(mw[q].x), bflo(mw[q].y), bfhi(mw[q].y)};
#pragma unroll
                for (int e = 0; e < 4; ++e) { xv[q][e] += mq[e] * rs1 * cG1[col + e]; s2 += xv[q][e] * xv[q][e]; }
                *(u32x2*)(orow + q * 256) = (u32x2){cvt_pk_bf16(xv[q][0], xv[q][1]), cvt_pk_bf16(xv[q][2], xv[q][3])}; }
            s2 = wave_sum(s2);
            const float rs2 = rsqrtf(s2 * (1.0f / DM) + RMS_EPS);
            int lz = F.lane * 4; asm volatile("" : "+v"(lz));
#pragma unroll
            for (int q = 0; q < 8; ++q) { const int col = q * 256 + lz; float h[4], lo[4]; unsigned hb[4];
#pragma unroll
                for (int e = 0; e < 4; ++e) { h[e] = xv[q][e] * rs2 * cA2[col + e] + cB2[col + e]; hb[e] = cvt_pk_bf16(h[e], 0.f) & 0xffffu; lo[e] = h[e] - __uint_as_float(hb[e] << 16); }
                u32x2 wh = {hb[0] | (hb[1] << 16), hb[2] | (hb[3] << 16)}; u32x2 wl = {cvt_pk_bf16(lo[0], lo[1]), cvt_pk_bf16(lo[2], lo[3])};
                *(u32x2*)(h2h + row * DM + col) = wh; *(u32x2*)(h2l + row * DM + col) = wl;
                *(unsigned*)(h2q + row * DM + col) = pk_fp8x4(clamp448(h[0]), clamp448(h[1]), clamp448(h[2]), clamp448(h[3])); }
#pragma unroll
            for (int q = 0; q < 8; ++q) { xv[q] = xn[q]; mw[q] = mn[q]; }
        }
        asm volatile("s_waitcnt vmcnt(0)" ::: "memory");
        if (F.tid >= 256 && F.tid < 288) se[512 + F.tid - 256] = 0;
        __syncthreads();
        {
            const int l = F.lane, m = l & 31, hi = l >> 5, g = F.wave & 3, kh = F.wave >> 2; const size_t r0 = (size_t)blk * 128 + g * 32;
            const bf16_t* ah = h2h + (r0 + m) * DM + kh * (DM / 2) + hi * 8; const bf16_t* al = h2l + (r0 + m) * DM + kh * (DM / 2) + hi * 8;
            const bf16_t* wh = F.at<bf16_t>(WS_WRT) + (size_t)m * DM + kh * (DM / 2) + hi * 8; const bf16_t* wl = wh + NE * DM;
            f32x16 acc = {};
#pragma unroll 8
            for (int kk = 0; kk < DM / 32; ++kk) { const bf16x8 a0 = *(const bf16x8*)(ah + kk * 16), a1 = *(const bf16x8*)(al + kk * 16), b0 = *(const bf16x8*)(wh + kk * 16), b1 = *(const bf16x8*)(wl + kk * 16);
                acc = MFMA32(a0, b0, acc); acc = MFMA32(a1, b0, acc); acc = MFMA32(a0, b1, acc); }
            const float br = F.kp->in[I_BR][m];
            if (kh == 0) {
#pragma unroll
                for (int r = 0; r < 16; ++r) lg[(g * 32 + (r & 3) + 8 * (r >> 2) + 4 * hi) * 33 + m] = acc[r] + br; }
            __syncthreads();
            if (kh == 1) {
#pragma unroll
                for (int r = 0; r < 16; ++r) lg[(g * 32 + (r & 3) + 8 * (r >> 2) + 4 * hi) * 33 + m] += acc[r]; }
        }
        __syncthreads();
        if (F.tid < 128) {
            float v[32];
#pragma unroll
            for (int e = 0; e < 32; ++e) v[e] = lg[F.tid * 33 + e];
            int te[4]; float tv[4];
#pragma unroll
            for (int k = 0; k < 4; ++k) { float best = -INFINITY; int bi = 0;
#pragma unroll
                for (int e = 0; e < 32; ++e) { if (v[e] > best) { best = v[e]; bi = e; } }
                te[k] = bi; tv[k] = best;
#pragma unroll
                for (int e = 0; e < 32; ++e) if (e == bi) v[e] = -INFINITY; }
            const float e1 = __expf(tv[1] - tv[0]), e2 = __expf(tv[2] - tv[0]), e3 = __expf(tv[3] - tv[0]); const float inv = 1.0f / (1.0f + e1 + e2 + e3);
            const size_t tok = (size_t)blk * 128 + F.tid;
            int* tep = F.at<int>(WS_TOPE) + tok * 4; float* twp = F.at<float>(WS_TOPW) + tok * 4;
            tep[0] = te[0]; tep[1] = te[1]; tep[2] = te[2]; tep[3] = te[3]; twp[0] = inv; twp[1] = e1 * inv; twp[2] = e2 * inv; twp[3] = e3 * inv;
#pragma unroll
            for (int k = 0; k < 4; ++k) __hip_atomic_fetch_add(se + 512 + te[k], 1, __ATOMIC_RELAXED, __HIP_MEMORY_SCOPE_WORKGROUP);
        }
        __syncthreads();
        if (F.tid < 32) F.at<int>(WS_CNT)[blk * 32 + F.tid] = se[512 + F.tid];
    }
}

DI void moe_tables(const Frame& F, int blk) {
    LAS int* tb = (LAS int*)(F.lds + LDS_TAB); LAS int* part = tb + 1024;
    __syncthreads();
    { const int e = F.tid & 31, g = F.tid >> 5; const int* cnt = F.at<int>(WS_CNT) + (g * 16) * 32 + e; int v[16];
#pragma unroll
      for (int j = 0; j < 16; ++j) v[j] = cnt[j * 32];
      int all = 0, bef = 0;
#pragma unroll
      for (int j = 0; j < 16; ++j) { all += v[j]; bef += (g * 16 + j < blk) ? v[j] : 0; }
      part[g * 32 + e] = all; part[512 + g * 32 + e] = bef; }
    __syncthreads();
    if (F.tid < 32) { int tot = 0, pre = 0;
#pragma unroll
        for (int g = 0; g < 16; ++g) { tot += part[g * 32 + F.tid]; pre += part[512 + g * 32 + F.tid]; }
        tb[F.tid] = tot; tb[160 + F.tid] = pre; tb[64 + F.tid] = (tot + 255) >> 8; }
    __syncthreads();
    if (F.tid == 0) { int rs = 0, us = 0; for (int e = 0; e < 32; ++e) { tb[32 + e] = rs; tb[96 + e] = us; rs += tb[64 + e] * 256; us += tb[64 + e]; } tb[96 + 32] = us; }
    __syncthreads();
}
DI void p11_sort(const Frame& F) {
    LAS int* tb = (LAS int*)(F.lds + LDS_TAB); LAS int* se = (LAS int*)F.lds; LAS int* pos = se + 512;
    int* rslot = F.at<int>(WS_RSLOT); float* rw = F.at<float>(WS_RW); const unsigned char* h2q = F.at<unsigned char>(WS_H2Q); unsigned char* hs = F.at<unsigned char>(WS_HS);
    for (int blk = F.wg; blk < T / 128; blk += F.G) {
        moe_tables(F, blk);
        se[F.tid] = F.at<int>(WS_TOPE)[(size_t)blk * 512 + F.tid];
        __syncthreads();
        {
            LAS int* wc = pos + 512;
            const int e = se[F.tid]; int rank = 0, mine = 0;
#pragma unroll 1
            for (int ee = 0; ee < 32; ++ee) { const unsigned long long mk = __ballot(e == ee);
                if (e == ee) { rank = __builtin_popcountll(mk & ((1ull << F.lane) - 1ull)); mine = __builtin_popcountll(mk); }
                if (F.lane == 0) wc[F.wave * 32 + ee] = __builtin_popcountll(mk); }
            (void)mine;
            __syncthreads();
            int before = 0;
            for (int w = 0; w < F.wave; ++w) before += wc[w * 32 + e];
            pos[F.tid] = tb[32 + e] + tb[160 + e] + before + rank;
        }
        __syncthreads();
        { const int p = pos[F.tid]; rslot[p] = blk * 512 + F.tid; rw[p] = F.at<float>(WS_TOPW)[(size_t)blk * 512 + F.tid]; }
        for (int t0 = F.wave * 8; t0 < 128; t0 += NWAVES * 8) {
            u32x4 v[8][2];
#pragma unroll
            for (int e = 0; e < 8; ++e) { const u32x4* src = (const u32x4*)(h2q + ((size_t)blk * 128 + t0 + e) * DM); v[e][0] = src[F.lane]; v[e][1] = src[64 + F.lane]; }
#pragma unroll
            for (int e = 0; e < 8; ++e)
#pragma unroll
                for (int k = 0; k < 4; ++k) { u32x4* dst = (u32x4*)(hs + (size_t)pos[(t0 + e) * 4 + k] * DM); dst[F.lane] = v[e][0]; dst[64 + F.lane] = v[e][1]; } }
        if (blk < 32) { const int e = blk, lo = tb[32 + e] + tb[e], hi_ = tb[32 + e] + tb[64 + e] * 256;
            for (int p = lo + F.tid; p < hi_; p += NTHR) { rslot[p] = -1; rw[p] = 0.f; }
            for (int p = lo + F.wave; p < hi_; p += NWAVES) { u32x4* dst = (u32x4*)(hs + (size_t)p * DM);
#pragma unroll
                for (int q = 0; q < 2; ++q) dst[q * 64 + F.lane] = (u32x4){0u, 0u, 0u, 0u}; } }
        __syncthreads();
    }
}

template <int NT_, int NROWS_B> DI void moe_units(const Frame& F, unsigned Abase, unsigned Bbase) {
    LAS int* tb = (LAS int*)(F.lds + LDS_TAB);
    const int total = tb[96 + 32] * NT_;
    int n = 0;
    for (int i = F.tid; ; i += NTHR) { const int L = i * F.G + F.wg; if (L >= total) break;
        int e = 0;
#pragma unroll 1
        for (int q = 1; q < 32; ++q) if (L >= tb[96 + q] * NT_) e = q;
        const int l = L - tb[96 + e] * NT_, mt = tb[64 + e], mi = l % mt, ni = l / mt, r0 = tb[32 + e] + mi * 256;
        tb[256 + 4 * i] = (int)(Abase + (unsigned)r0 * 2048u); tb[256 + 4 * i + 1] = (int)(Bbase + ((unsigned)e * NROWS_B + (unsigned)ni * 256u) * 2048u); tb[256 + 4 * i + 2] = r0 >> 8; tb[256 + 4 * i + 3] = (e << 8) | ni; }
    if (F.tid == 0) { const int mine = total > F.wg ? (total - F.wg + F.G - 1) / F.G : 0; tb[255] = mine; }
    (void)n;
    __syncthreads();
}
struct MoeSched {
    LAS const int* tb;
    DI bool next(int i, pg8::Unit& u) const {
        if (i >= __builtin_amdgcn_readfirstlane(tb[255])) return false;
        const v4i32q v = *(LAS const v4i32q*)(tb + 256 + 4 * i);
        u.A = (unsigned)__builtin_amdgcn_readfirstlane(v[0]); u.B = (unsigned)__builtin_amdgcn_readfirstlane(v[1]); u.pm = __builtin_amdgcn_readfirstlane(v[2]);
        const int w = __builtin_amdgcn_readfirstlane(v[3]); u.pn = w & 255; u.e = w >> 8; u.aux = 0; return true; }
};
DI void dense_units(const Frame& F, int nM, int nN, unsigned Abase, unsigned Bbase, unsigned RB) {
    LAS int* tb = (LAS int*)(F.lds + LDS_TAB);
    pg8::TileOrder ord; ord.init(nM, nN, F.G, F.wg);
    __syncthreads();
    int n = 0;
    for (int i = F.tid; ; i += NTHR) { int pm, pn; if (!ord.tile(i, pm, pn)) break;
        tb[256 + 4 * i] = (int)(Abase + (unsigned)pm * 256u * RB); tb[256 + 4 * i + 1] = (int)(Bbase + (unsigned)pn * 256u * RB); tb[256 + 4 * i + 2] = pm; tb[256 + 4 * i + 3] = pn; }
    if (F.tid == 0) { const int total = nM * nN; tb[255] = total > F.wg ? (total - F.wg + F.G - 1) / F.G : 0; }
    (void)n;
    __syncthreads();
}
DI u32x4 xpose4(unsigned d0, unsigned d1, unsigned d2, unsigned d3) {
    typedef unsigned u32x2v_ __attribute__((ext_vector_type(2)));
    const u32x2v_ a = __builtin_amdgcn_permlane16_swap(d0, d1, false, false), b = __builtin_amdgcn_permlane16_swap(d2, d3, false, false);
    const u32x2v_ x = __builtin_amdgcn_permlane32_swap(a.x, b.x, false, false), y = __builtin_amdgcn_permlane32_swap(a.y, b.y, false, false);
    u32x4 r; r.x = x.x; r.y = y.x; r.z = x.y; r.w = y.y; return r;
}
struct EpiMoe1 {
    static constexpr bool PERM = true;
    const float* b1; unsigned char* act;
    DI bool operator()(const f32x4 (&acc)[2][2][4][2], const pg8::Unit& u, int wr, int wc, int fr, int fq) const {
        const int row0 = u.pm * 256 + wr * 64 + fr, col0 = u.pn * 256 + wc * 32 + 8 * fq;
        f32x4 bva[2][2];
#pragma unroll
        for (int bj = 0; bj < 2; ++bj) { bva[bj][0] = *(const f32x4*)(b1 + (size_t)u.e * 4096 + col0 + bj * 128); bva[bj][1] = *(const f32x4*)(b1 + (size_t)u.e * 4096 + col0 + bj * 128 + 4); }
#pragma unroll
        for (int bj = 0; bj < 2; ++bj) {
            const f32x4 bv0 = bva[bj][0], bv1 = bva[bj][1];
#pragma unroll
            for (int ai = 0; ai < 2; ++ai) {
                unsigned d[4];
#pragma unroll
                for (int m = 0; m < 4; ++m) {
                    const f32x4 v0 = acc[ai][bj][m][0] + bv0, v1 = acc[ai][bj][m][1] + bv1;
                    float o[4];
#pragma unroll
                    for (int jp = 0; jp < 2; ++jp) {
                        const f32x4 vv = jp ? v1 : v0;
                        const f32x2 g2 = {fminf(vv[0], 7.0f), fminf(vv[2], 7.0f)}, l2 = {fminf(fmaxf(vv[1], -7.0f), 7.0f), fminf(fmaxf(vv[3], -7.0f), 7.0f)};
                        const f32x2 a2 = g2 * (-1.702f * 1.44269504f);
                        f32x2 d2 = {__builtin_amdgcn_exp2f(a2.x), __builtin_amdgcn_exp2f(a2.y)}; d2 = d2 + 1.0f;
                        const f32x2 r2 = {__builtin_amdgcn_rcpf(d2.x), __builtin_amdgcn_rcpf(d2.y)};
                        const f32x2 o2 = (g2 * r2) * (l2 * 4.0f + 4.0f);
                        o[2 * jp] = o2.x; o[2 * jp + 1] = o2.y; }
                    d[m] = pk_fp8x4(o[0], o[1], o[2], o[3]); }
                *(u32x4*)(act + (size_t)(row0 + ai * 128 + fq * 16) * DFF + ((col0 - 8 * fq) >> 1) + bj * 64) = xpose4(d[0], d[1], d[2], d[3]); }
            asm volatile("" ::: "memory");
        }
        return false;
    }
};
struct EpiMoe2 {
    static constexpr bool PERM = true;
    const float* b2; const int* rslot; const float* rw; unsigned char* ys;
    DI bool operator()(const f32x4 (&acc)[2][2][4][2], const pg8::Unit& u, int wr, int wc, int fr, int fq) const {
        const int row0 = u.pm * 256 + wr * 64 + fr, col0 = u.pn * 256 + wc * 32 + 8 * fq;
        int slot[2][4]; float w[2][4]; f32x4 bv[2][2];
#pragma unroll
        for (int ai = 0; ai < 2; ++ai)
#pragma unroll
            for (int m = 0; m < 4; ++m) { const int row = row0 + ai * 128 + m * 16; slot[ai][m] = rslot[row]; w[ai][m] = rw[row]; }
#pragma unroll
        for (int bj = 0; bj < 2; ++bj) { bv[bj][0] = *(const f32x4*)(b2 + (size_t)u.e * 2048 + col0 + bj * 128); bv[bj][1] = *(const f32x4*)(b2 + (size_t)u.e * 2048 + col0 + bj * 128 + 4); }
#pragma unroll
        for (int ai = 0; ai < 2; ++ai)
#pragma unroll
            for (int m = 0; m < 4; ++m) asm volatile("" : "+v"(slot[ai][m]), "+v"(w[ai][m]));
#pragma unroll
        for (int bj = 0; bj < 2; ++bj) asm volatile("" : "+v"(bv[bj][0]), "+v"(bv[bj][1]));
        asm volatile("" ::: "memory");
#pragma unroll
        for (int ai = 0; ai < 2; ++ai) {
#pragma unroll
            for (int bj = 0; bj < 2; ++bj) {
                const f32x4 bv0 = bv[bj][0], bv1 = bv[bj][1];
#pragma unroll
                for (int m = 0; m < 4; ++m) {
                    if (slot[ai][m] >= 0) { const float ws_ = w[ai][m] * 16.f; const f32x4 v0 = (acc[ai][bj][m][0] + bv0) * ws_, v1 = (acc[ai][bj][m][1] + bv1) * ws_;
                        u32x2 q; q.x = pk_fp8x4(clamp448(v0[0]), clamp448(v0[1]), clamp448(v0[2]), clamp448(v0[3])); q.y = pk_fp8x4(clamp448(v1[0]), clamp448(v1[1]), clamp448(v1[2]), clamp448(v1[3]));
                        *(u32x2*)(ys + (size_t)slot[ai][m] * DM + col0 + bj * 128) = q; } }
            }
        }
        return false;
    }
};

DI void p14_final(const Frame& F) {
    LAS float* cG = (LAS float*)F.lds; const float* mod = F.at<float>(WS_MOD); const unsigned char* ys = F.at<unsigned char>(WS_YS);
    for (int blk = F.wg; blk < T / 128; blk += F.G) {
        const int b = blk / 64;
        __syncthreads();
#pragma unroll
        for (int i = 0; i < 4; ++i) { const int col = F.tid * 4 + i; cG[col] = F.kp->in[I_GPOSTFFN][col] * mod[(size_t)b * 12288 + 10240 + col]; }
        __syncthreads();
        const size_t rowb = (size_t)blk * 128 + F.wave * 16;
        unsigned yw[4][8], yn[4][8];
#pragma unroll
        for (int k = 0; k < 4; ++k)
#pragma unroll
            for (int q = 0; q < 8; ++q) yw[k][q] = *(const unsigned*)(ys + (rowb * 4 + k) * DM + q * 256 + F.lane * 4);
        u32x2 x1w[8], x1n[8];
#pragma unroll
        for (int q = 0; q < 8; ++q) x1w[q] = *(const u32x2*)(F.at<bf16_t>(WS_X1B) + rowb * DM + F.lane * 4 + q * 256);
        for (int i = 0; i < 16; ++i) {
            const size_t row = rowb + i;
            if (i + 1 < 16) {
#pragma unroll
                for (int k = 0; k < 4; ++k)
#pragma unroll
                    for (int q = 0; q < 8; ++q) yn[k][q] = *(const unsigned*)(ys + ((row + 1) * 4 + k) * DM + q * 256 + F.lane * 4);
#pragma unroll
                for (int q = 0; q < 8; ++q) x1n[q] = *(const u32x2*)(F.at<bf16_t>(WS_X1B) + (row + 1) * DM + F.lane * 4 + q * 256); }
            float* orow = F.kp->out + row * DM + F.lane * 4;
            f32x4 x1[8];
#pragma unroll
            for (int q = 0; q < 8; ++q) x1[q] = (f32x4){bflo(x1w[q].x), bfhi(x1w[q].x), bflo(x1w[q].y), bfhi(x1w[q].y)};
            f32x4 f[8]; float ss = 0.f;
#pragma unroll
            for (int q = 0; q < 8; ++q) { f[q] = (f32x4){0.f, 0.f, 0.f, 0.f};
#pragma unroll
                for (int k = 0; k < 4; ++k) { const unsigned w = yw[k][q]; const f32x2 lo = __builtin_amdgcn_cvt_pk_f32_fp8((int)w, false), hi = __builtin_amdgcn_cvt_pk_f32_fp8((int)w, true);
                    f[q] += (f32x4){lo.x, lo.y, hi.x, hi.y}; }
                f[q] *= 0.0625f;
                ss += f[q][0] * f[q][0] + f[q][1] * f[q][1] + f[q][2] * f[q][2] + f[q][3] * f[q][3]; }
            ss = wave_sum(ss);
            const float rs = rsqrtf(ss * (1.0f / DM) + RMS_EPS);
#pragma unroll
            for (int q = 0; q < 8; ++q) { const int col = q * 256 + F.lane * 4;
#pragma unroll
                for (int e = 0; e < 4; ++e) x1[q][e] += f[q][e] * rs * cG[col + e];
                __builtin_nontemporal_store(x1[q], (f32x4*)(orow + q * 256)); }
#pragma unroll
            for (int k = 0; k < 4; ++k)
#pragma unroll
                for (int q = 0; q < 8; ++q) yw[k][q] = yn[k][q];
#pragma unroll
            for (int q = 0; q < 8; ++q) x1w[q] = x1n[q];
        }
    }
}

constexpr int N_PHASES = 15;
__global__ void __launch_bounds__(NTHR, 2) mega(Params p) {
    extern __shared__ __attribute__((aligned(16))) unsigned char lds_raw[];
    Frame F; F.kp = (KParams)__builtin_amdgcn_kernarg_segment_ptr(); F.ws = p.ws; F.lds = (LAS unsigned char*)lds_raw; F.tid = threadIdx.x; F.wave = __builtin_amdgcn_readfirstlane(threadIdx.x >> 6); F.lane = threadIdx.x & 63; F.G = gridDim.x; F.wg = blockIdx.x;
    volatile LAS unsigned* bst = (volatile LAS unsigned*)(F.lds + LDS_BYTES - 16);
    if (F.tid < 4) bst[F.tid] = 0u;
    __syncthreads();
    const int lo = p.ph_lo, hi = p.ph_hi;
    XcdBarrier bar; bar.bar = (unsigned*)(p.ws + WS_CTL); bar.x = 0; bar.st = bst;
    if (hi - lo > 1) bar = xcd_barrier_post((unsigned*)(p.ws + WS_CTL), bst);
#ifdef ONLY_PHASE
#define IN(k) ((k) == ONLY_PHASE)
#else
#ifdef SKIP_PHASE
#define IN(k) ((k) != SKIP_PHASE && lo <= (k) && (k) < hi)
#else
#define IN(k) (lo <= (k) && (k) < hi)
#endif
#endif
#define PH(k) if (IN(k)) { KParams kq_ = (KParams)__builtin_amdgcn_kernarg_segment_ptr(); asm volatile("" : "+s"(kq_)); F.kp = kq_; int t_ = threadIdx.x; asm volatile("" : "+v"(t_)); F.tid = t_; F.lane = t_ & 63; }
#define SEAM(k) do { if (IN(k) && IN((k) + 1)) xcd_barrier(bar); } while (0)
#ifndef DBG_DOUBLE
#define DBG_DOUBLE 0
#endif
#define PHASE(k, ...) PH(k) if (IN(k)) { { __VA_ARGS__ } if constexpr ((DBG_DOUBLE >> (k)) & 1) { xcd_barrier(bar); { __VA_ARGS__ } } }
    PHASE(0, p0_prologue(F);) SEAM(0);
    PHASE(1, p1_norm(F);) SEAM(1);
    PHASE(2, { dense_units(F, T / 256, (INB - NF8) / 256, (unsigned)WS_H, (unsigned)WS_WINT, 4096u); MoeSched S{(LAS const int*)(F.lds + LDS_TAB)};
          EpiStoreBf16 E{F.at<bf16_t>(WS_Z) + NF8, INWP, C_GA - NF8}; pg8::gemm_phase<2048, EpiStoreBf16, MoeSched>(F.lds, F.ws, S, E); }
        { dense_units(F, T / 256, (NF8 + 4096) / 256, (unsigned)WS_H8, (unsigned)WS_WING8, 2048u); MoeSched S{(LAS const int*)(F.lds + LDS_TAB)};
          EpiInFp8 E{F.at<bf16_t>(WS_Z), F.at<unsigned char>(WS_GZ)}; pg8::gemm_phase<1024, EpiInFp8, MoeSched, true, 122, 127>(F.lds, F.ws, S, E); }) SEAM(2);
    PHASE(3, p3_rope(F);) SEAM(3);
    PHASE(4, p4_indexer(F);) SEAM(4);
    PHASE(5, p5_select(F);)
    PHASE(6, p6_stick(F);) SEAM(6);
    PHASE(7, p7_dsa(F);) SEAM(7);
    PHASE(8, MergedSched S; S.ord.init(T / 256, DM / 256, F.G, F.wg); S.OA = (unsigned)WS_OA; S.OB = (unsigned)WS_OB; S.WA = (unsigned)WS_WAT; S.WB = (unsigned)WS_WBT;
        EpiMerged E{F.at<unsigned char>(WS_GZ), F.at<unsigned char>(WS_MERGED)}; pg8::gemm_phase<512, EpiMerged, MergedSched, true, 122, 122>(F.lds, F.ws, S, E);) SEAM(8);
    PHASE(9, dense_units(F, T / 256, DM / 256, (unsigned)WS_MERGED, (unsigned)WS_WOT, 2048u); MoeSched S{(LAS const int*)(F.lds + LDS_TAB)};
        EpiStoreBf16 E{F.at<bf16_t>(WS_MIX), DM, DM}; pg8::gemm_phase<1024, EpiStoreBf16, MoeSched, true, 122, 123>(F.lds, F.ws, S, E);) SEAM(9);
    PHASE(10, p10_rows(F);) SEAM(10);
    PHASE(11, p11_sort(F);) SEAM(11);
    PHASE(12, moe_tables(F, 0); moe_units<16, 4096>(F, (unsigned)WS_HS, (unsigned)WS_W1T); MoeSched S{(LAS const int*)(F.lds + LDS_TAB)};
        EpiMoe1 E{F.kp->in[I_B1], F.at<unsigned char>(WS_ACT)}; pg8::gemm_phase<1024, EpiMoe1, MoeSched, true, 122, 127>(F.lds, F.ws, S, E);) SEAM(12);
    PHASE(13, if (!IN(12)) moe_tables(F, 0); moe_units<8, 2048>(F, (unsigned)WS_ACT, (unsigned)WS_W2T);        MoeSched S{(LAS const int*)(F.lds + LDS_TAB)};
        EpiMoe2 E{F.kp->in[I_B2], F.at<int>(WS_RSLOT), F.at<float>(WS_RW), F.at<unsigned char>(WS_YS)}; pg8::gemm_phase<1024, EpiMoe2, MoeSched, true, 122, 125>(F.lds, F.ws, S, E);) SEAM(13);
    PHASE(14, p14_final(F);)
#undef IN
#undef SEAM
}


extern "C" void kernel_launch(void* const* d_in, const int* in_sizes, int n_in, void* d_out, int out_size, void* d_ws, size_t ws_size, hipStream_t stream) {
    static int grid = 0;
    if (grid == 0) {
        if (n_in != 19 || out_size != T * DM || ws_size < WS_END) { fprintf(stderr, "kernel_launch: unexpected shapes: n_in %d out %d ws %zu (need %zu)\n", n_in, out_size, ws_size, (size_t)WS_END); grid = -1; return; }
        int dev = 0, cus = 0, per_cu = 0;
        if (hipGetDevice(&dev) != hipSuccess || hipDeviceGetAttribute(&cus, hipDeviceAttributeMultiprocessorCount, dev) != hipSuccess) { grid = -1; return; }
        if (hipFuncSetAttribute((const void*)mega, hipFuncAttributeMaxDynamicSharedMemorySize, LDS_BYTES) != hipSuccess) { fprintf(stderr, "kernel_launch: hipFuncSetAttribute failed\n"); grid = -1; return; }
        if (hipOccupancyMaxActiveBlocksPerMultiprocessor(&per_cu, (const void*)mega, NTHR, LDS_BYTES) != hipSuccess || per_cu < 1) { fprintf(stderr, "kernel_launch: occupancy query says %d blocks per CU\n", per_cu); per_cu = 1; }
        (void)hipGetLastError();
        grid = cus;
    }
    if (grid < 0) return;
    (void)hipMemsetAsync((char*)d_ws + WS_CTL, 0, CTL_BYTES, stream);
    Params p{};
    for (int i = 0; i < 19; ++i) p.in[i] = (const float*)d_in[i];
    p.out = (float*)d_out; p.ws = (unsigned char*)d_ws;
#if MK_N_LAUNCHES == 1
    p.ph_lo = 0; p.ph_hi = N_PHASES;
    hipLaunchKernelGGL(mega, dim3(grid), dim3(NTHR), LDS_BYTES, stream, p);
#else
#ifndef DBG_LAST_PHASE
#define DBG_LAST_PHASE (N_PHASES - 1)
#endif
    for (int k = 0; k <= DBG_LAST_PHASE; ++k) { p.ph_lo = k; p.ph_hi = k + 1; hipLaunchKernelGGL(mega, dim3(grid), dim3(NTHR), LDS_BYTES, stream, p); }
#endif
    const hipError_t le = hipPeekAtLastError();
    if (le != hipSuccess) fprintf(stderr, "kernel_launch: launch failed: %s\n", hipGetErrorName(le));
}
```
